# Optimizing an MI355X kernel written in HIP

```python
import jax, jax.numpy as jnp
from jax import lax
import numpy as np

D_MODEL = 1024
BATCH = 4
SEQ = 4096
DEPTH = 2

CTX_LEN = 256
GRID_W = 64
N_MIXERS = 2
EPS = 1e-6
N_MOD = 6
HG_EXPAND = 128
HG_HEADS = D_MODEL // HG_EXPAND
HG_DV = D_MODEL // HG_HEADS
HG_CHUNK = 64
N_HG_PROJ = 5
POOL_WINDOWS = (2, 4, 8, 16)
POOL_GROUPS = len(POOL_WINDOWS)
POOL_GDIM = D_MODEL // POOL_GROUPS
N_EXPERTS = 16
N_EXPERT_GROUPS = 4
EXPERTS_PER_GROUP = N_EXPERTS // N_EXPERT_GROUPS
TOP_K = 2
D_EXPERT = 256

kernel_name = "hybrid_hgrn2_pool_moe_dit"


def rms_norm(x, g):
    xf = x.astype(jnp.float32)
    y = xf * lax.rsqrt(jnp.mean(xf * xf, axis=-1, keepdims=True) + EPS)
    return (y * g.astype(jnp.float32)).astype(x.dtype)


def modulate(x, g, shift, scale):
    return rms_norm(x, g) * (1.0 + scale) + shift


def _heads(t):
    b, l, _ = t.shape
    return t.reshape(b, l, HG_HEADS, -1).transpose(0, 2, 1, 3).astype(jnp.float32)


def _rev(t):
    return jnp.flip(t, axis=2)


def _lower_bound(logits, slot):
    p = jax.nn.softmax(logits.astype(jnp.float32), axis=0)
    return jnp.cumsum(p, axis=0)[slot].reshape(HG_HEADS, 1, HG_EXPAND)


def _gate(z, lb):
    log_f = jnp.logaddexp(jnp.log(lb), jnp.log1p(-lb) + jax.nn.log_sigmoid(z))
    k = (1.0 - lb) * jax.nn.sigmoid(-z)
    return log_f, k


def _gla_scan(q, k, v, log_f, s0):
    b, h, l, _ = q.shape
    dv = v.shape[-1]
    n = l // HG_CHUNK
    rs = lambda t: t.reshape(b, h, n, HG_CHUNK, t.shape[-1])
    q, k, v, log_f = rs(q), rs(k), rs(v), rs(log_f)
    cum = jnp.cumsum(log_f, axis=3)
    ref = cum[:, :, :, HG_CHUNK // 2 - 1:HG_CHUNK // 2, :]
    scores = jnp.einsum('bhnck,bhnsk->bhncs', q * jnp.exp(cum - ref), k * jnp.exp(ref - cum))
    tri = jnp.tril(jnp.ones((HG_CHUNK, HG_CHUNK), dtype=bool))
    scores = jnp.where(tri, scores, 0.0)
    intra = jnp.einsum('bhncs,bhnsv->bhncv', scores, v)
    last = cum[:, :, :, -1:, :]
    chunk_kv = jnp.einsum('bhnck,bhncv->nbhkv', k * jnp.exp(last - cum), v)
    chunk_decay = jnp.moveaxis(jnp.exp(last[:, :, :, 0, :]), 2, 0)

    def step(s, inp):
        dec, kv = inp
        return dec[..., None] * s + kv, s

    s_final, s_prev = lax.scan(step, s0, (chunk_decay, chunk_kv))
    inter = jnp.einsum('bhnck,nbhkv->bhncv', q * jnp.exp(cum), s_prev)
    return (intra + inter).reshape(b, h, l, dv), s_final


def _hgrn_inputs(h, w_in):
    q, v, zf, zb, g = jnp.split(h @ w_in, N_HG_PROJ, axis=-1)
    return jax.nn.silu(_heads(q)), _heads(v), _heads(zf), _heads(zb), g


def _hgrn_readout(o, g, gnorm, w_out):
    b, h, l, dv = o.shape
    o = o * lax.rsqrt(jnp.mean(o * o, axis=-1, keepdims=True) + EPS) * gnorm.astype(jnp.float32)
    o = o.transpose(0, 2, 1, 3).reshape(b, l, h * dv)
    y = (o * jax.nn.silu(g.astype(jnp.float32))).astype(g.dtype)
    return y @ w_out


def hgrn2_mixer(h_lat, h_ctx, w_in, lb_fwd, lb_bwd, gnorm, w_out, slot, need_ctx):
    lbf = _lower_bound(lb_fwd, slot)
    lbb = _lower_bound(lb_bwd, slot)
    qc, vc, zfc, zbc, gc = _hgrn_inputs(h_ctx, w_in)
    ql, vl, zfl, zbl, gl = _hgrn_inputs(h_lat, w_in)
    s0 = jnp.zeros((h_lat.shape[0], HG_HEADS, HG_EXPAND, HG_DV), jnp.float32)
    lf, kf = _gate(zfc, lbf)
    o_cf, s_f = _gla_scan(qc, kf, vc, lf, s0)
    lf, kf = _gate(zfl, lbf)
    o_lf, _ = _gla_scan(ql, kf, vl, lf, s_f)
    lbk, kb = _gate(zbc, lbb)
    o_cb, s_b = _gla_scan(_rev(qc), _rev(kb), _rev(vc), _rev(lbk), s0)
    lbk, kb = _gate(zbl, lbb)
    o_lb, _ = _gla_scan(_rev(ql), _rev(kb), _rev(vl), _rev(lbk), s_b)
    y_lat = _hgrn_readout(o_lf + _rev(o_lb), gl, gnorm, w_out)
    y_ctx = _hgrn_readout(o_cf + _rev(o_cb), gc, gnorm, w_out) if need_ctx else None
    return y_lat, y_ctx


def _box_sum(u, win, axis):
    n = u.shape[axis]
    cs = jnp.cumsum(u, axis=axis)
    pad = [(0, 0)] * u.ndim
    pad[axis] = (1, 0)
    cs = jnp.pad(cs, pad)
    t = jnp.arange(n)
    lo = jnp.clip(t - win // 2, 0, n)
    hi = jnp.clip(t - win // 2 + win, 0, n)
    return jnp.take(cs, hi, axis=axis) - jnp.take(cs, lo, axis=axis), hi - lo


def _grid_mean(u, win):
    b, l, d = u.shape
    rows = l // GRID_W
    g = u.reshape(b, rows, GRID_W, d)
    s, cnt_c = _box_sum(g, win, 2)
    s, cnt_r = _box_sum(s, win, 1)
    cnt = (cnt_r[:, None] * cnt_c[None, :]).astype(u.dtype)
    return (s / cnt[None, :, :, None]).reshape(b, l, d)


def _seq_mean(u, win):
    s, cnt = _box_sum(u, win, 1)
    return s / cnt.astype(u.dtype)[None, :, None]


def _pool_mix(h, mean_fn, w_in, w_grp, p_scale, w_out):
    u = (h @ w_in).astype(jnp.float32)
    parts = []
    for gi, win in enumerate(POOL_WINDOWS):
        ug = u[..., gi * POOL_GDIM:(gi + 1) * POOL_GDIM]
        parts.append((mean_fn(ug, win) - ug) @ w_grp[gi].astype(jnp.float32))
    y = jnp.concatenate(parts, axis=-1) * p_scale.astype(jnp.float32)
    return y.astype(h.dtype) @ w_out


def pool_mixer(h_lat, h_ctx, w_in, w_grp, p_scale, w_out, need_ctx):
    y_lat = _pool_mix(h_lat, _grid_mean, w_in, w_grp, p_scale, w_out)
    y_ctx = _pool_mix(h_ctx, _seq_mean, w_in, w_grp, p_scale, w_out) if need_ctx else None
    return y_lat, y_ctx


def moe_ffn(h, router_w, router_b, w_gate, w_up, w_down):
    n = h.shape[0]
    s = jax.nn.sigmoid((h @ router_w).astype(jnp.float32))
    sel = (s + router_b.astype(jnp.float32)).reshape(n, N_EXPERT_GROUPS, EXPERTS_PER_GROUP)
    top_v, top_i = lax.top_k(sel, TOP_K)
    best = jnp.argmax(jnp.sum(top_v, axis=-1), axis=-1)
    loc = jnp.take_along_axis(top_i, best[:, None, None], axis=1)[:, 0]
    ids = best[:, None] * EXPERTS_PER_GROUP + loc
    w = jnp.take_along_axis(s, ids, axis=1)
    w = w / jnp.sum(w, axis=-1, keepdims=True)
    combine = jnp.sum(jax.nn.one_hot(ids, N_EXPERTS, dtype=jnp.float32) * w[..., None], axis=1)
    y = jnp.zeros(h.shape, jnp.float32)
    for e in range(N_EXPERTS):
        a = jax.nn.silu(h @ w_gate[e]) * (h @ w_up[e])
        y = y + combine[:, e:e + 1] * (a @ w_down[e]).astype(jnp.float32)
    return y.astype(h.dtype)


def setup_inputs(seed: int = 0) -> dict:
    key = jax.random.key(seed)
    ks = jax.random.split(key, 24)
    n_a = (DEPTH + N_MIXERS - 1) // N_MIXERS
    n_b = DEPTH // N_MIXERS
    nrm = lambda k, shape, sc: jax.random.normal(k, shape, jnp.float32) * sc
    d = D_MODEL
    return {
        "x": nrm(ks[0], (BATCH, SEQ, d), 1.0),
        "c": nrm(ks[1], (BATCH, d), 1.0),
        "ctx": nrm(ks[2], (BATCH, CTX_LEN, d), 1.0),
        "c_ctx": nrm(ks[3], (d,), 1.0),
        "w_mod": nrm(ks[4], (DEPTH, d, N_MOD * d), 0.5 * d ** -0.5),
        "b_mod": nrm(ks[5], (DEPTH, N_MOD * d), 0.01),
        "norm1_g": 1.0 + nrm(ks[6], (DEPTH, d), 0.05),
        "norm2_g": 1.0 + nrm(ks[7], (DEPTH, d), 0.05),
        "hg_w_in": nrm(ks[8], (n_a, d, N_HG_PROJ * d), d ** -0.5),
        "hg_lb_fwd": nrm(ks[9], (n_a + 1, d), 0.5),
        "hg_lb_bwd": nrm(ks[10], (n_a + 1, d), 0.5),
        "hg_gnorm": 1.0 + nrm(ks[11], (n_a, HG_DV), 0.05),
        "hg_w_out": nrm(ks[12], (n_a, d, d), d ** -0.5),
        "pool_w_in": nrm(ks[13], (n_b, d, d), d ** -0.5),
        "pool_w_grp": nrm(ks[14], (n_b, POOL_GROUPS, POOL_GDIM, POOL_GDIM), POOL_GDIM ** -0.5),
        "pool_scale": 1.0 + nrm(ks[15], (n_b, d), 0.1),
        "pool_w_out": nrm(ks[16], (n_b, d, d), d ** -0.5),
        "router_w": nrm(ks[17], (d, N_EXPERTS), d ** -0.5),
        "router_b": nrm(ks[18], (N_EXPERTS,), 0.01),
        "moe_w_gate": nrm(ks[19], (DEPTH, N_EXPERTS, d, D_EXPERT), d ** -0.5),
        "moe_w_up": nrm(ks[20], (DEPTH, N_EXPERTS, d, D_EXPERT), d ** -0.5),
        "moe_w_down": nrm(ks[21], (DEPTH, N_EXPERTS, D_EXPERT, d), D_EXPERT ** -0.5),
        "final_g": 1.0 + nrm(ks[22], (d,), 0.05),
    }


def reference(x, c, ctx, c_ctx, w_mod, b_mod, norm1_g, norm2_g, hg_w_in, hg_lb_fwd, hg_lb_bwd, hg_gnorm,
              hg_w_out, pool_w_in, pool_w_grp, pool_scale, pool_w_out, router_w, router_b, moe_w_gate,
              moe_w_up, moe_w_down, final_g):
    x_lat, x_ctx = x, ctx
    d = x.shape[-1]
    for i in range(DEPTH):
        need_ctx = i < DEPTH - 1
        slot = i // N_MIXERS
        mod = jax.nn.silu(c) @ w_mod[i] + b_mod[i]
        sh1, sc1, g1, sh2, sc2, g2 = jnp.split(mod[:, None, :], N_MOD, axis=-1)
        mod_c = jax.nn.silu(c_ctx) @ w_mod[i] + b_mod[i]
        csh1, csc1, cg1, csh2, csc2, cg2 = jnp.split(mod_c, N_MOD, axis=-1)
        h_lat = modulate(x_lat, norm1_g[i], sh1, sc1)
        h_ctx = modulate(x_ctx, norm1_g[i], csh1, csc1)
        if i % N_MIXERS == 0:
            y_lat, y_ctx = hgrn2_mixer(h_lat, h_ctx, hg_w_in[slot], hg_lb_fwd, hg_lb_bwd, hg_gnorm[slot],
                                       hg_w_out[slot], slot, need_ctx)
        else:
            y_lat, y_ctx = pool_mixer(h_lat, h_ctx, pool_w_in[slot], pool_w_grp[slot], pool_scale[slot],
                                      pool_w_out[slot], need_ctx)
        x_lat = x_lat + g1 * y_lat
        h2_lat = modulate(x_lat, norm2_g[i], sh2, sc2).reshape(-1, d)
        n_lat = h2_lat.shape[0]
        if need_ctx:
            x_ctx = x_ctx + cg1 * y_ctx
            h2_ctx = modulate(x_ctx, norm2_g[i], csh2, csc2).reshape(-1, d)
            ff = moe_ffn(jnp.concatenate([h2_lat, h2_ctx], axis=0), router_w, router_b,
                         moe_w_gate[i], moe_w_up[i], moe_w_down[i])
            x_ctx = x_ctx + cg2 * ff[n_lat:].reshape(x_ctx.shape)
            ff_lat = ff[:n_lat]
        else:
            ff_lat = moe_ffn(h2_lat, router_w, router_b, moe_w_gate[i], moe_w_up[i], moe_w_down[i])
        x_lat = x_lat + g2 * ff_lat.reshape(x_lat.shape)
    return rms_norm(x_lat, final_g)
```

```cpp
#include <hip/hip_runtime.h>
#include <cstdio>
#include <cstdint>

#ifndef MK_ONE_LAUNCH
#define MK_ONE_LAUNCH 0
#endif
#ifndef CTX_FULL
#define CTX_FULL 1
#endif

constexpr int D = 1024, NB = 4, SEQ = 4096, CTXL = 256;
constexpr int M_LAT = NB * SEQ, M_CTX = NB * CTXL, M_ALL = M_LAT + M_CTX;
constexpr int NH = 8, DH = 128, NPROJ = 5;
constexpr int NE = 16, DE = 256, NGRP = 4, EPG = 4;
constexpr int GRIDW = 64;
constexpr float EPS = 1e-6f;
constexpr int NWAVES = 8, NTHR = 512;
constexpr int NPHASE = 18;

constexpr size_t MiB = 1u << 20;
constexpr size_t WS_CTL = 0, CTL_ZERO_BYTES = 1 * MiB;
constexpr size_t WS_MODV = 1 * MiB;
constexpr size_t WS_LIST = 2 * MiB;
constexpr size_t WS_SLOTE = 2 * MiB + 1280 * 1024;
constexpr size_t WS_SLOTW = 2 * MiB + 1536 * 1024;
constexpr size_t WS_WHGIN = 4 * MiB;
constexpr size_t WS_WHGOUT = 14 * MiB;
constexpr size_t WS_WGU0 = 16 * MiB;
constexpr size_t WS_WD0 = 32 * MiB;
constexpr size_t WS_XC = 40 * MiB;
constexpr size_t WS_H = 44 * MiB;
constexpr size_t WS_PL = 78 * MiB;
constexpr size_t PLANE = (size_t)M_ALL * D * 2;
constexpr size_t WS_OFC = 248 * MiB, WS_OBC = 250 * MiB;
constexpr size_t WS_WPIN = 78 * MiB, WS_WGRP = 80 * MiB, WS_WPOUT = 81 * MiB;
constexpr size_t WS_WGU1 = 83 * MiB, WS_WD1 = 99 * MiB;
constexpr size_t WS_ACT = 108 * MiB;
constexpr size_t WS_Y2 = 128 * MiB;
constexpr size_t WS_U = 204 * MiB;
constexpr size_t WS_DP = 108 * MiB;
constexpr size_t WS_E = 140 * MiB;
constexpr size_t WS_END = 256 * MiB;
static_assert(WS_PL + 5 * PLANE <= WS_OFC && WS_H + PLANE <= WS_PL && WS_Y2 + (size_t)38912 * 2048 <= WS_U && WS_U + (size_t)M_LAT * 2048 <= WS_OFC, "ws map");
static_assert(WS_ACT + (size_t)38912 * 512 <= WS_Y2 && WS_DP + (size_t)M_LAT * 2048 <= WS_E && WS_E + (size_t)M_LAT * 2048 <= WS_U && WS_WD1 + 8 * MiB <= WS_ACT, "ws map 2");
constexpr int CW_BAR = 4096;
constexpr int CW_CNT = 8192;
constexpr int LIST_CAP = M_ALL;

constexpr int RING_BYTES = 131072;
constexpr int LDSCTL_OFF = RING_BYTES, MISC_OFF = LDSCTL_OFF + 320;
constexpr int LDS_BYTES = 147456;

#define GAS __attribute__((address_space(1)))
#define LAS __attribute__((address_space(3)))
typedef unsigned short bf16;
typedef unsigned v4u __attribute__((ext_vector_type(4)));
typedef unsigned v2u __attribute__((ext_vector_type(2)));
typedef float f32x4 __attribute__((ext_vector_type(4)));
typedef short bf16x8 __attribute__((ext_vector_type(8)));
typedef GAS unsigned gu32;
#define RLX_AGENT __ATOMIC_RELAXED, __HIP_MEMORY_SCOPE_AGENT
#define LDS_WAIT() asm volatile("s_waitcnt lgkmcnt(0)" ::: "memory")
#define VM_WAIT() asm volatile("s_waitcnt vmcnt(0)" ::: "memory")

__device__ __forceinline__ unsigned f2bf(float f) { unsigned u = __builtin_bit_cast(unsigned, f); return (u + 0x7fffu + ((u >> 16) & 1u)) >> 16; }
__device__ __forceinline__ unsigned pk2(float lo, float hi) { return f2bf(lo) | (f2bf(hi) << 16); }
__device__ __forceinline__ float bf2f(unsigned b) { return __builtin_bit_cast(float, b << 16); }
__device__ __forceinline__ float bflo(unsigned w) { return __builtin_bit_cast(float, w << 16); }
__device__ __forceinline__ float bfhi(unsigned w) { return __builtin_bit_cast(float, w & 0xffff0000u); }
__device__ __forceinline__ float sigmoidf_(float x) { return 1.f / (1.f + __expf(-x)); }
__device__ __forceinline__ float siluf_(float x) { return x / (1.f + __expf(-x)); }
__device__ __forceinline__ float wave_sum(float v) {
#pragma unroll
    for (int o = 1; o < 64; o <<= 1) v += __shfl_xor(v, o);
    return v;
}

#define XB_TMO      128
#define XB_XCNT(j)  (256  + 64 * (j))
#define XB_XSUB(j)  (1280 + 64 * (j))
#define XB_XGEN(j)  (2304 + 64 * (j))
#define XB_TOP      3328
#define XB_TOPGEN   3392
#define XCD_BAR_WORDS 3456
#define XB_SPIN_CAP (1u << 18)
__device__ __forceinline__ unsigned xb_ld(unsigned* p)              { return __hip_atomic_load(p, __ATOMIC_RELAXED, __HIP_MEMORY_SCOPE_AGENT); }
__device__ __forceinline__ unsigned xb_add(unsigned* p, unsigned v) { return __hip_atomic_fetch_add(p, v, __ATOMIC_RELAXED, __HIP_MEMORY_SCOPE_AGENT); }
__device__ __forceinline__ unsigned xb_xcc_id() { return (unsigned)__builtin_amdgcn_s_getreg((3 << 11) | 20) & 0xFu; }
#define XB_SPIN(cond, bar) do { unsigned _sp = 0; while (cond) { __builtin_amdgcn_s_sleep(1); \
    if ((++_sp & 255u) == 0u) { if (xb_ld(&(bar)[XB_TMO])) break; if (_sp > XB_SPIN_CAP) { atomicAdd(&(bar)[XB_TMO], 1u); break; } } } } while (0)
struct XcdBarrier { unsigned* bar; unsigned x; volatile LAS unsigned* st; };
__device__ __forceinline__ XcdBarrier xcd_barrier_post(unsigned* bar, volatile LAS unsigned* st) {
    XcdBarrier b; b.bar = bar; b.x = xb_xcc_id(); b.st = st;
    if (threadIdx.x == 0) (void)xb_add(&bar[XB_XCNT(b.x)], 1u);
    return b;
}
__device__ __forceinline__ void xcd_barrier_complete(unsigned* bar, unsigned x, unsigned& nloc, unsigned& nx) {
    const unsigned G = gridDim.x * gridDim.y * gridDim.z;
    unsigned sum, cnt, mine, sp = 0u;
    for (;;) {
        sum = 0u; cnt = 0u; mine = 0u;
#pragma unroll
        for (unsigned j = 0; j < 16; ++j) { const unsigned c = xb_ld(&bar[XB_XCNT(j)]); sum += c; cnt += (c > 0u) ? 1u : 0u; mine = (j == x) ? c : mine; }
        if (sum == G) break;
        __builtin_amdgcn_s_sleep(1);
        if ((++sp & 255u) == 0u) { if (xb_ld(&bar[XB_TMO])) break; if (sp > XB_SPIN_CAP) { atomicAdd(&bar[XB_TMO], 1u); break; } }
    }
    nloc = mine > 0u ? mine : 1u; nx = cnt > 0u ? cnt : 1u;
}
__device__ __forceinline__ void xcd_barrier(const XcdBarrier& b) {
    asm volatile("s_waitcnt vmcnt(0)" ::: "memory");
    __syncthreads();
    if (threadIdx.x == 0) {
        unsigned* bar = b.bar;
        __builtin_amdgcn_s_waitcnt(0);
        unsigned nloc = b.st[0], nx = b.st[1];
        if (nloc == 0u) { xcd_barrier_complete(bar, b.x, nloc, nx); b.st[0] = nloc; b.st[1] = nx; }
        const unsigned old = xb_add(&bar[XB_XSUB(b.x)], 1u);
        const unsigned gen = old / nloc;
        if (old + 1u == (gen + 1u) * nloc) {
            __builtin_amdgcn_fence(__ATOMIC_RELEASE, "agent");
            asm volatile("s_waitcnt vmcnt(0)" ::: "memory");
            const unsigned og = xb_add(&bar[XB_TOP], 1u);
            const unsigned tg = og / nx;
            if (og + 1u == (tg + 1u) * nx) xb_add(&bar[XB_TOPGEN], 1u);
            else XB_SPIN(xb_ld(&bar[XB_TOPGEN]) == tg, bar);
            __builtin_amdgcn_fence(__ATOMIC_ACQUIRE, "agent");
            xb_add(&bar[XB_XGEN(b.x)], 1u);
            asm volatile("s_waitcnt vmcnt(0)" ::: "memory");
        } else {
            XB_SPIN(xb_ld(&bar[XB_XGEN(b.x)]) == gen, bar);
            __builtin_amdgcn_fence(__ATOMIC_ACQUIRE, "agent");
            asm volatile("s_waitcnt vmcnt(0)" ::: "memory");
        }
    }
    __syncthreads();
}

struct Unit { int pm, pn; };
struct Gemm { const bf16* A; const bf16* Bt; int K; };
constexpr int NXCD = 8, WGM = 8, BM = 256;

struct StaticOrder {
    int nM, nN, nwg, G, c;
    __device__ __forceinline__ void init(int M, int N, int G_, int c_) { nM = M / BM; nN = N / BM; nwg = nM * nN; G = G_; c = c_; }
    __device__ __forceinline__ bool next(int i, Unit& u) const {
        const long L = (long)i * G + c; if (L >= nwg) return false;
        int wgid = (int)L; { const int q = nwg / NXCD, r = nwg % NXCD, xcd = wgid % NXCD, off = wgid / NXCD; wgid = (xcd < r ? xcd * (q + 1) : r * (q + 1) + (xcd - r) * q) + off; }
        const int nig = WGM * nN, gid = wgid / nig, fm = gid * WGM, gsz = (nM - fm) < WGM ? (nM - fm) : WGM;
        u.pm = fm + ((wgid % nig) % gsz); u.pn = (wgid % nig) / gsz; return true;
    }
    __device__ __forceinline__ int a_row(const Unit& u, int r) const { return u.pm * BM + r; }
};
struct GroupOrder {
    int G, c;
    __device__ __forceinline__ bool next(int i, Unit& u) const { const int L = i * G + c; if (L >= 256) return false; u.pm = L; u.pn = L >> 6; return true; }
    __device__ __forceinline__ int a_row(const Unit& u, int r) const { return u.pm * BM + r; }
};
struct MoeOrder {
    int G, c, npn, gather; const volatile LAS unsigned* tb; const unsigned* list;
    __device__ __forceinline__ bool next(int i, Unit& u) const {
        const int L = i * G + c; const int nt = (int)tb[16];
        if (L >= nt * npn) return false;
        const int t = L / npn, nl = L % npn; int e = 0;
#pragma unroll
        for (int j = 1; j < 16; ++j) e += (t >= (int)tb[j]) ? 1 : 0;
        u.pm = t; u.pn = e * npn + nl; return true;
    }
    __device__ __forceinline__ int a_row(const Unit& u, int r) const {
        if (!gather) return u.pm * BM + r;
        const int e = u.pn / npn; const int idx = (u.pm - (int)tb[e]) * BM + r;
        const unsigned ent = (idx < (int)tb[17 + e]) ? list[(size_t)e * LIST_CAP + idx] : 0u;
        return (int)(ent >> 1);
    }
};

template <class Epi, class Sched>
__device__ __forceinline__ void gemm_naive(const Gemm g, const Sched& S, const Epi& E) {
    const int tid = threadIdx.x, wid = tid >> 6, lane = tid & 63, wr = wid >> 2, wc = wid & 3, fr = lane & 15, fq = lane >> 4;
    const int K = g.K;
    Unit u;
    for (int i = 0; S.next(i, u); ++i) {
        f32x4 acc[2][2][4][2];
#pragma unroll
        for (int ai = 0; ai < 2; ++ai)
#pragma unroll
            for (int m = 0; m < 4; ++m) {
                const bf16* ar = g.A + (size_t)S.a_row(u, 128 * ai + 64 * wr + 16 * m + fr) * K;
#pragma unroll
                for (int bj = 0; bj < 2; ++bj)
#pragma unroll
                    for (int n = 0; n < 2; ++n) {
                        const int c0 = 128 * bj + 32 * wc + (Epi::PERM ? 8 * fq + 4 * n : 16 * n + 4 * fq);
                        const bf16* br = g.Bt + (size_t)(u.pn * BM + c0) * K;
                        f32x4 a0 = {0.f, 0.f, 0.f, 0.f};
#pragma unroll 1
                        for (int k = 0; k < K; k += 8) {
                            const v4u b0 = *(const v4u*)(br + k), b1 = *(const v4u*)(br + (size_t)K + k), b2 = *(const v4u*)(br + (size_t)2 * K + k), b3 = *(const v4u*)(br + (size_t)3 * K + k);
                            const v4u x0 = *(const v4u*)(ar + k);
#pragma unroll
                            for (int q = 0; q < 4; ++q) {
                                const f32x4 blo = {bflo(b0[q]), bflo(b1[q]), bflo(b2[q]), bflo(b3[q])}, bhi = {bfhi(b0[q]), bfhi(b1[q]), bfhi(b2[q]), bfhi(b3[q])};
                                a0 += blo * bflo(x0[q]) + bhi * bfhi(x0[q]);
                            }
                        }
                        asm volatile("" : "+v"(a0));
                        acc[ai][bj][m][n] = a0;
                    }
            }
        E(acc, u, wr, wc, fr, fq);
    }
}

struct EpiInProj {
    static constexpr bool PERM = true;
    bf16* PL;
    __device__ __forceinline__ void operator()(const f32x4 (&acc)[2][2][4][2], const Unit& u, int wr, int wc, int fr, int fq) const {
        const int p = u.pn >> 2; const bool act = (p == 0) || (p == 4);
        bf16* base = PL + (size_t)p * ((size_t)M_ALL * D);
        const int col0 = (u.pn & 3) * BM + wc * 32 + 8 * fq, row0 = u.pm * BM + wr * 64 + fr;
#pragma unroll
        for (int ai = 0; ai < 2; ++ai)
#pragma unroll
            for (int m = 0; m < 4; ++m) { bf16* rowp = base + (size_t)(row0 + ai * 128 + m * 16) * D + col0;
#pragma unroll
                for (int bj = 0; bj < 2; ++bj) { f32x4 v0 = acc[ai][bj][m][0], v1 = acc[ai][bj][m][1];
                    if (act) {
#pragma unroll
                        for (int j = 0; j < 4; ++j) { v0[j] = siluf_(v0[j]); v1[j] = siluf_(v1[j]); } }
                    v4u w; w.x = pk2(v0[0], v0[1]); w.y = pk2(v0[2], v0[3]); w.z = pk2(v1[0], v1[1]); w.w = pk2(v1[2], v1[3]);
                    *(v4u*)(rowp + bj * 128) = w; } }
    }
};
struct EpiBf16Plain {
    static constexpr bool PERM = true;
    bf16* O; int ldc;
    __device__ __forceinline__ void operator()(const f32x4 (&acc)[2][2][4][2], const Unit& u, int wr, int wc, int fr, int fq) const {
        const int col0 = u.pn * BM + wc * 32 + 8 * fq, row0 = u.pm * BM + wr * 64 + fr;
#pragma unroll
        for (int ai = 0; ai < 2; ++ai)
#pragma unroll
            for (int m = 0; m < 4; ++m) { bf16* rowp = O + (size_t)(row0 + ai * 128 + m * 16) * ldc + col0;
#pragma unroll
                for (int bj = 0; bj < 2; ++bj) { const f32x4 v0 = acc[ai][bj][m][0], v1 = acc[ai][bj][m][1];
                    v4u w; w.x = pk2(v0[0], v0[1]); w.y = pk2(v0[2], v0[3]); w.z = pk2(v1[0], v1[1]); w.w = pk2(v1[2], v1[3]);
                    *(v4u*)(rowp + bj * 128) = w; } }
    }
};
struct EpiDown {
    static constexpr bool PERM = true;
    bf16* O;
    __device__ __forceinline__ void operator()(const f32x4 (&acc)[2][2][4][2], const Unit& u, int wr, int wc, int fr, int fq) const {
        const int col0 = (u.pn & 3) * BM + wc * 32 + 8 * fq, row0 = u.pm * BM + wr * 64 + fr;
#pragma unroll
        for (int ai = 0; ai < 2; ++ai)
#pragma unroll
            for (int m = 0; m < 4; ++m) { bf16* rowp = O + (size_t)(row0 + ai * 128 + m * 16) * D + col0;
#pragma unroll
                for (int bj = 0; bj < 2; ++bj) { const f32x4 v0 = acc[ai][bj][m][0], v1 = acc[ai][bj][m][1];
                    v4u w; w.x = pk2(v0[0], v0[1]); w.y = pk2(v0[2], v0[3]); w.z = pk2(v1[0], v1[1]); w.w = pk2(v1[2], v1[3]);
                    *(v4u*)(rowp + bj * 128) = w; } }
    }
};
struct EpiGateUp {
    static constexpr bool PERM = true;
    bf16* ACT;
    __device__ __forceinline__ void operator()(const f32x4 (&acc)[2][2][4][2], const Unit& u, int wr, int wc, int fr, int fq) const {
        const int col0 = (u.pn & 1) * 128 + wc * 32 + 8 * fq, row0 = u.pm * BM + wr * 64 + fr;
#pragma unroll
        for (int ai = 0; ai < 2; ++ai)
#pragma unroll
            for (int m = 0; m < 4; ++m) { bf16* rowp = ACT + (size_t)(row0 + ai * 128 + m * 16) * DE + col0;
                f32x4 v0, v1;
#pragma unroll
                for (int j = 0; j < 4; ++j) { v0[j] = siluf_(acc[ai][0][m][0][j]) * acc[ai][1][m][0][j]; v1[j] = siluf_(acc[ai][0][m][1][j]) * acc[ai][1][m][1][j]; }
                v4u w; w.x = pk2(v0[0], v0[1]); w.y = pk2(v0[2], v0[3]); w.z = pk2(v1[0], v1[1]); w.w = pk2(v1[2], v1[3]);
                *(v4u*)rowp = w; }
    }
};
struct EpiGrp {
    static constexpr bool PERM = true;
    bf16* O; const float* ps;
    __device__ __forceinline__ void operator()(const f32x4 (&acc)[2][2][4][2], const Unit& u, int wr, int wc, int fr, int fq) const {
        const int col0 = u.pn * BM + wc * 32 + 8 * fq, row0 = (u.pm & 63) * BM + wr * 64 + fr;
#pragma unroll
        for (int bj = 0; bj < 2; ++bj) {
            const f32x4 s0 = *(const f32x4*)(ps + col0 + bj * 128), s1 = *(const f32x4*)(ps + col0 + bj * 128 + 4);
#pragma unroll
            for (int ai = 0; ai < 2; ++ai)
#pragma unroll
                for (int m = 0; m < 4; ++m) { bf16* rowp = O + (size_t)(row0 + ai * 128 + m * 16) * D + col0 + bj * 128;
                    const f32x4 v0 = acc[ai][bj][m][0] * s0, v1 = acc[ai][bj][m][1] * s1;
                    v4u w; w.x = pk2(v0[0], v0[1]); w.y = pk2(v0[2], v0[3]); w.z = pk2(v1[0], v1[1]); w.w = pk2(v1[2], v1[3]);
                    *(v4u*)rowp = w; }
        }
    }
};
struct EpiResid {
    static constexpr bool PERM = false;
    const float* xin_lat; const float* xin_ctx; float* out_lat; float* out_ctx; const float* gate;
    __device__ __forceinline__ void operator()(const f32x4 (&acc)[2][2][4][2], const Unit& u, int wr, int wc, int fr, int fq) const {
        const int col0 = u.pn * BM + wc * 32 + 4 * fq, row0 = u.pm * BM + wr * 64 + fr;
        const bool isctx = row0 >= M_LAT;
        const int bidx = isctx ? 4 : (row0 / SEQ);
        const float* xin = isctx ? xin_ctx - (size_t)M_LAT * D : xin_lat; float* out = isctx ? out_ctx - (size_t)M_LAT * D : out_lat;
        const float* gp = gate + (size_t)bidx * 6144 + col0;
        f32x4 gv[2][2];
#pragma unroll
        for (int bj = 0; bj < 2; ++bj)
#pragma unroll
            for (int n = 0; n < 2; ++n) gv[bj][n] = *(const f32x4*)(gp + bj * 128 + n * 16);
#pragma unroll
        for (int ai = 0; ai < 2; ++ai)
#pragma unroll
            for (int m = 0; m < 4; ++m) { const size_t ro = (size_t)(row0 + ai * 128 + m * 16) * D + col0;
#pragma unroll
                for (int bj = 0; bj < 2; ++bj)
#pragma unroll
                    for (int n = 0; n < 2; ++n) { const f32x4 xv = *(const f32x4*)(xin + ro + bj * 128 + n * 16);
                        *(f32x4*)(out + ro + bj * 128 + n * 16) = xv + gv[bj][n] * acc[ai][bj][m][n]; } }
    }
};

struct Frame {
    LAS unsigned char* lds; volatile LAS unsigned* MISC; gu32* ctl;
    int tid, lane, wave, G, bid;
    const float* in[23]; float* out; unsigned char* ws;
};
__device__ __forceinline__ const float* modv(const Frame& F, int l, int b, int j) { return (const float*)(F.ws + WS_MODV) + ((size_t)l * 5 + b) * 6144 + j * 1024; }

__device__ __forceinline__ void transpose_item(const float* W, int N, int k0, int n0, bf16* WT, int KT, size_t dst_row0, LAS float* scr, int lane) {
#pragma unroll 8
    for (int i = 0; i < 32; ++i) { const int kk = 2 * i + (lane >> 5); scr[kk * 33 + (lane & 31)] = W[(size_t)(k0 + kk) * N + n0 + (lane & 31)]; }
    LDS_WAIT(); asm volatile("" ::: "memory");
    const int c = lane & 7;
#pragma unroll
    for (int j = 0; j < 4; ++j) { const int n = (lane >> 3) + 8 * j; const LAS float* s = scr + (8 * c) * 33 + n;
        v4u o; o.x = pk2(s[0 * 33], s[1 * 33]); o.y = pk2(s[2 * 33], s[3 * 33]); o.z = pk2(s[4 * 33], s[5 * 33]); o.w = pk2(s[6 * 33], s[7 * 33]);
        *(v4u*)(WT + (dst_row0 + n) * KT + k0 + 8 * c) = o; }
    LDS_WAIT(); asm volatile("" ::: "memory");
}
__device__ __forceinline__ void conv_moe_item(const Frame& F, int l, int r, bf16* WGU, bf16* WD, LAS float* scr) {
    const int kind = r >> 11, rr = r & 2047, e = rr >> 7, it = rr & 127;
    if (kind < 2) { const float* W = (kind ? F.in[20] : F.in[19]) + (size_t)(l * NE + e) * D * DE; const int kb = it >> 3, nb = it & 7, n0 = 32 * nb;
        transpose_item(W, DE, 64 * kb, n0, WGU, D, (size_t)e * 512 + (n0 >> 7) * 256 + kind * 128 + (n0 & 127), scr, F.lane); }
    else { const float* W = F.in[21] + (size_t)(l * NE + e) * DE * D; const int kb = it >> 5, nb = it & 31;
        transpose_item(W, D, 64 * kb, 32 * nb, WD, DE, (size_t)e * D + 32 * nb, scr, F.lane); }
}

__device__ __forceinline__ void p0_prep(Frame& F) {
    if (F.bid < 192) {
        LAS float* sil = (LAS float*)(F.lds);
        LAS float* red = (LAS float*)(F.lds + 32768);
        for (int i = F.tid; i < 5 * D; i += NTHR) { const float cv = (i < 4 * D) ? F.in[1][i] : F.in[3][i - 4 * D]; sil[i] = siluf_(cv); }
        __syncthreads();
        const int l = F.bid / 96, col0 = (F.bid % 96) * 64;
        const float* W = F.in[4] + (size_t)l * D * 6144 + col0 + F.lane;
        float a0 = 0.f, a1 = 0.f, a2 = 0.f, a3 = 0.f, a4 = 0.f;
        const int kbeg = F.wave * 128;
#pragma unroll 8
        for (int k = kbeg; k < kbeg + 128; ++k) { const float w = W[(size_t)k * 6144];
            a0 += sil[k] * w; a1 += sil[D + k] * w; a2 += sil[2 * D + k] * w; a3 += sil[3 * D + k] * w; a4 += sil[4 * D + k] * w; }
        red[(F.wave * 5 + 0) * 64 + F.lane] = a0; red[(F.wave * 5 + 1) * 64 + F.lane] = a1; red[(F.wave * 5 + 2) * 64 + F.lane] = a2;
        red[(F.wave * 5 + 3) * 64 + F.lane] = a3; red[(F.wave * 5 + 4) * 64 + F.lane] = a4;
        __syncthreads();
        if (F.tid < 320) { const int b = F.tid >> 6, cc = F.tid & 63; float s = 0.f;
#pragma unroll
            for (int w = 0; w < 8; ++w) s += red[(w * 5 + b) * 64 + cc];
            ((float*)(F.ws + WS_MODV))[((size_t)l * 5 + b) * 6144 + col0 + cc] = s + F.in[5][l * 6144 + col0 + cc]; }
        __syncthreads();
    }
    LAS float* scr = (LAS float*)(F.lds + F.wave * 16384);
    const int gw = F.bid * NWAVES + F.wave, NGW = F.G * NWAVES;
    constexpr int I_IN = 16 * 160, I_OUT = 16 * 32, I_MOE = 6144;
    for (int it = gw; it < I_IN + I_OUT + I_MOE; it += NGW) {
        int r = it;
        if (r < I_IN) { const int kb = r / 160, nb = r % 160; transpose_item(F.in[8], NPROJ * D, 64 * kb, 32 * nb, (bf16*)(F.ws + WS_WHGIN), D, (size_t)32 * nb, scr, F.lane); continue; } r -= I_IN;
        if (r < I_OUT) { const int kb = r >> 5, nb = r & 31; transpose_item(F.in[12], D, 64 * kb, 32 * nb, (bf16*)(F.ws + WS_WHGOUT), D, (size_t)32 * nb, scr, F.lane); continue; } r -= I_OUT;
        conv_moe_item(F, 0, r, (bf16*)(F.ws + WS_WGU0), (bf16*)(F.ws + WS_WD0), scr);
    }
}
__device__ __forceinline__ void conv_layer1(Frame& F) {
    LAS float* scr = (LAS float*)(F.lds + F.wave * 16384);
    const int gw = F.bid * NWAVES + F.wave, NGW = F.G * NWAVES;
    constexpr int I_SQ = 16 * 32, I_GRP = 4 * 4 * 8, I_MOE = 6144;
    for (int it = gw; it < 2 * I_SQ + I_GRP + I_MOE; it += NGW) {
        int r = it;
        if (r < I_SQ) { const int kb = r >> 5, nb = r & 31; transpose_item(F.in[13], D, 64 * kb, 32 * nb, (bf16*)(F.ws + WS_WPIN), D, (size_t)32 * nb, scr, F.lane); continue; } r -= I_SQ;
        if (r < I_SQ) { const int kb = r >> 5, nb = r & 31; transpose_item(F.in[16], D, 64 * kb, 32 * nb, (bf16*)(F.ws + WS_WPOUT), D, (size_t)32 * nb, scr, F.lane); continue; } r -= I_SQ;
        if (r < I_GRP) { const int g = r >> 5, q = r & 31, kb = q >> 3, nb = q & 7;
            transpose_item(F.in[14] + (size_t)g * 256 * 256, 256, 64 * kb, 32 * nb, (bf16*)(F.ws + WS_WGRP), 256, (size_t)g * 256 + 32 * nb, scr, F.lane); continue; } r -= I_GRP;
        conv_moe_item(F, 1, r, (bf16*)(F.ws + WS_WGU1), (bf16*)(F.ws + WS_WD1), scr);
    }
}

__device__ __forceinline__ void modulate_row(const f32x4 (&v)[4], const float* g, const float* sh, const float* sc, bf16* orow, int lane) {
    float s2 = 0.f;
#pragma unroll
    for (int j = 0; j < 4; ++j) s2 += (v[j].x * v[j].x + v[j].y * v[j].y) + (v[j].z * v[j].z + v[j].w * v[j].w);
    const float rstd = 1.f / sqrtf(wave_sum(s2) * (1.f / D) + EPS);
    unsigned long long* o8 = (unsigned long long*)orow + lane;
#pragma unroll
    for (int j = 0; j < 4; ++j) { const int c = 4 * lane + 256 * j;
        const f32x4 gv = *(const f32x4*)(g + c), shv = *(const f32x4*)(sh + c), scv = *(const f32x4*)(sc + c);
        const f32x4 h = v[j] * rstd * gv * (scv + 1.f) + shv;
        o8[64 * j] = (unsigned long long)pk2(h.x, h.y) | ((unsigned long long)pk2(h.z, h.w) << 32); }
}
__device__ __forceinline__ void p1_modulate0(Frame& F) {
    const int gw = F.bid * NWAVES + F.wave, NGW = F.G * NWAVES;
    bf16* H = (bf16*)(F.ws + WS_H);
    for (int row = gw; row < M_ALL; row += NGW) {
        const bool isctx = row >= M_LAT; const int b = isctx ? 4 : row / SEQ;
        const float* xr = isctx ? F.in[2] + (size_t)(row - M_LAT) * D : F.in[0] + (size_t)row * D;
        f32x4 v[4];
#pragma unroll
        for (int j = 0; j < 4; ++j) v[j] = ((const f32x4*)xr)[F.lane + 64 * j];
        modulate_row(v, F.in[6], modv(F, 0, b, 0), modv(F, 0, b, 1), H + (size_t)row * D, F.lane);
    }
}

__device__ __forceinline__ void p3_scan_naive(Frame& F) {
    if (F.bid >= 64) return;
    const int b = F.bid >> 4, h = (F.bid >> 1) & 7, dir = F.bid & 1;
    const bf16* PQ = (const bf16*)(F.ws + WS_PL), *PV = PQ + (size_t)M_ALL * D, *PZ = PQ + (size_t)(2 + dir) * M_ALL * D;
    bf16* OL = (bf16*)F.out + (size_t)dir * M_LAT * D; bf16* OC = (bf16*)(F.ws + (dir ? WS_OBC : WS_OFC));
    LAS float* fl = (LAS float*)F.lds, *kl = fl + 128, *ql = fl + 256, *ored = fl + 384;
    const int v = F.tid & 127, kq = F.tid >> 7;
    float lbv = 0.f;
    if (F.tid < 128) { const float* lb = dir ? F.in[10] : F.in[9]; lbv = sigmoidf_(lb[h * DH + F.tid] - lb[D + h * DH + F.tid]); }
    float S[32];
#pragma unroll
    for (int j = 0; j < 32; ++j) S[j] = 0.f;
    for (int s = 0; s < CTXL + SEQ; ++s) {
        int row;
        if (s < CTXL) row = M_LAT + b * CTXL + (dir ? CTXL - 1 - s : s);
        else row = b * SEQ + (dir ? SEQ - 1 - (s - CTXL) : s - CTXL);
        const size_t off = (size_t)row * D + h * DH;
        if (F.tid < 128) { const float z = bf2f(PZ[off + F.tid]); const float sg = sigmoidf_(z);
            fl[F.tid] = lbv + (1.f - lbv) * sg; kl[F.tid] = (1.f - lbv) * (1.f - sg); ql[F.tid] = bf2f(PQ[off + F.tid]); }
        const float vv = bf2f(PV[off + v]);
        __syncthreads();
        float po = 0.f;
#pragma unroll
        for (int j = 0; j < 32; ++j) { const int k = 32 * kq + j; S[j] = fl[k] * S[j] + kl[k] * vv; po += S[j] * ql[k]; }
        ored[kq * 128 + v] = po;
        __syncthreads();
        if (kq == 0) { const float o = (ored[v] + ored[128 + v]) + (ored[256 + v] + ored[384 + v]);
            if (s >= CTXL) OL[(size_t)row * D + h * DH + v] = (bf16)f2bf(o);
            else if (CTX_FULL) OC[(size_t)(row - M_LAT) * D + h * DH + v] = (bf16)f2bf(o); }
    }
}

__device__ __forceinline__ void p4_readout_prep(Frame& F) {
    const int gw = F.bid * NWAVES + F.wave, NGW = F.G * NWAVES;
    const bf16* SG = (const bf16*)(F.ws + WS_PL) + (size_t)4 * M_ALL * D; bf16* YP = (bf16*)(F.ws + WS_H);
    const int nrows = CTX_FULL ? M_ALL : M_LAT;
    for (int row = gw; row < nrows; row += NGW) {
        const bf16 *ofp, *obp;
        if (row < M_LAT) { ofp = (const bf16*)F.out + (size_t)row * D; obp = ofp + (size_t)M_LAT * D; }
        else { ofp = (const bf16*)(F.ws + WS_OFC) + (size_t)(row - M_LAT) * D; obp = (const bf16*)(F.ws + WS_OBC) + (size_t)(row - M_LAT) * D; }
        const int c0 = 16 * F.lane;
        const v4u f0 = *(const v4u*)(ofp + c0), f1 = *(const v4u*)(ofp + c0 + 8), b0 = *(const v4u*)(obp + c0), b1 = *(const v4u*)(obp + c0 + 8);
        const v4u g0 = *(const v4u*)(SG + (size_t)row * D + c0), g1 = *(const v4u*)(SG + (size_t)row * D + c0 + 8);
        float o[16]; float ss = 0.f;
#pragma unroll
        for (int q = 0; q < 4; ++q) { o[2 * q] = bflo(f0[q]) + bflo(b0[q]); o[2 * q + 1] = bfhi(f0[q]) + bfhi(b0[q]); o[8 + 2 * q] = bflo(f1[q]) + bflo(b1[q]); o[8 + 2 * q + 1] = bfhi(f1[q]) + bfhi(b1[q]); }
#pragma unroll
        for (int j = 0; j < 16; ++j) ss += o[j] * o[j];
        ss += __shfl_xor(ss, 1); ss += __shfl_xor(ss, 2); ss += __shfl_xor(ss, 4);
        const float rstd = 1.f / sqrtf(ss * (1.f / DH) + EPS);
        const float* gn = F.in[11] + (c0 & 127);
        float y[16];
#pragma unroll
        for (int q = 0; q < 4; ++q) { y[2 * q] = o[2 * q] * rstd * gn[2 * q] * bflo(g0[q]); y[2 * q + 1] = o[2 * q + 1] * rstd * gn[2 * q + 1] * bfhi(g0[q]);
            y[8 + 2 * q] = o[8 + 2 * q] * rstd * gn[8 + 2 * q] * bflo(g1[q]); y[8 + 2 * q + 1] = o[8 + 2 * q + 1] * rstd * gn[8 + 2 * q + 1] * bfhi(g1[q]); }
        v4u w0, w1;
#pragma unroll
        for (int q = 0; q < 4; ++q) { w0[q] = pk2(y[2 * q], y[2 * q + 1]); w1[q] = pk2(y[8 + 2 * q], y[8 + 2 * q + 1]); }
        *(v4u*)(YP + (size_t)row * D + c0) = w0; *(v4u*)(YP + (size_t)row * D + c0 + 8) = w1;
    }
    conv_layer1(F);
}

__device__ __forceinline__ void top2_of4(float a0, float a1, float a2, float a3, int& i1, int& i2, float& sum) {
    i1 = 0; float v1 = a0;
    if (a1 > v1) { v1 = a1; i1 = 1; }
    if (a2 > v1) { v1 = a2; i1 = 2; }
    if (a3 > v1) { v1 = a3; i1 = 3; }
    const float c0 = (i1 == 0) ? -1e30f : a0, c1 = (i1 == 1) ? -1e30f : a1, c2 = (i1 == 2) ? -1e30f : a2, c3 = (i1 == 3) ? -1e30f : a3;
    i2 = 0; float v2 = c0;
    if (c1 > v2) { v2 = c1; i2 = 1; }
    if (c2 > v2) { v2 = c2; i2 = 2; }
    if (c3 > v2) { v2 = c3; i2 = 3; }
    sum = v1 + v2;
}
__device__ __forceinline__ void route_row(Frame& F, int l, int row, const f32x4 (&v)[4], int b, LAS float* rw  ) {
    float s2 = 0.f;
#pragma unroll
    for (int j = 0; j < 4; ++j) s2 += (v[j].x * v[j].x + v[j].y * v[j].y) + (v[j].z * v[j].z + v[j].w * v[j].w);
    const float rstd = 1.f / sqrtf(wave_sum(s2) * (1.f / D) + EPS);
    const float* g = F.in[7] + l * D; const float* sh = modv(F, l, b, 3); const float* sc = modv(F, l, b, 4);
    unsigned long long* o8 = (unsigned long long*)((bf16*)(F.ws + WS_H) + (size_t)row * D) + F.lane;
    LAS float* hl = rw + D * NE + F.wave * D;
#pragma unroll
    for (int j = 0; j < 4; ++j) { const int c = 4 * F.lane + 256 * j;
        const f32x4 gv = *(const f32x4*)(g + c), shv = *(const f32x4*)(sh + c), scv = *(const f32x4*)(sc + c);
        const f32x4 h = v[j] * rstd * gv * (scv + 1.f) + shv;
        o8[64 * j] = (unsigned long long)pk2(h.x, h.y) | ((unsigned long long)pk2(h.z, h.w) << 32);
        *(LAS f32x4*)(hl + c) = h; }
    LDS_WAIT(); asm volatile("" ::: "memory");
    float part = 0.f;
    { const int e = F.lane & 15, k0 = (F.lane >> 4) * 256;
#pragma unroll 8
      for (int k = 0; k < 256; ++k) part += hl[k0 + k] * rw[(k0 + k) * 16 + e]; }
    part += __shfl_xor(part, 16); part += __shfl_xor(part, 32);
    LDS_WAIT(); asm volatile("" ::: "memory");
    float s[16], sel[16];
#pragma unroll
    for (int e = 0; e < 16; ++e) { s[e] = sigmoidf_(__shfl(part, e)); sel[e] = s[e] + F.in[18][e]; }
    int i1a, i2a, i1b, i2b, i1c, i2c, i1d, i2d; float gsa, gsb, gsc, gsd;
    top2_of4(sel[0], sel[1], sel[2], sel[3], i1a, i2a, gsa); top2_of4(sel[4], sel[5], sel[6], sel[7], i1b, i2b, gsb);
    top2_of4(sel[8], sel[9], sel[10], sel[11], i1c, i2c, gsc); top2_of4(sel[12], sel[13], sel[14], sel[15], i1d, i2d, gsd);
    int bpk = i1a | (i2a << 2); float bestv = gsa;
    { const bool c = gsb > bestv; bestv = c ? gsb : bestv; bpk = c ? (i1b | (i2b << 2) | 16) : bpk; }
    { const bool c = gsc > bestv; bestv = c ? gsc : bestv; bpk = c ? (i1c | (i2c << 2) | 32) : bpk; }
    { const bool c = gsd > bestv; bestv = c ? gsd : bestv; bpk = c ? (i1d | (i2d << 2) | 48) : bpk; }
    const int e1 = (bpk >> 4) * 4 + (bpk & 3), e2 = (bpk >> 4) * 4 + ((bpk >> 2) & 3);
    float s1 = 0.f, s2v = 0.f;
#pragma unroll
    for (int e = 0; e < 16; ++e) { s1 = (e == e1) ? s[e] : s1; s2v = (e == e2) ? s[e] : s2v; }
    const float inv = 1.f / (s1 + s2v);
    if (F.lane == 0) {
        unsigned* cnt = (unsigned*)(F.ctl + CW_CNT + 64 * l); unsigned* list = (unsigned*)(F.ws + WS_LIST);
        unsigned* slote = (unsigned*)(F.ws + WS_SLOTE); float* slotw = (float*)(F.ws + WS_SLOTW);
        const unsigned p1 = atomicAdd(cnt + e1, 1u); list[(size_t)e1 * LIST_CAP + p1] = (unsigned)row * 2u;
        const unsigned p2 = atomicAdd(cnt + e2, 1u); list[(size_t)e2 * LIST_CAP + p2] = (unsigned)row * 2u + 1u;
        slote[row * 2] = (unsigned)e1 | (p1 << 8); slote[row * 2 + 1] = (unsigned)e2 | (p2 << 8);
        slotw[row * 2] = s1 * inv; slotw[row * 2 + 1] = s2v * inv;
    }
}
__device__ __forceinline__ void p_route(Frame& F, int l) {
    LAS float* rw = (LAS float*)F.lds;
    for (int i = F.tid; i < D * NE / 4; i += NTHR) ((LAS f32x4*)rw)[i] = ((const f32x4*)F.in[17])[i];
    __syncthreads();
    const int gw = F.bid * NWAVES + F.wave, NGW = F.G * NWAVES;
    const int nrows = (l == 0 && CTX_FULL) ? M_ALL : M_LAT;
    for (int row = gw; row < nrows; row += NGW) {
        const bool isctx = row >= M_LAT; const int b = isctx ? 4 : row / SEQ;
        const float* xr = isctx ? (const float*)(F.ws + WS_XC) + (size_t)(row - M_LAT) * D : F.out + (size_t)row * D;
        f32x4 v[4];
#pragma unroll
        for (int j = 0; j < 4; ++j) v[j] = ((const f32x4*)xr)[F.lane + 64 * j];
        route_row(F, l, row, v, b, rw);
    }
    __syncthreads();
}
__device__ __forceinline__ void moe_prefix(Frame& F, int l) {
    if (F.tid == 0) { unsigned acc = 0;
        for (int e = 0; e < 16; ++e) { const unsigned c = __hip_atomic_load((unsigned*)(F.ctl + CW_CNT + 64 * l + e), RLX_AGENT); F.MISC[32 + e] = acc; F.MISC[32 + 17 + e] = c; acc += (c + 255u) >> 8; }
        F.MISC[32 + 16] = acc; }
    __syncthreads();
}
__device__ __forceinline__ void combine_row(Frame& F, int l, int row, int b, const volatile LAS unsigned* tb, f32x4 (&v)[4]) {
    const unsigned se0 = ((const unsigned*)(F.ws + WS_SLOTE))[row * 2], se1 = ((const unsigned*)(F.ws + WS_SLOTE))[row * 2 + 1];
    const float w0 = ((const float*)(F.ws + WS_SLOTW))[row * 2], w1 = ((const float*)(F.ws + WS_SLOTW))[row * 2 + 1];
    const size_t p0 = (size_t)tb[se0 & 255u] * 256 + (se0 >> 8), p1 = (size_t)tb[se1 & 255u] * 256 + (se1 >> 8);
    const bf16* Y2 = (const bf16*)(F.ws + WS_Y2);
    const v2u* y0 = (const v2u*)(Y2 + p0 * D) + F.lane; const v2u* y1 = (const v2u*)(Y2 + p1 * D) + F.lane;
    const float* g2 = modv(F, l, b, 5);
#pragma unroll
    for (int j = 0; j < 4; ++j) { const v2u a = y0[64 * j], c = y1[64 * j]; const f32x4 gv = *(const f32x4*)(g2 + 4 * F.lane + 256 * j);
        f32x4 ff; ff.x = w0 * bflo(a.x) + w1 * bflo(c.x); ff.y = w0 * bfhi(a.x) + w1 * bfhi(c.x); ff.z = w0 * bflo(a.y) + w1 * bflo(c.y); ff.w = w0 * bfhi(a.y) + w1 * bfhi(c.y);
        v[j] = v[j] + gv * ff; }
}
__device__ __forceinline__ void p9_combine_mod(Frame& F) {
    moe_prefix(F, 0);
    const volatile LAS unsigned* tb = F.MISC + 32;
    const int gw = F.bid * NWAVES + F.wave, NGW = F.G * NWAVES;
    const int nrows = CTX_FULL ? M_ALL : M_LAT;
    for (int row = gw; row < nrows; row += NGW) {
        const bool isctx = row >= M_LAT; const int b = isctx ? 4 : row / SEQ;
        float* xr = isctx ? (float*)(F.ws + WS_XC) + (size_t)(row - M_LAT) * D : F.out + (size_t)row * D;
        f32x4 v[4];
#pragma unroll
        for (int j = 0; j < 4; ++j) v[j] = ((const f32x4*)xr)[F.lane + 64 * j];
        combine_row(F, 0, row, b, tb, v);
#pragma unroll
        for (int j = 0; j < 4; ++j) ((f32x4*)xr)[F.lane + 64 * j] = v[j];
        if (!isctx) modulate_row(v, F.in[6] + D, modv(F, 1, b, 0), modv(F, 1, b, 1), (bf16*)(F.ws + WS_H) + (size_t)row * D, F.lane);
    }
}
__device__ __forceinline__ void p11_pool_naive(Frame& F) {
    const bf16* U = (const bf16*)(F.ws + WS_U); bf16* DP = (bf16*)(F.ws + WS_DP);
    const long total = (long)M_LAT * 128;
    for (long idx = (long)F.bid * NTHR + F.tid; idx < total; idx += (long)F.G * NTHR) {
        const int tok = (int)(idx >> 7), ch8 = (int)(idx & 127), b = tok / SEQ, t = tok % SEQ, r = t / GRIDW, c = t % GRIDW;
        const int g = ch8 >> 5, win = 2 << g, half = win >> 1;
        const int rlo = max(r - half, 0), rhi = min(r - half + win, GRIDW), clo = max(c - half, 0), chi = min(c - half + win, GRIDW);
        float acc[8];
#pragma unroll
        for (int j = 0; j < 8; ++j) acc[j] = 0.f;
        for (int rr = rlo; rr < rhi; ++rr)
            for (int cc = clo; cc < chi; ++cc) { const v4u w = *(const v4u*)(U + (size_t)(b * SEQ + rr * GRIDW + cc) * D + ch8 * 8);
#pragma unroll
                for (int q = 0; q < 4; ++q) { acc[2 * q] += bflo(w[q]); acc[2 * q + 1] += bfhi(w[q]); } }
        const float inv = 1.f / (float)((rhi - rlo) * (chi - clo));
        const v4u w = *(const v4u*)(U + (size_t)tok * D + ch8 * 8);
        v4u o;
#pragma unroll
        for (int q = 0; q < 4; ++q) o[q] = pk2(acc[2 * q] * inv - bflo(w[q]), acc[2 * q + 1] * inv - bfhi(w[q]));
        *(v4u*)(DP + ((size_t)g * M_LAT + tok) * 256 + (ch8 & 31) * 8) = o;
    }
}
__device__ __forceinline__ void p17_final(Frame& F) {
    moe_prefix(F, 1);
    const volatile LAS unsigned* tb = F.MISC + 32;
    const int gw = F.bid * NWAVES + F.wave, NGW = F.G * NWAVES;
    for (int row = gw; row < M_LAT; row += NGW) {
        float* xr = F.out + (size_t)row * D;
        f32x4 v[4];
#pragma unroll
        for (int j = 0; j < 4; ++j) v[j] = ((const f32x4*)xr)[F.lane + 64 * j];
        combine_row(F, 1, row, row / SEQ, tb, v);
        float s2 = 0.f;
#pragma unroll
        for (int j = 0; j < 4; ++j) s2 += (v[j].x * v[j].x + v[j].y * v[j].y) + (v[j].z * v[j].z + v[j].w * v[j].w);
        const float rstd = 1.f / sqrtf(wave_sum(s2) * (1.f / D) + EPS);
#pragma unroll
        for (int j = 0; j < 4; ++j) { const f32x4 gv = *(const f32x4*)(F.in[22] + 4 * F.lane + 256 * j); ((f32x4*)xr)[F.lane + 64 * j] = v[j] * rstd * gv; }
    }
}

struct Args { const float* in[23]; float* out; unsigned char* ws; int ph_lo, ph_hi; };
#define GEMM_CORE gemm_naive

__global__ void __launch_bounds__(NTHR, 2) fwd_kernel(Args args) {
    extern __shared__ __attribute__((aligned(16))) unsigned char lds[];
    Frame F;
    F.lds = (LAS unsigned char*)lds; F.MISC = (volatile LAS unsigned*)(F.lds + MISC_OFF);
    F.tid = threadIdx.x; F.lane = F.tid & 63; F.wave = __builtin_amdgcn_readfirstlane(F.tid >> 6);
    F.G = gridDim.x; F.bid = blockIdx.x;
#pragma unroll
    for (int i = 0; i < 23; ++i) F.in[i] = args.in[i];
    F.out = args.out; F.ws = args.ws; F.ctl = (gu32*)(args.ws + WS_CTL);
    for (int u = F.tid; u < (LDS_BYTES - LDSCTL_OFF) / 4; u += NTHR) ((LAS unsigned*)(F.lds + LDSCTL_OFF))[u] = 0u;
    __syncthreads();
    XcdBarrier bar; bar.bar = (unsigned*)(F.ctl + CW_BAR); bar.x = 0; bar.st = nullptr;
    if (MK_ONE_LAUNCH) bar = xcd_barrier_post((unsigned*)(F.ctl + CW_BAR), F.MISC + 8);
    const int lo = args.ph_lo, hi = args.ph_hi;
#ifndef PHMASK
#define PHMASK 0x3ffff
#endif
#define IN(k) (((PHMASK >> (k)) & 1) && lo <= (k) && (k) < hi)
#define SEAM(k) do { if (IN(k) && IN((k) + 1)) xcd_barrier(bar); } while (0)
    bf16* const PL = (bf16*)(F.ws + WS_PL);

    if (IN(0)) { p0_prep(F); } SEAM(0);
    if (IN(1)) { p1_modulate0(F); } SEAM(1);
    if (IN(2)) {
        Gemm g{(const bf16*)(F.ws + WS_H), (const bf16*)(F.ws + WS_WHGIN), D}; StaticOrder S; S.init(M_ALL, NPROJ * D, F.G, F.bid);
        EpiInProj E{PL}; GEMM_CORE<EpiInProj, StaticOrder>(g, S, E); } SEAM(2);
    if (IN(3)) { p3_scan_naive(F); } SEAM(3);
    if (IN(4)) { p4_readout_prep(F); } SEAM(4);
    if (IN(5)) {
        Gemm g{(const bf16*)(F.ws + WS_H), (const bf16*)(F.ws + WS_WHGOUT), D}; StaticOrder S; S.init(CTX_FULL ? M_ALL : M_LAT, D, F.G, F.bid);
        EpiResid E{F.in[0], F.in[2], F.out, (float*)(F.ws + WS_XC), modv(F, 0, 0, 2)}; GEMM_CORE<EpiResid, StaticOrder>(g, S, E); } SEAM(5);
    if (IN(6)) { p_route(F, 0); } SEAM(6);
    if (IN(7)) { moe_prefix(F, 0);
        Gemm g{(const bf16*)(F.ws + WS_H), (const bf16*)(F.ws + WS_WGU0), D}; MoeOrder S{F.G, F.bid, 2, 1, F.MISC + 32, (const unsigned*)(F.ws + WS_LIST)};
        EpiGateUp E{(bf16*)(F.ws + WS_ACT)}; GEMM_CORE<EpiGateUp, MoeOrder>(g, S, E); } SEAM(7);
    if (IN(8)) { moe_prefix(F, 0);
        Gemm g{(const bf16*)(F.ws + WS_ACT), (const bf16*)(F.ws + WS_WD0), DE}; MoeOrder S{F.G, F.bid, 4, 0, F.MISC + 32, (const unsigned*)(F.ws + WS_LIST)};
        EpiDown E{(bf16*)(F.ws + WS_Y2)}; GEMM_CORE<EpiDown, MoeOrder>(g, S, E); } SEAM(8);
    if (IN(9)) { p9_combine_mod(F); } SEAM(9);
    if (IN(10)) {
        Gemm g{(const bf16*)(F.ws + WS_H), (const bf16*)(F.ws + WS_WPIN), D}; StaticOrder S; S.init(M_LAT, D, F.G, F.bid);
        EpiBf16Plain E{(bf16*)(F.ws + WS_U), D}; GEMM_CORE<EpiBf16Plain, StaticOrder>(g, S, E); } SEAM(10);
    if (IN(11)) { p11_pool_naive(F); } SEAM(11);
    if (IN(12)) {
        Gemm g{(const bf16*)(F.ws + WS_DP), (const bf16*)(F.ws + WS_WGRP), 256}; GroupOrder S{F.G, F.bid};
        EpiGrp E{(bf16*)(F.ws + WS_E), F.in[15]}; GEMM_CORE<EpiGrp, GroupOrder>(g, S, E); } SEAM(12);
    if (IN(13)) {
        Gemm g{(const bf16*)(F.ws + WS_E), (const bf16*)(F.ws + WS_WPOUT), D}; StaticOrder S; S.init(M_LAT, D, F.G, F.bid);
        EpiResid E{F.out, nullptr, F.out, nullptr, modv(F, 1, 0, 2)}; GEMM_CORE<EpiResid, StaticOrder>(g, S, E); } SEAM(13);
    if (IN(14)) { p_route(F, 1); } SEAM(14);
    if (IN(15)) { moe_prefix(F, 1);
        Gemm g{(const bf16*)(F.ws + WS_H), (const bf16*)(F.ws + WS_WGU1), D}; MoeOrder S{F.G, F.bid, 2, 1, F.MISC + 32, (const unsigned*)(F.ws + WS_LIST)};
        EpiGateUp E{(bf16*)(F.ws + WS_ACT)}; GEMM_CORE<EpiGateUp, MoeOrder>(g, S, E); } SEAM(15);
    if (IN(16)) { moe_prefix(F, 1);
        Gemm g{(const bf16*)(F.ws + WS_ACT), (const bf16*)(F.ws + WS_WD1), DE}; MoeOrder S{F.G, F.bid, 4, 0, F.MISC + 32, (const unsigned*)(F.ws + WS_LIST)};
        EpiDown E{(bf16*)(F.ws + WS_Y2)}; GEMM_CORE<EpiDown, MoeOrder>(g, S, E); } SEAM(16);
    if (IN(17)) { p17_final(F); }
#undef IN
#undef SEAM
}

extern "C" void kernel_launch(void* const* d_in, const int* in_sizes, int n_in, void* d_out, int out_size, void* d_ws, size_t ws_size, hipStream_t stream) {
    static int grid = 0;
    if (grid == 0) {
        if (n_in != 23 || in_sizes[0] != M_LAT * D || out_size != M_LAT * D || ws_size < WS_END) { fprintf(stderr, "kernel_launch: unexpected shapes (n_in %d, in0 %d, out %d, ws %zu); nothing launched\n", n_in, n_in > 0 ? in_sizes[0] : -1, out_size, ws_size); grid = -1; return; }
        int dev = 0, cus = 0, per_cu = 0;
        if (hipGetDevice(&dev) != hipSuccess || hipDeviceGetAttribute(&cus, hipDeviceAttributeMultiprocessorCount, dev) != hipSuccess) { grid = -1; return; }
        if (hipFuncSetAttribute((const void*)fwd_kernel, hipFuncAttributeMaxDynamicSharedMemorySize, LDS_BYTES) != hipSuccess) { fprintf(stderr, "kernel_launch: hipFuncSetAttribute failed\n"); grid = -1; return; }
        if (hipOccupancyMaxActiveBlocksPerMultiprocessor(&per_cu, (const void*)fwd_kernel, NTHR, LDS_BYTES) != hipSuccess || per_cu < 1) { fprintf(stderr, "kernel_launch: occupancy query says %d blocks per CU\n", per_cu); per_cu = 1; }
        (void)hipGetLastError();
        grid = cus;
    }
    if (grid < 0) return;
    if (hipMemsetAsync((char*)d_ws + WS_CTL, 0, CTL_ZERO_BYTES, stream) != hipSuccess) return;
    Args a{};
    for (int i = 0; i < 23; ++i) a.in[i] = (const float*)d_in[i];
    a.out = (float*)d_out; a.ws = (unsigned char*)d_ws;
    if (MK_ONE_LAUNCH) { a.ph_lo = 0; a.ph_hi = NPHASE; hipLaunchKernelGGL(fwd_kernel, dim3(grid), dim3(NTHR), LDS_BYTES, stream, a); }
    else for (int p = 0; p < NPHASE; ++p) { a.ph_lo = p; a.ph_hi = p + 1; hipLaunchKernelGGL(fwd_kernel, dim3(grid), dim3(NTHR), LDS_BYTES, stream, a); }
}
```

```cpp
#include <hip/hip_runtime.h>
#include <cstdio>
#include <cstdint>

#ifndef MK_ONE_LAUNCH
#define MK_ONE_LAUNCH 1
#endif
#ifndef CTX_FULL
#define CTX_FULL 1
#endif

constexpr int D = 1024, NB = 4, SEQ = 4096, CTXL = 256;
constexpr int M_LAT = NB * SEQ, M_CTX = NB * CTXL, M_ALL = M_LAT + M_CTX;
constexpr int NH = 8, DH = 128, NPROJ = 5;
constexpr int NE = 16, DE = 256, NGRP = 4, EPG = 4;
constexpr int GRIDW = 64;
constexpr float EPS = 1e-6f;
constexpr int NWAVES = 8, NTHR = 512;
constexpr int NPHASE = 18;

constexpr size_t MiB = 1u << 20;
constexpr size_t WS_CTL = 0, CTL_ZERO_BYTES = 1 * MiB;
constexpr size_t WS_MODV = 1 * MiB;
constexpr size_t WS_LIST = 2 * MiB;
constexpr size_t WS_SLOTE = 2 * MiB + 1280 * 1024;
constexpr size_t WS_SLOTW = 2 * MiB + 1536 * 1024;
constexpr size_t WS_WHGIN = 4 * MiB;
constexpr size_t WS_WHGOUT = 14 * MiB;
constexpr size_t WS_WGU0 = 16 * MiB;
constexpr size_t WS_WD0 = 32 * MiB;
constexpr size_t WS_XC = 40 * MiB;
constexpr size_t WS_H = 44 * MiB;
constexpr size_t WS_PL = 78 * MiB;
constexpr size_t PLANE = (size_t)M_ALL * D * 2;
constexpr size_t WS_OFC = 248 * MiB, WS_OBC = 250 * MiB;
constexpr size_t WS_WPIN = 78 * MiB, WS_WGRP = 80 * MiB, WS_WPOUT = 81 * MiB;
constexpr size_t WS_WGU1 = 83 * MiB, WS_WD1 = 99 * MiB;
constexpr size_t WS_ACT = 108 * MiB;
constexpr size_t WS_Y2 = 128 * MiB;
constexpr size_t WS_U = 204 * MiB;
constexpr size_t WS_DP = 108 * MiB;
constexpr size_t WS_E = 140 * MiB;
constexpr size_t WS_END = 256 * MiB;
static_assert(WS_PL + 5 * PLANE <= WS_OFC && WS_H + PLANE <= WS_PL && WS_Y2 + (size_t)38912 * 2048 <= WS_U && WS_U + (size_t)M_LAT * 2048 <= WS_OFC, "ws map");
static_assert(WS_ACT + (size_t)38912 * 512 <= WS_Y2 && WS_DP + (size_t)M_LAT * 2048 <= WS_E && WS_E + (size_t)M_LAT * 2048 <= WS_U && WS_WD1 + 8 * MiB <= WS_ACT, "ws map 2");
constexpr int CW_BAR = 4096;
constexpr int CW_CNT = 8192;
constexpr int LIST_CAP = M_ALL;

constexpr int RING_BYTES = 131072;
constexpr int LDSCTL_OFF = RING_BYTES, MISC_OFF = LDSCTL_OFF + 320;
constexpr int LDS_BYTES = 147456;

#define GAS __attribute__((address_space(1)))
#define LAS __attribute__((address_space(3)))
typedef unsigned short bf16;
typedef unsigned v4u __attribute__((ext_vector_type(4)));
typedef unsigned v2u __attribute__((ext_vector_type(2)));
typedef float f32x4 __attribute__((ext_vector_type(4)));
typedef short bf16x8 __attribute__((ext_vector_type(8)));
typedef GAS unsigned gu32;
#define RLX_AGENT __ATOMIC_RELAXED, __HIP_MEMORY_SCOPE_AGENT
#define LDS_WAIT() asm volatile("s_waitcnt lgkmcnt(0)" ::: "memory")
#define VM_WAIT() asm volatile("s_waitcnt vmcnt(0)" ::: "memory")

__device__ __forceinline__ unsigned f2bf(float f) { unsigned u = __builtin_bit_cast(unsigned, f); return (u + 0x7fffu + ((u >> 16) & 1u)) >> 16; }
__device__ __forceinline__ unsigned pk2(float lo, float hi) { return f2bf(lo) | (f2bf(hi) << 16); }
__device__ __forceinline__ float bf2f(unsigned b) { return __builtin_bit_cast(float, b << 16); }
__device__ __forceinline__ float bflo(unsigned w) { return __builtin_bit_cast(float, w << 16); }
__device__ __forceinline__ float bfhi(unsigned w) { return __builtin_bit_cast(float, w & 0xffff0000u); }
__device__ __forceinline__ float sigmoidf_(float x) { return 1.f / (1.f + __expf(-x)); }
__device__ __forceinline__ float siluf_(float x) { return x / (1.f + __expf(-x)); }
__device__ __forceinline__ float wave_sum(float v) {
#pragma unroll
    for (int o = 1; o < 64; o <<= 1) v += __shfl_xor(v, o);
    return v;
}

#define XB_TMO      128
#define XB_XCNT(j)  (256  + 64 * (j))
#define XB_XSUB(j)  (1280 + 64 * (j))
#define XB_XGEN(j)  (2304 + 64 * (j))
#define XB_TOP      3328
#define XB_TOPGEN   3392
#define XCD_BAR_WORDS 3456
#define XB_SPIN_CAP (1u << 18)
__device__ __forceinline__ unsigned xb_ld(unsigned* p)              { return __hip_atomic_load(p, __ATOMIC_RELAXED, __HIP_MEMORY_SCOPE_AGENT); }
__device__ __forceinline__ unsigned xb_add(unsigned* p, unsigned v) { return __hip_atomic_fetch_add(p, v, __ATOMIC_RELAXED, __HIP_MEMORY_SCOPE_AGENT); }
__device__ __forceinline__ unsigned xb_xcc_id() { return (unsigned)__builtin_amdgcn_s_getreg((3 << 11) | 20) & 0xFu; }
#define XB_SPIN(cond, bar) do { unsigned _sp = 0; while (cond) { __builtin_amdgcn_s_sleep(1); \
    if ((++_sp & 255u) == 0u) { if (xb_ld(&(bar)[XB_TMO])) break; if (_sp > XB_SPIN_CAP) { atomicAdd(&(bar)[XB_TMO], 1u); break; } } } } while (0)
struct XcdBarrier { unsigned* bar; unsigned x; volatile LAS unsigned* st; };
__device__ __forceinline__ XcdBarrier xcd_barrier_post(unsigned* bar, volatile LAS unsigned* st) {
    XcdBarrier b; b.bar = bar; b.x = xb_xcc_id(); b.st = st;
    if (threadIdx.x == 0) (void)xb_add(&bar[XB_XCNT(b.x)], 1u);
    return b;
}
__device__ __forceinline__ void xcd_barrier_complete(unsigned* bar, unsigned x, unsigned& nloc, unsigned& nx) {
    const unsigned G = gridDim.x * gridDim.y * gridDim.z;
    unsigned sum, cnt, mine, sp = 0u;
    for (;;) {
        sum = 0u; cnt = 0u; mine = 0u;
#pragma unroll
        for (unsigned j = 0; j < 16; ++j) { const unsigned c = xb_ld(&bar[XB_XCNT(j)]); sum += c; cnt += (c > 0u) ? 1u : 0u; mine = (j == x) ? c : mine; }
        if (sum == G) break;
        __builtin_amdgcn_s_sleep(1);
        if ((++sp & 255u) == 0u) { if (xb_ld(&bar[XB_TMO])) break; if (sp > XB_SPIN_CAP) { atomicAdd(&bar[XB_TMO], 1u); break; } }
    }
    nloc = mine > 0u ? mine : 1u; nx = cnt > 0u ? cnt : 1u;
}
__device__ __forceinline__ void xcd_barrier(const XcdBarrier& b) {
    asm volatile("s_waitcnt vmcnt(0)" ::: "memory");
    __syncthreads();
    if (threadIdx.x == 0) {
        unsigned* bar = b.bar;
        __builtin_amdgcn_s_waitcnt(0);
        unsigned nloc = b.st[0], nx = b.st[1];
        if (nloc == 0u) { xcd_barrier_complete(bar, b.x, nloc, nx); b.st[0] = nloc; b.st[1] = nx; }
        const unsigned old = xb_add(&bar[XB_XSUB(b.x)], 1u);
        const unsigned gen = old / nloc;
        if (old + 1u == (gen + 1u) * nloc) {
            __builtin_amdgcn_fence(__ATOMIC_RELEASE, "agent");
            asm volatile("s_waitcnt vmcnt(0)" ::: "memory");
            const unsigned og = xb_add(&bar[XB_TOP], 1u);
            const unsigned tg = og / nx;
            if (og + 1u == (tg + 1u) * nx) xb_add(&bar[XB_TOPGEN], 1u);
            else XB_SPIN(xb_ld(&bar[XB_TOPGEN]) == tg, bar);
            __builtin_amdgcn_fence(__ATOMIC_ACQUIRE, "agent");
            xb_add(&bar[XB_XGEN(b.x)], 1u);
            asm volatile("s_waitcnt vmcnt(0)" ::: "memory");
        } else {
            XB_SPIN(xb_ld(&bar[XB_XGEN(b.x)]) == gen, bar);
            __builtin_amdgcn_fence(__ATOMIC_ACQUIRE, "agent");
            asm volatile("s_waitcnt vmcnt(0)" ::: "memory");
        }
    }
    __syncthreads();
}

struct Unit { int pm, pn; };
struct Gemm { const bf16* A; const bf16* Bt; int K; };
constexpr int NXCD = 8, WGM = 8, BM = 256;

struct StaticOrder {
    int nM, nN, nwg, G, c;
    __device__ __forceinline__ void init(int M, int N, int G_, int c_) { nM = M / BM; nN = N / BM; nwg = nM * nN; G = G_; c = c_; }
    __device__ __forceinline__ bool next(int i, Unit& u) const {
        const long L = (long)i * G + c; if (L >= nwg) return false;
        int wgid = (int)L; { const int q = nwg / NXCD, r = nwg % NXCD, xcd = wgid % NXCD, off = wgid / NXCD; wgid = (xcd < r ? xcd * (q + 1) : r * (q + 1) + (xcd - r) * q) + off; }
        const int nig = WGM * nN, gid = wgid / nig, fm = gid * WGM, gsz = (nM - fm) < WGM ? (nM - fm) : WGM;
        u.pm = fm + ((wgid % nig) % gsz); u.pn = (wgid % nig) / gsz; return true;
    }
    __device__ __forceinline__ int a_row(const Unit& u, int r) const { return u.pm * BM + r; }
};
struct GroupOrder {
    int G, c;
    __device__ __forceinline__ bool next(int i, Unit& u) const { const int L = i * G + c; if (L >= 256) return false; u.pm = L; u.pn = L >> 6; return true; }
    __device__ __forceinline__ int a_row(const Unit& u, int r) const { return u.pm * BM + r; }
};
struct MoeOrder {
    int G, c, npn, gather; const volatile LAS unsigned* tb; const unsigned* list;
    __device__ __forceinline__ bool next(int i, Unit& u) const {
        const int L = i * G + c; const int nt = (int)tb[16];
        if (L >= nt * npn) return false;
        const int t = L / npn, nl = L % npn; int e = 0;
#pragma unroll
        for (int j = 1; j < 16; ++j) e += (t >= (int)tb[j]) ? 1 : 0;
        u.pm = t; u.pn = e * npn + nl; return true;
    }
    __device__ __forceinline__ int a_row(const Unit& u, int r) const {
        if (!gather) return u.pm * BM + r;
        const int e = u.pn / npn; const int idx = (u.pm - (int)tb[e]) * BM + r;
        const unsigned ent = (idx < (int)tb[17 + e]) ? list[(size_t)e * LIST_CAP + idx] : 0u;
        return (int)(ent >> 1);
    }
};

template <class Epi, class Sched>
__device__ __forceinline__ void gemm_naive(const Gemm g, const Sched& S, const Epi& E) {
    const int tid = threadIdx.x, wid = tid >> 6, lane = tid & 63, wr = wid >> 2, wc = wid & 3, fr = lane & 15, fq = lane >> 4;
    const int K = g.K;
    Unit u;
    for (int i = 0; S.next(i, u); ++i) {
        f32x4 acc[2][2][4][2];
#pragma unroll
        for (int ai = 0; ai < 2; ++ai)
#pragma unroll
            for (int m = 0; m < 4; ++m) {
                const bf16* ar = g.A + (size_t)S.a_row(u, 128 * ai + 64 * wr + 16 * m + fr) * K;
#pragma unroll
                for (int bj = 0; bj < 2; ++bj)
#pragma unroll
                    for (int n = 0; n < 2; ++n) {
                        const int c0 = 128 * bj + 32 * wc + (Epi::PERM ? 8 * fq + 4 * n : 16 * n + 4 * fq);
                        const bf16* br = g.Bt + (size_t)(u.pn * BM + c0) * K;
                        f32x4 a0 = {0.f, 0.f, 0.f, 0.f};
#pragma unroll 1
                        for (int k = 0; k < K; k += 8) {
                            const v4u b0 = *(const v4u*)(br + k), b1 = *(const v4u*)(br + (size_t)K + k), b2 = *(const v4u*)(br + (size_t)2 * K + k), b3 = *(const v4u*)(br + (size_t)3 * K + k);
                            const v4u x0 = *(const v4u*)(ar + k);
#pragma unroll
                            for (int q = 0; q < 4; ++q) {
                                const f32x4 blo = {bflo(b0[q]), bflo(b1[q]), bflo(b2[q]), bflo(b3[q])}, bhi = {bfhi(b0[q]), bfhi(b1[q]), bfhi(b2[q]), bfhi(b3[q])};
                                a0 += blo * bflo(x0[q]) + bhi * bfhi(x0[q]);
                            }
                        }
                        asm volatile("" : "+v"(a0));
                        acc[ai][bj][m][n] = a0;
                    }
            }
        E(acc, u, wr, wc, fr, fq);
    }
}

struct EpiInProj {
    static constexpr bool PERM = true;
    bf16* PL;
    __device__ __forceinline__ void operator()(const f32x4 (&acc)[2][2][4][2], const Unit& u, int wr, int wc, int fr, int fq) const {
        const int p = u.pn >> 2; const bool act = (p == 0) || (p == 4);
        bf16* base = PL + (size_t)p * ((size_t)M_ALL * D);
        const int col0 = (u.pn & 3) * BM + wc * 32 + 8 * fq, row0 = u.pm * BM + wr * 64 + fr;
#pragma unroll
        for (int ai = 0; ai < 2; ++ai)
#pragma unroll
            for (int m = 0; m < 4; ++m) { bf16* rowp = base + (size_t)(row0 + ai * 128 + m * 16) * D + col0;
#pragma unroll
                for (int bj = 0; bj < 2; ++bj) { f32x4 v0 = acc[ai][bj][m][0], v1 = acc[ai][bj][m][1];
                    if (act) {
#pragma unroll
                        for (int j = 0; j < 4; ++j) { v0[j] = siluf_(v0[j]); v1[j] = siluf_(v1[j]); } }
                    v4u w; w.x = pk2(v0[0], v0[1]); w.y = pk2(v0[2], v0[3]); w.z = pk2(v1[0], v1[1]); w.w = pk2(v1[2], v1[3]);
                    *(v4u*)(rowp + bj * 128) = w; } }
    }
};
struct EpiBf16Plain {
    static constexpr bool PERM = true;
    bf16* O; int ldc;
    __device__ __forceinline__ void operator()(const f32x4 (&acc)[2][2][4][2], const Unit& u, int wr, int wc, int fr, int fq) const {
        const int col0 = u.pn * BM + wc * 32 + 8 * fq, row0 = u.pm * BM + wr * 64 + fr;
#pragma unroll
        for (int ai = 0; ai < 2; ++ai)
#pragma unroll
            for (int m = 0; m < 4; ++m) { bf16* rowp = O + (size_t)(row0 + ai * 128 + m * 16) * ldc + col0;
#pragma unroll
                for (int bj = 0; bj < 2; ++bj) { const f32x4 v0 = acc[ai][bj][m][0], v1 = acc[ai][bj][m][1];
                    v4u w; w.x = pk2(v0[0], v0[1]); w.y = pk2(v0[2], v0[3]); w.z = pk2(v1[0], v1[1]); w.w = pk2(v1[2], v1[3]);
                    *(v4u*)(rowp + bj * 128) = w; } }
    }
};
struct EpiDown {
    static constexpr bool PERM = true;
    bf16* O;
    __device__ __forceinline__ void operator()(const f32x4 (&acc)[2][2][4][2], const Unit& u, int wr, int wc, int fr, int fq) const {
        const int col0 = (u.pn & 3) * BM + wc * 32 + 8 * fq, row0 = u.pm * BM + wr * 64 + fr;
#pragma unroll
        for (int ai = 0; ai < 2; ++ai)
#pragma unroll
            for (int m = 0; m < 4; ++m) { bf16* rowp = O + (size_t)(row0 + ai * 128 + m * 16) * D + col0;
#pragma unroll
                for (int bj = 0; bj < 2; ++bj) { const f32x4 v0 = acc[ai][bj][m][0], v1 = acc[ai][bj][m][1];
                    v4u w; w.x = pk2(v0[0], v0[1]); w.y = pk2(v0[2], v0[3]); w.z = pk2(v1[0], v1[1]); w.w = pk2(v1[2], v1[3]);
                    *(v4u*)(rowp + bj * 128) = w; } }
    }
};
struct EpiGateUp {
    static constexpr bool PERM = true;
    bf16* ACT;
    __device__ __forceinline__ void operator()(const f32x4 (&acc)[2][2][4][2], const Unit& u, int wr, int wc, int fr, int fq) const {
        const int col0 = (u.pn & 1) * 128 + wc * 32 + 8 * fq, row0 = u.pm * BM + wr * 64 + fr;
#pragma unroll
        for (int ai = 0; ai < 2; ++ai)
#pragma unroll
            for (int m = 0; m < 4; ++m) { bf16* rowp = ACT + (size_t)(row0 + ai * 128 + m * 16) * DE + col0;
                f32x4 v0, v1;
#pragma unroll
                for (int j = 0; j < 4; ++j) { v0[j] = siluf_(acc[ai][0][m][0][j]) * acc[ai][1][m][0][j]; v1[j] = siluf_(acc[ai][0][m][1][j]) * acc[ai][1][m][1][j]; }
                v4u w; w.x = pk2(v0[0], v0[1]); w.y = pk2(v0[2], v0[3]); w.z = pk2(v1[0], v1[1]); w.w = pk2(v1[2], v1[3]);
                *(v4u*)rowp = w; }
    }
};
struct EpiGrp {
    static constexpr bool PERM = true;
    bf16* O; const float* ps;
    __device__ __forceinline__ void operator()(const f32x4 (&acc)[2][2][4][2], const Unit& u, int wr, int wc, int fr, int fq) const {
        const int col0 = u.pn * BM + wc * 32 + 8 * fq, row0 = (u.pm & 63) * BM + wr * 64 + fr;
#pragma unroll
        for (int bj = 0; bj < 2; ++bj) {
            const f32x4 s0 = *(const f32x4*)(ps + col0 + bj * 128), s1 = *(const f32x4*)(ps + col0 + bj * 128 + 4);
#pragma unroll
            for (int ai = 0; ai < 2; ++ai)
#pragma unroll
                for (int m = 0; m < 4; ++m) { bf16* rowp = O + (size_t)(row0 + ai * 128 + m * 16) * D + col0 + bj * 128;
                    const f32x4 v0 = acc[ai][bj][m][0] * s0, v1 = acc[ai][bj][m][1] * s1;
                    v4u w; w.x = pk2(v0[0], v0[1]); w.y = pk2(v0[2], v0[3]); w.z = pk2(v1[0], v1[1]); w.w = pk2(v1[2], v1[3]);
                    *(v4u*)rowp = w; }
        }
    }
};
struct EpiResid {
    static constexpr bool PERM = false;
    const float* xin_lat; const float* xin_ctx; float* out_lat; float* out_ctx; const float* gate;
    __device__ __forceinline__ void operator()(const f32x4 (&acc)[2][2][4][2], const Unit& u, int wr, int wc, int fr, int fq) const {
        const int col0 = u.pn * BM + wc * 32 + 4 * fq, row0 = u.pm * BM + wr * 64 + fr;
        const bool isctx = row0 >= M_LAT;
        const int bidx = isctx ? 4 : (row0 / SEQ);
        const float* xin = isctx ? xin_ctx - (size_t)M_LAT * D : xin_lat; float* out = isctx ? out_ctx - (size_t)M_LAT * D : out_lat;
        const float* gp = gate + (size_t)bidx * 6144 + col0;
        f32x4 gv[2][2];
#pragma unroll
        for (int bj = 0; bj < 2; ++bj)
#pragma unroll
            for (int n = 0; n < 2; ++n) gv[bj][n] = *(const f32x4*)(gp + bj * 128 + n * 16);
#pragma unroll
        for (int ai = 0; ai < 2; ++ai)
#pragma unroll
            for (int m = 0; m < 4; ++m) { const size_t ro = (size_t)(row0 + ai * 128 + m * 16) * D + col0;
#pragma unroll
                for (int bj = 0; bj < 2; ++bj)
#pragma unroll
                    for (int n = 0; n < 2; ++n) { const f32x4 xv = *(const f32x4*)(xin + ro + bj * 128 + n * 16);
                        *(f32x4*)(out + ro + bj * 128 + n * 16) = xv + gv[bj][n] * acc[ai][bj][m][n]; } }
    }
};

struct Frame {
    LAS unsigned char* lds; volatile LAS unsigned* MISC; gu32* ctl;
    int tid, lane, wave, G, bid;
    const float* in[23]; float* out; unsigned char* ws;
};
__device__ __forceinline__ const float* modv(const Frame& F, int l, int b, int j) { return (const float*)(F.ws + WS_MODV) + ((size_t)l * 5 + b) * 6144 + j * 1024; }

__device__ __forceinline__ void transpose_item(const float* W, int N, int k0, int n0, bf16* WT, int KT, size_t dst_row0, LAS float* scr, int lane) {
#pragma unroll 8
    for (int i = 0; i < 32; ++i) { const int kk = 2 * i + (lane >> 5); scr[kk * 33 + (lane & 31)] = W[(size_t)(k0 + kk) * N + n0 + (lane & 31)]; }
    LDS_WAIT(); asm volatile("" ::: "memory");
    const int c = lane & 7;
#pragma unroll
    for (int j = 0; j < 4; ++j) { const int n = (lane >> 3) + 8 * j; const LAS float* s = scr + (8 * c) * 33 + n;
        v4u o; o.x = pk2(s[0 * 33], s[1 * 33]); o.y = pk2(s[2 * 33], s[3 * 33]); o.z = pk2(s[4 * 33], s[5 * 33]); o.w = pk2(s[6 * 33], s[7 * 33]);
        *(v4u*)(WT + (dst_row0 + n) * KT + k0 + 8 * c) = o; }
    LDS_WAIT(); asm volatile("" ::: "memory");
}
__device__ __forceinline__ void conv_moe_item(const Frame& F, int l, int r, bf16* WGU, bf16* WD, LAS float* scr) {
    const int kind = r >> 11, rr = r & 2047, e = rr >> 7, it = rr & 127;
    if (kind < 2) { const float* W = (kind ? F.in[20] : F.in[19]) + (size_t)(l * NE + e) * D * DE; const int kb = it >> 3, nb = it & 7, n0 = 32 * nb;
        transpose_item(W, DE, 64 * kb, n0, WGU, D, (size_t)e * 512 + (n0 >> 7) * 256 + kind * 128 + (n0 & 127), scr, F.lane); }
    else { const float* W = F.in[21] + (size_t)(l * NE + e) * DE * D; const int kb = it >> 5, nb = it & 31;
        transpose_item(W, D, 64 * kb, 32 * nb, WD, DE, (size_t)e * D + 32 * nb, scr, F.lane); }
}

__device__ __forceinline__ void p0_prep(Frame& F) {
    if (F.bid < 192) {
        LAS float* sil = (LAS float*)(F.lds);
        LAS float* red = (LAS float*)(F.lds + 32768);
        for (int i = F.tid; i < 5 * D; i += NTHR) { const float cv = (i < 4 * D) ? F.in[1][i] : F.in[3][i - 4 * D]; sil[i] = siluf_(cv); }
        __syncthreads();
        const int l = F.bid / 96, col0 = (F.bid % 96) * 64;
        const float* W = F.in[4] + (size_t)l * D * 6144 + col0 + F.lane;
        float a0 = 0.f, a1 = 0.f, a2 = 0.f, a3 = 0.f, a4 = 0.f;
        const int kbeg = F.wave * 128;
#pragma unroll 8
        for (int k = kbeg; k < kbeg + 128; ++k) { const float w = W[(size_t)k * 6144];
            a0 += sil[k] * w; a1 += sil[D + k] * w; a2 += sil[2 * D + k] * w; a3 += sil[3 * D + k] * w; a4 += sil[4 * D + k] * w; }
        red[(F.wave * 5 + 0) * 64 + F.lane] = a0; red[(F.wave * 5 + 1) * 64 + F.lane] = a1; red[(F.wave * 5 + 2) * 64 + F.lane] = a2;
        red[(F.wave * 5 + 3) * 64 + F.lane] = a3; red[(F.wave * 5 + 4) * 64 + F.lane] = a4;
        __syncthreads();
        if (F.tid < 320) { const int b = F.tid >> 6, cc = F.tid & 63; float s = 0.f;
#pragma unroll
            for (int w = 0; w < 8; ++w) s += red[(w * 5 + b) * 64 + cc];
            ((float*)(F.ws + WS_MODV))[((size_t)l * 5 + b) * 6144 + col0 + cc] = s + F.in[5][l * 6144 + col0 + cc]; }
        __syncthreads();
    }
    LAS float* scr = (LAS float*)(F.lds + F.wave * 16384);
    const int gw = F.bid * NWAVES + F.wave, NGW = F.G * NWAVES;
    constexpr int I_IN = 16 * 160, I_OUT = 16 * 32, I_MOE = 6144;
    for (int it = gw; it < I_IN + I_OUT + I_MOE; it += NGW) {
        int r = it;
        if (r < I_IN) { const int kb = r / 160, nb = r % 160; transpose_item(F.in[8], NPROJ * D, 64 * kb, 32 * nb, (bf16*)(F.ws + WS_WHGIN), D, (size_t)32 * nb, scr, F.lane); continue; } r -= I_IN;
        if (r < I_OUT) { const int kb = r >> 5, nb = r & 31; transpose_item(F.in[12], D, 64 * kb, 32 * nb, (bf16*)(F.ws + WS_WHGOUT), D, (size_t)32 * nb, scr, F.lane); continue; } r -= I_OUT;
        conv_moe_item(F, 0, r, (bf16*)(F.ws + WS_WGU0), (bf16*)(F.ws + WS_WD0), scr);
    }
}
__device__ __forceinline__ void conv_layer1(Frame& F) {
    LAS float* scr = (LAS float*)(F.lds + F.wave * 16384);
    const int gw = F.bid * NWAVES + F.wave, NGW = F.G * NWAVES;
    constexpr int I_SQ = 16 * 32, I_GRP = 4 * 4 * 8, I_MOE = 6144;
    for (int it = gw; it < 2 * I_SQ + I_GRP + I_MOE; it += NGW) {
        int r = it;
        if (r < I_SQ) { const int kb = r >> 5, nb = r & 31; transpose_item(F.in[13], D, 64 * kb, 32 * nb, (bf16*)(F.ws + WS_WPIN), D, (size_t)32 * nb, scr, F.lane); continue; } r -= I_SQ;
        if (r < I_SQ) { const int kb = r >> 5, nb = r & 31; transpose_item(F.in[16], D, 64 * kb, 32 * nb, (bf16*)(F.ws + WS_WPOUT), D, (size_t)32 * nb, scr, F.lane); continue; } r -= I_SQ;
        if (r < I_GRP) { const int g = r >> 5, q = r & 31, kb = q >> 3, nb = q & 7;
            transpose_item(F.in[14] + (size_t)g * 256 * 256, 256, 64 * kb, 32 * nb, (bf16*)(F.ws + WS_WGRP), 256, (size_t)g * 256 + 32 * nb, scr, F.lane); continue; } r -= I_GRP;
        conv_moe_item(F, 1, r, (bf16*)(F.ws + WS_WGU1), (bf16*)(F.ws + WS_WD1), scr);
    }
}

__device__ __forceinline__ void modulate_row(const f32x4 (&v)[4], const float* g, const float* sh, const float* sc, bf16* orow, int lane) {
    float s2 = 0.f;
#pragma unroll
    for (int j = 0; j < 4; ++j) s2 += (v[j].x * v[j].x + v[j].y * v[j].y) + (v[j].z * v[j].z + v[j].w * v[j].w);
    const float rstd = 1.f / sqrtf(wave_sum(s2) * (1.f / D) + EPS);
    unsigned long long* o8 = (unsigned long long*)orow + lane;
#pragma unroll
    for (int j = 0; j < 4; ++j) { const int c = 4 * lane + 256 * j;
        const f32x4 gv = *(const f32x4*)(g + c), shv = *(const f32x4*)(sh + c), scv = *(const f32x4*)(sc + c);
        const f32x4 h = v[j] * rstd * gv * (scv + 1.f) + shv;
        o8[64 * j] = (unsigned long long)pk2(h.x, h.y) | ((unsigned long long)pk2(h.z, h.w) << 32); }
}
__device__ __forceinline__ void p1_modulate0(Frame& F) {
    const int gw = F.bid * NWAVES + F.wave, NGW = F.G * NWAVES;
    bf16* H = (bf16*)(F.ws + WS_H);
    for (int row = gw; row < M_ALL; row += NGW) {
        const bool isctx = row >= M_LAT; const int b = isctx ? 4 : row / SEQ;
        const float* xr = isctx ? F.in[2] + (size_t)(row - M_LAT) * D : F.in[0] + (size_t)row * D;
        f32x4 v[4];
#pragma unroll
        for (int j = 0; j < 4; ++j) v[j] = ((const f32x4*)xr)[F.lane + 64 * j];
        modulate_row(v, F.in[6], modv(F, 0, b, 0), modv(F, 0, b, 1), H + (size_t)row * D, F.lane);
    }
}

__device__ __forceinline__ void p3_scan_naive(Frame& F) {
    if (F.bid >= 64) return;
    const int b = F.bid >> 4, h = (F.bid >> 1) & 7, dir = F.bid & 1;
    const bf16* PQ = (const bf16*)(F.ws + WS_PL), *PV = PQ + (size_t)M_ALL * D, *PZ = PQ + (size_t)(2 + dir) * M_ALL * D;
    bf16* OL = (bf16*)F.out + (size_t)dir * M_LAT * D; bf16* OC = (bf16*)(F.ws + (dir ? WS_OBC : WS_OFC));
    LAS float* fl = (LAS float*)F.lds, *kl = fl + 128, *ql = fl + 256, *ored = fl + 384;
    const int v = F.tid & 127, kq = F.tid >> 7;
    float lbv = 0.f;
    if (F.tid < 128) { const float* lb = dir ? F.in[10] : F.in[9]; lbv = sigmoidf_(lb[h * DH + F.tid] - lb[D + h * DH + F.tid]); }
    float S[32];
#pragma unroll
    for (int j = 0; j < 32; ++j) S[j] = 0.f;
    for (int s = 0; s < CTXL + SEQ; ++s) {
        int row;
        if (s < CTXL) row = M_LAT + b * CTXL + (dir ? CTXL - 1 - s : s);
        else row = b * SEQ + (dir ? SEQ - 1 - (s - CTXL) : s - CTXL);
        const size_t off = (size_t)row * D + h * DH;
        if (F.tid < 128) { const float z = bf2f(PZ[off + F.tid]); const float sg = sigmoidf_(z);
            fl[F.tid] = lbv + (1.f - lbv) * sg; kl[F.tid] = (1.f - lbv) * (1.f - sg); ql[F.tid] = bf2f(PQ[off + F.tid]); }
        const float vv = bf2f(PV[off + v]);
        __syncthreads();
        float po = 0.f;
#pragma unroll
        for (int j = 0; j < 32; ++j) { const int k = 32 * kq + j; S[j] = fl[k] * S[j] + kl[k] * vv; po += S[j] * ql[k]; }
        ored[kq * 128 + v] = po;
        __syncthreads();
        if (kq == 0) { const float o = (ored[v] + ored[128 + v]) + (ored[256 + v] + ored[384 + v]);
            if (s >= CTXL) OL[(size_t)row * D + h * DH + v] = (bf16)f2bf(o);
            else if (CTX_FULL) OC[(size_t)(row - M_LAT) * D + h * DH + v] = (bf16)f2bf(o); }
    }
}

__device__ __forceinline__ void p4_readout_prep(Frame& F) {
    const int gw = F.bid * NWAVES + F.wave, NGW = F.G * NWAVES;
    const bf16* SG = (const bf16*)(F.ws + WS_PL) + (size_t)4 * M_ALL * D; bf16* YP = (bf16*)(F.ws + WS_H);
    const int nrows = CTX_FULL ? M_ALL : M_LAT;
    for (int row = gw; row < nrows; row += NGW) {
        const bf16 *ofp, *obp;
        if (row < M_LAT) { ofp = (const bf16*)F.out + (size_t)row * D; obp = ofp + (size_t)M_LAT * D; }
        else { ofp = (const bf16*)(F.ws + WS_OFC) + (size_t)(row - M_LAT) * D; obp = (const bf16*)(F.ws + WS_OBC) + (size_t)(row - M_LAT) * D; }
        const int c0 = 16 * F.lane;
        const v4u f0 = *(const v4u*)(ofp + c0), f1 = *(const v4u*)(ofp + c0 + 8), b0 = *(const v4u*)(obp + c0), b1 = *(const v4u*)(obp + c0 + 8);
        const v4u g0 = *(const v4u*)(SG + (size_t)row * D + c0), g1 = *(const v4u*)(SG + (size_t)row * D + c0 + 8);
        float o[16]; float ss = 0.f;
#pragma unroll
        for (int q = 0; q < 4; ++q) { o[2 * q] = bflo(f0[q]) + bflo(b0[q]); o[2 * q + 1] = bfhi(f0[q]) + bfhi(b0[q]); o[8 + 2 * q] = bflo(f1[q]) + bflo(b1[q]); o[8 + 2 * q + 1] = bfhi(f1[q]) + bfhi(b1[q]); }
#pragma unroll
        for (int j = 0; j < 16; ++j) ss += o[j] * o[j];
        ss += __shfl_xor(ss, 1); ss += __shfl_xor(ss, 2); ss += __shfl_xor(ss, 4);
        const float rstd = 1.f / sqrtf(ss * (1.f / DH) + EPS);
        const float* gn = F.in[11] + (c0 & 127);
        float y[16];
#pragma unroll
        for (int q = 0; q < 4; ++q) { y[2 * q] = o[2 * q] * rstd * gn[2 * q] * bflo(g0[q]); y[2 * q + 1] = o[2 * q + 1] * rstd * gn[2 * q + 1] * bfhi(g0[q]);
            y[8 + 2 * q] = o[8 + 2 * q] * rstd * gn[8 + 2 * q] * bflo(g1[q]); y[8 + 2 * q + 1] = o[8 + 2 * q + 1] * rstd * gn[8 + 2 * q + 1] * bfhi(g1[q]); }
        v4u w0, w1;
#pragma unroll
        for (int q = 0; q < 4; ++q) { w0[q] = pk2(y[2 * q], y[2 * q + 1]); w1[q] = pk2(y[8 + 2 * q], y[8 + 2 * q + 1]); }
        *(v4u*)(YP + (size_t)row * D + c0) = w0; *(v4u*)(YP + (size_t)row * D + c0 + 8) = w1;
    }
    conv_layer1(F);
}

__device__ __forceinline__ void top2_of4(float a0, float a1, float a2, float a3, int& i1, int& i2, float& sum) {
    i1 = 0; float v1 = a0;
    if (a1 > v1) { v1 = a1; i1 = 1; }
    if (a2 > v1) { v1 = a2; i1 = 2; }
    if (a3 > v1) { v1 = a3; i1 = 3; }
    const float c0 = (i1 == 0) ? -1e30f : a0, c1 = (i1 == 1) ? -1e30f : a1, c2 = (i1 == 2) ? -1e30f : a2, c3 = (i1 == 3) ? -1e30f : a3;
    i2 = 0; float v2 = c0;
    if (c1 > v2) { v2 = c1; i2 = 1; }
    if (c2 > v2) { v2 = c2; i2 = 2; }
    if (c3 > v2) { v2 = c3; i2 = 3; }
    sum = v1 + v2;
}
__device__ __forceinline__ void route_row(Frame& F, int l, int row, const f32x4 (&v)[4], int b, LAS float* rw  ) {
    float s2 = 0.f;
#pragma unroll
    for (int j = 0; j < 4; ++j) s2 += (v[j].x * v[j].x + v[j].y * v[j].y) + (v[j].z * v[j].z + v[j].w * v[j].w);
    const float rstd = 1.f / sqrtf(wave_sum(s2) * (1.f / D) + EPS);
    const float* g = F.in[7] + l * D; const float* sh = modv(F, l, b, 3); const float* sc = modv(F, l, b, 4);
    unsigned long long* o8 = (unsigned long long*)((bf16*)(F.ws + WS_H) + (size_t)row * D) + F.lane;
    LAS float* hl = rw + D * NE + F.wave * D;
#pragma unroll
    for (int j = 0; j < 4; ++j) { const int c = 4 * F.lane + 256 * j;
        const f32x4 gv = *(const f32x4*)(g + c), shv = *(const f32x4*)(sh + c), scv = *(const f32x4*)(sc + c);
        const f32x4 h = v[j] * rstd * gv * (scv + 1.f) + shv;
        o8[64 * j] = (unsigned long long)pk2(h.x, h.y) | ((unsigned long long)pk2(h.z, h.w) << 32);
        *(LAS f32x4*)(hl + c) = h; }
    LDS_WAIT(); asm volatile("" ::: "memory");
    float part = 0.f;
    { const int e = F.lane & 15, k0 = (F.lane >> 4) * 256;
#pragma unroll 8
      for (int k = 0; k < 256; ++k) part += hl[k0 + k] * rw[(k0 + k) * 16 + e]; }
    part += __shfl_xor(part, 16); part += __shfl_xor(part, 32);
    LDS_WAIT(); asm volatile("" ::: "memory");
    float s[16], sel[16];
#pragma unroll
    for (int e = 0; e < 16; ++e) { s[e] = sigmoidf_(__shfl(part, e)); sel[e] = s[e] + F.in[18][e]; }
    int i1a, i2a, i1b, i2b, i1c, i2c, i1d, i2d; float gsa, gsb, gsc, gsd;
    top2_of4(sel[0], sel[1], sel[2], sel[3], i1a, i2a, gsa); top2_of4(sel[4], sel[5], sel[6], sel[7], i1b, i2b, gsb);
    top2_of4(sel[8], sel[9], sel[10], sel[11], i1c, i2c, gsc); top2_of4(sel[12], sel[13], sel[14], sel[15], i1d, i2d, gsd);
    int bpk = i1a | (i2a << 2); float bestv = gsa;
    { const bool c = gsb > bestv; bestv = c ? gsb : bestv; bpk = c ? (i1b | (i2b << 2) | 16) : bpk; }
    { const bool c = gsc > bestv; bestv = c ? gsc : bestv; bpk = c ? (i1c | (i2c << 2) | 32) : bpk; }
    { const bool c = gsd > bestv; bestv = c ? gsd : bestv; bpk = c ? (i1d | (i2d << 2) | 48) : bpk; }
    const int e1 = (bpk >> 4) * 4 + (bpk & 3), e2 = (bpk >> 4) * 4 + ((bpk >> 2) & 3);
    float s1 = 0.f, s2v = 0.f;
#pragma unroll
    for (int e = 0; e < 16; ++e) { s1 = (e == e1) ? s[e] : s1; s2v = (e == e2) ? s[e] : s2v; }
    const float inv = 1.f / (s1 + s2v);
    if (F.lane == 0) {
        unsigned* cnt = (unsigned*)(F.ctl + CW_CNT + 64 * l); unsigned* list = (unsigned*)(F.ws + WS_LIST);
        unsigned* slote = (unsigned*)(F.ws + WS_SLOTE); float* slotw = (float*)(F.ws + WS_SLOTW);
        const unsigned p1 = atomicAdd(cnt + e1, 1u); list[(size_t)e1 * LIST_CAP + p1] = (unsigned)row * 2u;
        const unsigned p2 = atomicAdd(cnt + e2, 1u); list[(size_t)e2 * LIST_CAP + p2] = (unsigned)row * 2u + 1u;
        slote[row * 2] = (unsigned)e1 | (p1 << 8); slote[row * 2 + 1] = (unsigned)e2 | (p2 << 8);
        slotw[row * 2] = s1 * inv; slotw[row * 2 + 1] = s2v * inv;
    }
}
__device__ __forceinline__ void p_route(Frame& F, int l) {
    LAS float* rw = (LAS float*)F.lds;
    for (int i = F.tid; i < D * NE / 4; i += NTHR) ((LAS f32x4*)rw)[i] = ((const f32x4*)F.in[17])[i];
    __syncthreads();
    const int gw = F.bid * NWAVES + F.wave, NGW = F.G * NWAVES;
    const int nrows = (l == 0 && CTX_FULL) ? M_ALL : M_LAT;
    for (int row = gw; row < nrows; row += NGW) {
        const bool isctx = row >= M_LAT; const int b = isctx ? 4 : row / SEQ;
        const float* xr = isctx ? (const float*)(F.ws + WS_XC) + (size_t)(row - M_LAT) * D : F.out + (size_t)row * D;
        f32x4 v[4];
#pragma unroll
        for (int j = 0; j < 4; ++j) v[j] = ((const f32x4*)xr)[F.lane + 64 * j];
        route_row(F, l, row, v, b, rw);
    }
    __syncthreads();
}
__device__ __forceinline__ void moe_prefix(Frame& F, int l) {
    if (F.tid == 0) { unsigned acc = 0;
        for (int e = 0; e < 16; ++e) { const unsigned c = __hip_atomic_load((unsigned*)(F.ctl + CW_CNT + 64 * l + e), RLX_AGENT); F.MISC[32 + e] = acc; F.MISC[32 + 17 + e] = c; acc += (c + 255u) >> 8; }
        F.MISC[32 + 16] = acc; }
    __syncthreads();
}
__device__ __forceinline__ void combine_row(Frame& F, int l, int row, int b, const volatile LAS unsigned* tb, f32x4 (&v)[4]) {
    const unsigned se0 = ((const unsigned*)(F.ws + WS_SLOTE))[row * 2], se1 = ((const unsigned*)(F.ws + WS_SLOTE))[row * 2 + 1];
    const float w0 = ((const float*)(F.ws + WS_SLOTW))[row * 2], w1 = ((const float*)(F.ws + WS_SLOTW))[row * 2 + 1];
    const size_t p0 = (size_t)tb[se0 & 255u] * 256 + (se0 >> 8), p1 = (size_t)tb[se1 & 255u] * 256 + (se1 >> 8);
    const bf16* Y2 = (const bf16*)(F.ws + WS_Y2);
    const v2u* y0 = (const v2u*)(Y2 + p0 * D) + F.lane; const v2u* y1 = (const v2u*)(Y2 + p1 * D) + F.lane;
    const float* g2 = modv(F, l, b, 5);
#pragma unroll
    for (int j = 0; j < 4; ++j) { const v2u a = y0[64 * j], c = y1[64 * j]; const f32x4 gv = *(const f32x4*)(g2 + 4 * F.lane + 256 * j);
        f32x4 ff; ff.x = w0 * bflo(a.x) + w1 * bflo(c.x); ff.y = w0 * bfhi(a.x) + w1 * bfhi(c.x); ff.z = w0 * bflo(a.y) + w1 * bflo(c.y); ff.w = w0 * bfhi(a.y) + w1 * bfhi(c.y);
        v[j] = v[j] + gv * ff; }
}
__device__ __forceinline__ void p9_combine_mod(Frame& F) {
    moe_prefix(F, 0);
    const volatile LAS unsigned* tb = F.MISC + 32;
    const int gw = F.bid * NWAVES + F.wave, NGW = F.G * NWAVES;
    const int nrows = CTX_FULL ? M_ALL : M_LAT;
    for (int row = gw; row < nrows; row += NGW) {
        const bool isctx = row >= M_LAT; const int b = isctx ? 4 : row / SEQ;
        float* xr = isctx ? (float*)(F.ws + WS_XC) + (size_t)(row - M_LAT) * D : F.out + (size_t)row * D;
        f32x4 v[4];
#pragma unroll
        for (int j = 0; j < 4; ++j) v[j] = ((const f32x4*)xr)[F.lane + 64 * j];
        combine_row(F, 0, row, b, tb, v);
#pragma unroll
        for (int j = 0; j < 4; ++j) ((f32x4*)xr)[F.lane + 64 * j] = v[j];
        if (!isctx) modulate_row(v, F.in[6] + D, modv(F, 1, b, 0), modv(F, 1, b, 1), (bf16*)(F.ws + WS_H) + (size_t)row * D, F.lane);
    }
}
__device__ __forceinline__ void p11_pool_naive(Frame& F) {
    const bf16* U = (const bf16*)(F.ws + WS_U); bf16* DP = (bf16*)(F.ws + WS_DP);
    const long total = (long)M_LAT * 128;
    for (long idx = (long)F.bid * NTHR + F.tid; idx < total; idx += (long)F.G * NTHR) {
        const int tok = (int)(idx >> 7), ch8 = (int)(idx & 127), b = tok / SEQ, t = tok % SEQ, r = t / GRIDW, c = t % GRIDW;
        const int g = ch8 >> 5, win = 2 << g, half = win >> 1;
        const int rlo = max(r - half, 0), rhi = min(r - half + win, GRIDW), clo = max(c - half, 0), chi = min(c - half + win, GRIDW);
        float acc[8];
#pragma unroll
        for (int j = 0; j < 8; ++j) acc[j] = 0.f;
        for (int rr = rlo; rr < rhi; ++rr)
            for (int cc = clo; cc < chi; ++cc) { const v4u w = *(const v4u*)(U + (size_t)(b * SEQ + rr * GRIDW + cc) * D + ch8 * 8);
#pragma unroll
                for (int q = 0; q < 4; ++q) { acc[2 * q] += bflo(w[q]); acc[2 * q + 1] += bfhi(w[q]); } }
        const float inv = 1.f / (float)((rhi - rlo) * (chi - clo));
        const v4u w = *(const v4u*)(U + (size_t)tok * D + ch8 * 8);
        v4u o;
#pragma unroll
        for (int q = 0; q < 4; ++q) o[q] = pk2(acc[2 * q] * inv - bflo(w[q]), acc[2 * q + 1] * inv - bfhi(w[q]));
        *(v4u*)(DP + ((size_t)g * M_LAT + tok) * 256 + (ch8 & 31) * 8) = o;
    }
}
__device__ __forceinline__ void p17_final(Frame& F) {
    moe_prefix(F, 1);
    const volatile LAS unsigned* tb = F.MISC + 32;
    const int gw = F.bid * NWAVES + F.wave, NGW = F.G * NWAVES;
    for (int row = gw; row < M_LAT; row += NGW) {
        float* xr = F.out + (size_t)row * D;
        f32x4 v[4];
#pragma unroll
        for (int j = 0; j < 4; ++j) v[j] = ((const f32x4*)xr)[F.lane + 64 * j];
        combine_row(F, 1, row, row / SEQ, tb, v);
        float s2 = 0.f;
#pragma unroll
        for (int j = 0; j < 4; ++j) s2 += (v[j].x * v[j].x + v[j].y * v[j].y) + (v[j].z * v[j].z + v[j].w * v[j].w);
        const float rstd = 1.f / sqrtf(wave_sum(s2) * (1.f / D) + EPS);
#pragma unroll
        for (int j = 0; j < 4; ++j) { const f32x4 gv = *(const f32x4*)(F.in[22] + 4 * F.lane + 256 * j); ((f32x4*)xr)[F.lane + 64 * j] = v[j] * rstd * gv; }
    }
}

struct Args { const float* in[23]; float* out; unsigned char* ws; int ph_lo, ph_hi; };
#define GEMM_CORE gemm_naive

__global__ void __launch_bounds__(NTHR, 2) fwd_kernel(Args args) {
    extern __shared__ __attribute__((aligned(16))) unsigned char lds[];
    Frame F;
    F.lds = (LAS unsigned char*)lds; F.MISC = (volatile LAS unsigned*)(F.lds + MISC_OFF);
    F.tid = threadIdx.x; F.lane = F.tid & 63; F.wave = __builtin_amdgcn_readfirstlane(F.tid >> 6);
    F.G = gridDim.x; F.bid = blockIdx.x;
#pragma unroll
    for (int i = 0; i < 23; ++i) F.in[i] = args.in[i];
    F.out = args.out; F.ws = args.ws; F.ctl = (gu32*)(args.ws + WS_CTL);
    for (int u = F.tid; u < (LDS_BYTES - LDSCTL_OFF) / 4; u += NTHR) ((LAS unsigned*)(F.lds + LDSCTL_OFF))[u] = 0u;
    __syncthreads();
    XcdBarrier bar; bar.bar = (unsigned*)(F.ctl + CW_BAR); bar.x = 0; bar.st = nullptr;
    if (MK_ONE_LAUNCH) bar = xcd_barrier_post((unsigned*)(F.ctl + CW_BAR), F.MISC + 8);
    const int lo = args.ph_lo, hi = args.ph_hi;
#ifndef PHMASK
#define PHMASK 0x3ffff
#endif
#define IN(k) (((PHMASK >> (k)) & 1) && lo <= (k) && (k) < hi)
#define SEAM(k) do { if (IN(k) && IN((k) + 1)) xcd_barrier(bar); } while (0)
    bf16* const PL = (bf16*)(F.ws + WS_PL);

    if (IN(0)) { p0_prep(F); } SEAM(0);
    if (IN(1)) { p1_modulate0(F); } SEAM(1);
    if (IN(2)) {
        Gemm g{(const bf16*)(F.ws + WS_H), (const bf16*)(F.ws + WS_WHGIN), D}; StaticOrder S; S.init(M_ALL, NPROJ * D, F.G, F.bid);
        EpiInProj E{PL}; GEMM_CORE<EpiInProj, StaticOrder>(g, S, E); } SEAM(2);
    if (IN(3)) { p3_scan_naive(F); } SEAM(3);
    if (IN(4)) { p4_readout_prep(F); } SEAM(4);
    if (IN(5)) {
        Gemm g{(const bf16*)(F.ws + WS_H), (const bf16*)(F.ws + WS_WHGOUT), D}; StaticOrder S; S.init(CTX_FULL ? M_ALL : M_LAT, D, F.G, F.bid);
        EpiResid E{F.in[0], F.in[2], F.out, (float*)(F.ws + WS_XC), modv(F, 0, 0, 2)}; GEMM_CORE<EpiResid, StaticOrder>(g, S, E); } SEAM(5);
    if (IN(6)) { p_route(F, 0); } SEAM(6);
    if (IN(7)) { moe_prefix(F, 0);
        Gemm g{(const bf16*)(F.ws + WS_H), (const bf16*)(F.ws + WS_WGU0), D}; MoeOrder S{F.G, F.bid, 2, 1, F.MISC + 32, (const unsigned*)(F.ws + WS_LIST)};
        EpiGateUp E{(bf16*)(F.ws + WS_ACT)}; GEMM_CORE<EpiGateUp, MoeOrder>(g, S, E); } SEAM(7);
    if (IN(8)) { moe_prefix(F, 0);
        Gemm g{(const bf16*)(F.ws + WS_ACT), (const bf16*)(F.ws + WS_WD0), DE}; MoeOrder S{F.G, F.bid, 4, 0, F.MISC + 32, (const unsigned*)(F.ws + WS_LIST)};
        EpiDown E{(bf16*)(F.ws + WS_Y2)}; GEMM_CORE<EpiDown, MoeOrder>(g, S, E); } SEAM(8);
    if (IN(9)) { p9_combine_mod(F); } SEAM(9);
    if (IN(10)) {
        Gemm g{(const bf16*)(F.ws + WS_H), (const bf16*)(F.ws + WS_WPIN), D}; StaticOrder S; S.init(M_LAT, D, F.G, F.bid);
        EpiBf16Plain E{(bf16*)(F.ws + WS_U), D}; GEMM_CORE<EpiBf16Plain, StaticOrder>(g, S, E); } SEAM(10);
    if (IN(11)) { p11_pool_naive(F); } SEAM(11);
    if (IN(12)) {
        Gemm g{(const bf16*)(F.ws + WS_DP), (const bf16*)(F.ws + WS_WGRP), 256}; GroupOrder S{F.G, F.bid};
        EpiGrp E{(bf16*)(F.ws + WS_E), F.in[15]}; GEMM_CORE<EpiGrp, GroupOrder>(g, S, E); } SEAM(12);
    if (IN(13)) {
        Gemm g{(const bf16*)(F.ws + WS_E), (const bf16*)(F.ws + WS_WPOUT), D}; StaticOrder S; S.init(M_LAT, D, F.G, F.bid);
        EpiResid E{F.out, nullptr, F.out, nullptr, modv(F, 1, 0, 2)}; GEMM_CORE<EpiResid, StaticOrder>(g, S, E); } SEAM(13);
    if (IN(14)) { p_route(F, 1); } SEAM(14);
    if (IN(15)) { moe_prefix(F, 1);
        Gemm g{(const bf16*)(F.ws + WS_H), (const bf16*)(F.ws + WS_WGU1), D}; MoeOrder S{F.G, F.bid, 2, 1, F.MISC + 32, (const unsigned*)(F.ws + WS_LIST)};
        EpiGateUp E{(bf16*)(F.ws + WS_ACT)}; GEMM_CORE<EpiGateUp, MoeOrder>(g, S, E); } SEAM(15);
    if (IN(16)) { moe_prefix(F, 1);
        Gemm g{(const bf16*)(F.ws + WS_ACT), (const bf16*)(F.ws + WS_WD1), DE}; MoeOrder S{F.G, F.bid, 4, 0, F.MISC + 32, (const unsigned*)(F.ws + WS_LIST)};
        EpiDown E{(bf16*)(F.ws + WS_Y2)}; GEMM_CORE<EpiDown, MoeOrder>(g, S, E); } SEAM(16);
    if (IN(17)) { p17_final(F); }
#undef IN
#undef SEAM
}

extern "C" void kernel_launch(void* const* d_in, const int* in_sizes, int n_in, void* d_out, int out_size, void* d_ws, size_t ws_size, hipStream_t stream) {
    static int grid = 0;
    if (grid == 0) {
        if (n_in != 23 || in_sizes[0] != M_LAT * D || out_size != M_LAT * D || ws_size < WS_END) { fprintf(stderr, "kernel_launch: unexpected shapes (n_in %d, in0 %d, out %d, ws %zu); nothing launched\n", n_in, n_in > 0 ? in_sizes[0] : -1, out_size, ws_size); grid = -1; return; }
        int dev = 0, cus = 0, per_cu = 0;
        if (hipGetDevice(&dev) != hipSuccess || hipDeviceGetAttribute(&cus, hipDeviceAttributeMultiprocessorCount, dev) != hipSuccess) { grid = -1; return; }
        if (hipFuncSetAttribute((const void*)fwd_kernel, hipFuncAttributeMaxDynamicSharedMemorySize, LDS_BYTES) != hipSuccess) { fprintf(stderr, "kernel_launch: hipFuncSetAttribute failed\n"); grid = -1; return; }
        if (hipOccupancyMaxActiveBlocksPerMultiprocessor(&per_cu, (const void*)fwd_kernel, NTHR, LDS_BYTES) != hipSuccess || per_cu < 1) { fprintf(stderr, "kernel_launch: occupancy query says %d blocks per CU\n", per_cu); per_cu = 1; }
        (void)hipGetLastError();
        grid = cus;
    }
    if (grid < 0) return;
    if (hipMemsetAsync((char*)d_ws + WS_CTL, 0, CTL_ZERO_BYTES, stream) != hipSuccess) return;
    Args a{};
    for (int i = 0; i < 23; ++i) a.in[i] = (const float*)d_in[i];
    a.out = (float*)d_out; a.ws = (unsigned char*)d_ws;
    if (MK_ONE_LAUNCH) { a.ph_lo = 0; a.ph_hi = NPHASE; hipLaunchKernelGGL(fwd_kernel, dim3(grid), dim3(NTHR), LDS_BYTES, stream, a); }
    else for (int p = 0; p < NPHASE; ++p) { a.ph_lo = p; a.ph_hi = p + 1; hipLaunchKernelGGL(fwd_kernel, dim3(grid), dim3(NTHR), LDS_BYTES, stream, a); }
}
```

```cpp
#include <hip/hip_runtime.h>
#include <cstdio>
#include <cstdint>

#ifndef MK_ONE_LAUNCH
#define MK_ONE_LAUNCH 1
#endif
#ifndef CTX_FULL
#define CTX_FULL 1
#endif

constexpr int D = 1024, NB = 4, SEQ = 4096, CTXL = 256;
constexpr int M_LAT = NB * SEQ, M_CTX = NB * CTXL, M_ALL = M_LAT + M_CTX;
constexpr int NH = 8, DH = 128, NPROJ = 5;
constexpr int NE = 16, DE = 256, NGRP = 4, EPG = 4;
constexpr int GRIDW = 64;
constexpr float EPS = 1e-6f;
constexpr int NWAVES = 8, NTHR = 512;
constexpr int NPHASE = 18;

constexpr size_t MiB = 1u << 20;
constexpr size_t WS_CTL = 0, CTL_ZERO_BYTES = 1 * MiB;
constexpr size_t WS_MODV = 1 * MiB;
constexpr size_t WS_LIST = 2 * MiB;
constexpr size_t WS_SLOTE = 2 * MiB + 1280 * 1024;
constexpr size_t WS_SLOTW = 2 * MiB + 1536 * 1024;
constexpr size_t WS_WHGIN = 4 * MiB;
constexpr size_t WS_WHGOUT = 14 * MiB;
constexpr size_t WS_WGU0 = 16 * MiB;
constexpr size_t WS_WD0 = 32 * MiB;
constexpr size_t WS_XC = 40 * MiB;
constexpr size_t WS_H = 44 * MiB;
constexpr size_t WS_PL = 78 * MiB;
constexpr size_t PLANE = (size_t)M_ALL * D * 2;
constexpr size_t WS_OFC = 248 * MiB, WS_OBC = 250 * MiB;
constexpr size_t WS_WPIN = 78 * MiB, WS_WGRP = 80 * MiB, WS_WPOUT = 81 * MiB;
constexpr size_t WS_WGU1 = 83 * MiB, WS_WD1 = 99 * MiB;
constexpr size_t WS_ACT = 108 * MiB;
constexpr size_t WS_Y2 = 128 * MiB;
constexpr size_t WS_U = 204 * MiB;
constexpr size_t WS_DP = 108 * MiB;
constexpr size_t WS_E = 140 * MiB;
constexpr size_t WS_END = 256 * MiB;
static_assert(WS_PL + 5 * PLANE <= WS_OFC && WS_H + PLANE <= WS_PL && WS_Y2 + (size_t)38912 * 2048 <= WS_U && WS_U + (size_t)M_LAT * 2048 <= WS_OFC, "ws map");
static_assert(WS_ACT + (size_t)38912 * 512 <= WS_Y2 && WS_DP + (size_t)M_LAT * 2048 <= WS_E && WS_E + (size_t)M_LAT * 2048 <= WS_U && WS_WD1 + 8 * MiB <= WS_ACT, "ws map 2");
constexpr int CW_BAR = 4096;
constexpr int CW_CNT = 8192;
constexpr int LIST_CAP = M_ALL;

constexpr int RING_BYTES = 131072;
constexpr int LDSCTL_OFF = RING_BYTES, MISC_OFF = LDSCTL_OFF + 320;
constexpr int LDS_BYTES = 147456;

#define GAS __attribute__((address_space(1)))
#define LAS __attribute__((address_space(3)))
typedef unsigned short bf16;
typedef unsigned v4u __attribute__((ext_vector_type(4)));
typedef unsigned v2u __attribute__((ext_vector_type(2)));
typedef float f32x4 __attribute__((ext_vector_type(4)));
typedef short bf16x8 __attribute__((ext_vector_type(8)));
typedef GAS unsigned gu32;
#define RLX_AGENT __ATOMIC_RELAXED, __HIP_MEMORY_SCOPE_AGENT
#define LDS_WAIT() asm volatile("s_waitcnt lgkmcnt(0)" ::: "memory")
#define VM_WAIT() asm volatile("s_waitcnt vmcnt(0)" ::: "memory")

__device__ __forceinline__ unsigned f2bf(float f) { unsigned u = __builtin_bit_cast(unsigned, f); return (u + 0x7fffu + ((u >> 16) & 1u)) >> 16; }
__device__ __forceinline__ unsigned pk2(float lo, float hi) { return f2bf(lo) | (f2bf(hi) << 16); }
__device__ __forceinline__ float bf2f(unsigned b) { return __builtin_bit_cast(float, b << 16); }
__device__ __forceinline__ float bflo(unsigned w) { return __builtin_bit_cast(float, w << 16); }
__device__ __forceinline__ float bfhi(unsigned w) { return __builtin_bit_cast(float, w & 0xffff0000u); }
__device__ __forceinline__ float sigmoidf_(float x) { return 1.f / (1.f + __expf(-x)); }
__device__ __forceinline__ float siluf_(float x) { return x / (1.f + __expf(-x)); }
__device__ __forceinline__ float wave_sum(float v) {
#pragma unroll
    for (int o = 1; o < 64; o <<= 1) v += __shfl_xor(v, o);
    return v;
}

#define XB_TMO      128
#define XB_XCNT(j)  (256  + 64 * (j))
#define XB_XSUB(j)  (1280 + 64 * (j))
#define XB_XGEN(j)  (2304 + 64 * (j))
#define XB_TOP      3328
#define XB_TOPGEN   3392
#define XCD_BAR_WORDS 3456
#define XB_SPIN_CAP (1u << 18)
__device__ __forceinline__ unsigned xb_ld(unsigned* p)              { return __hip_atomic_load(p, __ATOMIC_RELAXED, __HIP_MEMORY_SCOPE_AGENT); }
__device__ __forceinline__ unsigned xb_add(unsigned* p, unsigned v) { return __hip_atomic_fetch_add(p, v, __ATOMIC_RELAXED, __HIP_MEMORY_SCOPE_AGENT); }
__device__ __forceinline__ unsigned xb_xcc_id() { return (unsigned)__builtin_amdgcn_s_getreg((3 << 11) | 20) & 0xFu; }
#define XB_SPIN(cond, bar) do { unsigned _sp = 0; while (cond) { __builtin_amdgcn_s_sleep(1); \
    if ((++_sp & 255u) == 0u) { if (xb_ld(&(bar)[XB_TMO])) break; if (_sp > XB_SPIN_CAP) { atomicAdd(&(bar)[XB_TMO], 1u); break; } } } } while (0)
struct XcdBarrier { unsigned* bar; unsigned x; volatile LAS unsigned* st; };
__device__ __forceinline__ XcdBarrier xcd_barrier_post(unsigned* bar, volatile LAS unsigned* st) {
    XcdBarrier b; b.bar = bar; b.x = xb_xcc_id(); b.st = st;
    if (threadIdx.x == 0) (void)xb_add(&bar[XB_XCNT(b.x)], 1u);
    return b;
}
__device__ __forceinline__ void xcd_barrier_complete(unsigned* bar, unsigned x, unsigned& nloc, unsigned& nx) {
    const unsigned G = gridDim.x * gridDim.y * gridDim.z;
    unsigned sum, cnt, mine, sp = 0u;
    for (;;) {
        sum = 0u; cnt = 0u; mine = 0u;
#pragma unroll
        for (unsigned j = 0; j < 16; ++j) { const unsigned c = xb_ld(&bar[XB_XCNT(j)]); sum += c; cnt += (c > 0u) ? 1u : 0u; mine = (j == x) ? c : mine; }
        if (sum == G) break;
        __builtin_amdgcn_s_sleep(1);
        if ((++sp & 255u) == 0u) { if (xb_ld(&bar[XB_TMO])) break; if (sp > XB_SPIN_CAP) { atomicAdd(&bar[XB_TMO], 1u); break; } }
    }
    nloc = mine > 0u ? mine : 1u; nx = cnt > 0u ? cnt : 1u;
}
__device__ __forceinline__ void xcd_barrier(const XcdBarrier& b) {
    asm volatile("s_waitcnt vmcnt(0)" ::: "memory");
    __syncthreads();
    if (threadIdx.x == 0) {
        unsigned* bar = b.bar;
        __builtin_amdgcn_s_waitcnt(0);
        unsigned nloc = b.st[0], nx = b.st[1];
        if (nloc == 0u) { xcd_barrier_complete(bar, b.x, nloc, nx); b.st[0] = nloc; b.st[1] = nx; }
        const unsigned old = xb_add(&bar[XB_XSUB(b.x)], 1u);
        const unsigned gen = old / nloc;
        if (old + 1u == (gen + 1u) * nloc) {
            __builtin_amdgcn_fence(__ATOMIC_RELEASE, "agent");
            asm volatile("s_waitcnt vmcnt(0)" ::: "memory");
            const unsigned og = xb_add(&bar[XB_TOP], 1u);
            const unsigned tg = og / nx;
            if (og + 1u == (tg + 1u) * nx) xb_add(&bar[XB_TOPGEN], 1u);
            else XB_SPIN(xb_ld(&bar[XB_TOPGEN]) == tg, bar);
            __builtin_amdgcn_fence(__ATOMIC_ACQUIRE, "agent");
            xb_add(&bar[XB_XGEN(b.x)], 1u);
            asm volatile("s_waitcnt vmcnt(0)" ::: "memory");
        } else {
            XB_SPIN(xb_ld(&bar[XB_XGEN(b.x)]) == gen, bar);
            __builtin_amdgcn_fence(__ATOMIC_ACQUIRE, "agent");
            asm volatile("s_waitcnt vmcnt(0)" ::: "memory");
        }
    }
    __syncthreads();
}

struct Unit { int pm, pn; };
struct Gemm { const bf16* A; const bf16* Bt; int K; };
constexpr int NXCD = 8, WGM = 8, BM = 256;

struct StaticOrder {
    int nM, nN, nwg, G, c;
    __device__ __forceinline__ void init(int M, int N, int G_, int c_) { nM = M / BM; nN = N / BM; nwg = nM * nN; G = G_; c = c_; }
    __device__ __forceinline__ bool next(int i, Unit& u) const {
        const long L = (long)i * G + c; if (L >= nwg) return false;
        int wgid = (int)L; { const int q = nwg / NXCD, r = nwg % NXCD, xcd = wgid % NXCD, off = wgid / NXCD; wgid = (xcd < r ? xcd * (q + 1) : r * (q + 1) + (xcd - r) * q) + off; }
        const int nig = WGM * nN, gid = wgid / nig, fm = gid * WGM, gsz = (nM - fm) < WGM ? (nM - fm) : WGM;
        u.pm = fm + ((wgid % nig) % gsz); u.pn = (wgid % nig) / gsz; return true;
    }
    __device__ __forceinline__ int a_row(const Unit& u, int r) const { return u.pm * BM + r; }
};
struct GroupOrder {
    int G, c;
    __device__ __forceinline__ bool next(int i, Unit& u) const { const int L = i * G + c; if (L >= 256) return false; u.pm = L; u.pn = L >> 6; return true; }
    __device__ __forceinline__ int a_row(const Unit& u, int r) const { return u.pm * BM + r; }
};
struct MoeOrder {
    int G, c, npn, gather; const volatile LAS unsigned* tb; const unsigned* list;
    __device__ __forceinline__ bool next(int i, Unit& u) const {
        const int L = i * G + c; const int nt = (int)tb[16];
        if (L >= nt * npn) return false;
        const int t = L / npn, nl = L % npn; int e = 0;
#pragma unroll
        for (int j = 1; j < 16; ++j) e += (t >= (int)tb[j]) ? 1 : 0;
        u.pm = t; u.pn = e * npn + nl; return true;
    }
    __device__ __forceinline__ int a_row(const Unit& u, int r) const {
        if (!gather) return u.pm * BM + r;
        const int e = u.pn / npn; const int idx = (u.pm - (int)tb[e]) * BM + r;
        const unsigned ent = (idx < (int)tb[17 + e]) ? list[(size_t)e * LIST_CAP + idx] : 0u;
        return (int)(ent >> 1);
    }
};

template <class Epi, class Sched>
__device__ __forceinline__ void gemm_naive(const Gemm g, const Sched& S, const Epi& E) {
    const int tid = threadIdx.x, wid = tid >> 6, lane = tid & 63, wr = wid >> 2, wc = wid & 3, fr = lane & 15, fq = lane >> 4;
    const int K = g.K;
    Unit u;
    for (int i = 0; S.next(i, u); ++i) {
        f32x4 acc[2][2][4][2];
#pragma unroll
        for (int ai = 0; ai < 2; ++ai)
#pragma unroll
            for (int m = 0; m < 4; ++m) {
                const bf16* ar = g.A + (size_t)S.a_row(u, 128 * ai + 64 * wr + 16 * m + fr) * K;
#pragma unroll
                for (int bj = 0; bj < 2; ++bj)
#pragma unroll
                    for (int n = 0; n < 2; ++n) {
                        const int c0 = 128 * bj + 32 * wc + (Epi::PERM ? 8 * fq + 4 * n : 16 * n + 4 * fq);
                        const bf16* br = g.Bt + (size_t)(u.pn * BM + c0) * K;
                        f32x4 a0 = {0.f, 0.f, 0.f, 0.f};
#pragma unroll 1
                        for (int k = 0; k < K; k += 8) {
                            const v4u b0 = *(const v4u*)(br + k), b1 = *(const v4u*)(br + (size_t)K + k), b2 = *(const v4u*)(br + (size_t)2 * K + k), b3 = *(const v4u*)(br + (size_t)3 * K + k);
                            const v4u x0 = *(const v4u*)(ar + k);
#pragma unroll
                            for (int q = 0; q < 4; ++q) {
                                const f32x4 blo = {bflo(b0[q]), bflo(b1[q]), bflo(b2[q]), bflo(b3[q])}, bhi = {bfhi(b0[q]), bfhi(b1[q]), bfhi(b2[q]), bfhi(b3[q])};
                                a0 += blo * bflo(x0[q]) + bhi * bfhi(x0[q]);
                            }
                        }
                        asm volatile("" : "+v"(a0));
                        acc[ai][bj][m][n] = a0;
                    }
            }
        E(acc, u, wr, wc, fr, fq);
    }
}

constexpr int BK = 64, HALF = 128, HTB = HALF * BK * 2;
__device__ __forceinline__ int lds_byte(int r, int c) { const int st = (r >> 4) * 2 + (c >> 5), rr = r & 15, cc = c & 31, ob = rr * 64 + cc * 2; return st * 1024 + (ob ^ (((ob >> 9) & 1) << 5)); }
__device__ __forceinline__ void stage_rc(int b, int& R, int& C) { const int st = b / 1024, sb = b % 1024, swz = sb ^ (((sb >> 9) & 1) << 5); R = (st >> 1) * 16 + swz / 64; C = (st & 1) * 32 + (swz % 64) / 2; }
__device__ __forceinline__ int perm32(int rho) { const int n = rho >> 4, i = rho & 15; return 8 * (i >> 2) + 4 * n + (i & 3); }
template <class Epi, class Sched, bool ALIGN_EPI = false, bool SP2 = false>
__device__ __forceinline__ void gemm_phase(LAS unsigned char* lds, const Gemm g, const Sched& S, const Epi& E) {
    const int tid = threadIdx.x, wid = __builtin_amdgcn_readfirstlane(tid >> 6), lane = tid & 63, wr = wid >> 2, wc = wid & 3, fr = lane & 15, fq = lane >> 4;
    const int K = g.K, nt = K / BK;
    unsigned vAc0[2], vAc1[2], vAn0[2], vAn1[2], voffB[2]; int stR[2], stC[2];
#pragma unroll
    for (int i = 0; i < 2; ++i) { int R, C; stage_rc(tid * 16 + i * 8192, R, C); const int Rb = Epi::PERM ? ((R & ~31) + perm32(R & 31)) : R;
        stR[i] = R; stC[i] = C; voffB[i] = (unsigned)(Rb * K + C) * 2u; }
#define PG8_SETA(v0, v1, U) do { _Pragma("unroll") for (int _i = 0; _i < 2; ++_i) { v0[_i] = (unsigned)(S.a_row(U, stR[_i]) * K + stC[_i]) * 2u; v1[_i] = (unsigned)(S.a_row(U, HALF + stR[_i]) * K + stC[_i]) * 2u; } } while (0)
    const size_t kstep = (size_t)(BK * 2);
    const size_t hstep = (size_t)HALF * K * 2;
    const size_t tstep = 2 * hstep;
    const unsigned ldsw = (unsigned)wid * 1024u;
    const int aoff = lds_byte(wr * 64 + fr, fq * 8), boff = lds_byte(wc * 32 + fr, fq * 8);
#define PG8_SA(b, h) (((b) * 2 + (h)) * HTB)
#define PG8_SB(b, h) ((4 + (b) * 2 + (h)) * HTB)
#define PG8_STAGE(bufoff, gbase, voff) do { _Pragma("unroll") for (int _i = 0; _i < 2; ++_i) \
        __builtin_amdgcn_global_load_lds((const unsigned*)((const char*)(gbase) + (voff)[_i]), (LAS unsigned*)(lds + (bufoff) + ldsw + _i * 8192), 16, 0, 0); } while (0)
#define PG8_LDA(dst, b, h) do { _Pragma("unroll") for (int m = 0; m < 4; ++m) _Pragma("unroll") for (int k = 0; k < 2; ++k) dst[m][k] = *(const LAS bf16x8*)(lds + PG8_SA(b, h) + aoff + m * 2048 + k * 1024); } while (0)
#define PG8_LDB(dst, b, h) do { _Pragma("unroll") for (int n = 0; n < 2; ++n) _Pragma("unroll") for (int k = 0; k < 2; ++k) dst[n][k] = *(const LAS bf16x8*)(lds + PG8_SB(b, h) + boff + n * 2048 + k * 1024); } while (0)
#define PG8_MMA(ai, bj, At, Bt) do { __builtin_amdgcn_s_setprio(1); _Pragma("unroll") for (int m = 0; m < 4; ++m) _Pragma("unroll") for (int n = 0; n < 2; ++n) _Pragma("unroll") for (int k = 0; k < 2; ++k) \
        acc[ai][bj][m][n] = __builtin_amdgcn_mfma_f32_16x16x32_bf16(Bt[n][k], At[m][k], acc[ai][bj][m][n], 0, 0, 0); __builtin_amdgcn_s_setprio(0); } while (0)
#define PG8_WAIT_V(n) asm volatile("s_waitcnt vmcnt(" #n ")" ::: "memory")
#define PG8_WAIT_L(n) asm volatile("s_waitcnt lgkmcnt(" #n ")" ::: "memory")
#define PG8_BAR __builtin_amdgcn_s_barrier()
#define PG8_SCHED __builtin_amdgcn_sched_barrier(0)
    Unit cur, nxt; int ui = 0;
    if (!S.next(0, cur)) return;
    f32x4 acc[2][2][4][2];
#pragma unroll
    for (int a = 0; a < 2; ++a)
#pragma unroll
        for (int b = 0; b < 2; ++b)
#pragma unroll
            for (int m = 0; m < 4; ++m)
#pragma unroll
                for (int n = 0; n < 2; ++n) acc[a][b][m][n] = (f32x4){0.f, 0.f, 0.f, 0.f};
    bf16x8 At[4][2], B0[2][2], B1[2][2];
    const char* const cA = (const char*)g.A; PG8_SETA(vAc0, vAc1, cur); const char* cB = (const char*)g.Bt + (size_t)cur.pn * tstep;
    if constexpr (SP2) {
        PG8_STAGE(PG8_SB(0, 0), cB, voffB); PG8_STAGE(PG8_SB(0, 1), cB + hstep, voffB); PG8_STAGE(PG8_SA(0, 0), cA, vAc0); PG8_STAGE(PG8_SA(0, 1), cA, vAc1);
        if (wr == 1) PG8_BAR;
        PG8_WAIT_V(2); PG8_BAR;
        PG8_STAGE(PG8_SB(1, 0), cB + kstep, voffB); PG8_STAGE(PG8_SA(1, 0), cA + kstep, vAc0); PG8_STAGE(PG8_SB(1, 1), cB + hstep + kstep, voffB);
        PG8_WAIT_V(6); PG8_BAR;
    } else {
        PG8_STAGE(PG8_SB(0, 0), cB, voffB); PG8_STAGE(PG8_SA(0, 0), cA, vAc0); PG8_STAGE(PG8_SB(0, 1), cB + hstep, voffB); PG8_STAGE(PG8_SA(0, 1), cA, vAc1);
        if (wr == 1) PG8_BAR;
        PG8_WAIT_V(4); PG8_BAR;
        PG8_STAGE(PG8_SB(1, 0), cB + kstep, voffB); PG8_STAGE(PG8_SA(1, 0), cA + kstep, vAc0); PG8_STAGE(PG8_SB(1, 1), cB + hstep + kstep, voffB);
        PG8_WAIT_V(6); PG8_BAR;
    }
    for (;;) {
        const bool has_next = S.next(ui + 1, nxt);
        if (has_next) { PG8_SETA(vAn0, vAn1, nxt); } else { vAn0[0] = vAc0[0]; vAn0[1] = vAc0[1]; vAn1[0] = vAc1[0]; vAn1[1] = vAc1[1]; }
        const char* nB = has_next ? (const char*)g.Bt + (size_t)nxt.pn * tstep : cB;
#pragma unroll 1
        for (int t = 0; t < nt; t += 2) {
            const bool last = (t == nt - 2);
            const char* a1 = cA + (size_t)(t + 1) * kstep;
            const char* a2 = last ? cA : cA + (size_t)(t + 2) * kstep; unsigned w0[2], w1[2]; w0[0] = last ? vAn0[0] : vAc0[0]; w0[1] = last ? vAn0[1] : vAc0[1]; w1[0] = last ? vAn1[0] : vAc1[0]; w1[1] = last ? vAn1[1] : vAc1[1]; const char* b2 = last ? nB : cB + (size_t)(t + 2) * kstep;
            const char* a3 = a2 + kstep; const char* b3 = b2 + kstep;
            if constexpr (SP2) {
            PG8_LDB(B0, 0, 0); PG8_LDB(B1, 0, 1); PG8_SCHED; PG8_LDA(At, 0, 0); PG8_STAGE(PG8_SA(1, 1), a1, vAc1);
            PG8_WAIT_V(8); PG8_WAIT_L(0); PG8_BAR; PG8_MMA(0, 0, At, B0); PG8_MMA(0, 1, At, B1); PG8_BAR; PG8_SCHED;
            PG8_LDA(At, 0, 1); PG8_STAGE(PG8_SB(0, 0), b2, voffB); PG8_STAGE(PG8_SB(0, 1), b2 + hstep, voffB); PG8_STAGE(PG8_SA(0, 0), a2, w0);
            PG8_WAIT_V(8); PG8_WAIT_L(0); PG8_BAR; PG8_MMA(1, 0, At, B0); PG8_MMA(1, 1, At, B1); PG8_BAR; PG8_SCHED;
            PG8_LDB(B0, 1, 0); PG8_LDB(B1, 1, 1); PG8_SCHED; PG8_LDA(At, 1, 0); PG8_STAGE(PG8_SA(0, 1), a2, w1);
            PG8_WAIT_V(8); PG8_WAIT_L(0); PG8_BAR; PG8_MMA(0, 0, At, B0); PG8_MMA(0, 1, At, B1); PG8_BAR; PG8_SCHED;
            PG8_LDA(At, 1, 1); PG8_STAGE(PG8_SB(1, 0), b3, voffB); PG8_STAGE(PG8_SB(1, 1), b3 + hstep, voffB); PG8_STAGE(PG8_SA(1, 0), a3, w0);
            PG8_WAIT_V(8); PG8_WAIT_L(0); PG8_BAR; PG8_MMA(1, 0, At, B0); PG8_MMA(1, 1, At, B1); PG8_BAR; PG8_SCHED;
            } else {
            PG8_LDB(B0, 0, 0); PG8_SCHED; PG8_LDA(At, 0, 0); PG8_STAGE(PG8_SA(1, 1), a1, vAc1);
            PG8_WAIT_L(8); PG8_BAR; PG8_WAIT_L(0); PG8_MMA(0, 0, At, B0); PG8_BAR; PG8_SCHED;
            PG8_LDB(B1, 0, 1); PG8_STAGE(PG8_SB(0, 0), b2, voffB);
            PG8_BAR; PG8_WAIT_L(0); PG8_MMA(0, 1, At, B1); PG8_BAR;
            PG8_LDA(At, 0, 1); PG8_STAGE(PG8_SA(0, 0), a2, w0);
            PG8_BAR; PG8_WAIT_L(0); PG8_MMA(1, 0, At, B0); PG8_BAR; PG8_SCHED;
            PG8_STAGE(PG8_SB(0, 1), b2 + hstep, voffB);
            PG8_WAIT_V(6); PG8_BAR; PG8_MMA(1, 1, At, B1); PG8_BAR;
            PG8_LDB(B0, 1, 0); PG8_SCHED; PG8_LDA(At, 1, 0); PG8_STAGE(PG8_SA(0, 1), a2, w1);
            PG8_WAIT_L(8); PG8_BAR; PG8_WAIT_L(0); PG8_MMA(0, 0, At, B0); PG8_BAR; PG8_SCHED;
            PG8_LDB(B1, 1, 1); PG8_STAGE(PG8_SB(1, 0), b3, voffB);
            PG8_BAR; PG8_WAIT_L(0); PG8_MMA(0, 1, At, B1); PG8_BAR;
            PG8_LDA(At, 1, 1); PG8_STAGE(PG8_SA(1, 0), a3, w0);
            PG8_BAR; PG8_WAIT_L(0); PG8_MMA(1, 0, At, B0); PG8_BAR; PG8_SCHED;
            PG8_STAGE(PG8_SB(1, 1), b3 + hstep, voffB);
            PG8_WAIT_V(6); PG8_BAR; PG8_MMA(1, 1, At, B1); PG8_BAR;
            }
        }
        if constexpr (ALIGN_EPI) { if (wr == 0) PG8_BAR; }
        { E(acc, cur, wr, wc, fr, fq); }
        if (!has_next) break;
#pragma unroll
        for (int a = 0; a < 2; ++a)
#pragma unroll
            for (int b = 0; b < 2; ++b)
#pragma unroll
                for (int m = 0; m < 4; ++m)
#pragma unroll
                    for (int n = 0; n < 2; ++n) acc[a][b][m][n] = (f32x4){0.f, 0.f, 0.f, 0.f};
        cur = nxt; cB = nB; ++ui; vAc0[0] = vAn0[0]; vAc0[1] = vAn0[1]; vAc1[0] = vAn1[0]; vAc1[1] = vAn1[1];
        if constexpr (ALIGN_EPI) { if (wr == 1) PG8_BAR; }
    }
    PG8_WAIT_V(0);
    if constexpr (!ALIGN_EPI) { if (wr == 0) PG8_BAR; }
    PG8_BAR;

#undef PG8_SETA
#undef PG8_SA
#undef PG8_SB
#undef PG8_STAGE
#undef PG8_LDA
#undef PG8_LDB
#undef PG8_MMA
#undef PG8_WAIT_V
#undef PG8_WAIT_L
#undef PG8_BAR
#undef PG8_SCHED
}

struct EpiInProj {
    static constexpr bool PERM = true, AFTER_DRAIN = false;
    bf16* PL;
    __device__ __forceinline__ void operator()(const f32x4 (&acc)[2][2][4][2], const Unit& u, int wr, int wc, int fr, int fq) const {
        const int p = u.pn >> 2; const bool act = (p == 0) || (p == 4);
        bf16* base = PL + (size_t)p * ((size_t)M_ALL * D);
        const int col0 = (u.pn & 3) * BM + wc * 32 + 8 * fq, row0 = u.pm * BM + wr * 64 + fr;
#pragma unroll
        for (int ai = 0; ai < 2; ++ai)
#pragma unroll
            for (int m = 0; m < 4; ++m) { bf16* rowp = base + (size_t)(row0 + ai * 128 + m * 16) * D + col0;
#pragma unroll
                for (int bj = 0; bj < 2; ++bj) { f32x4 v0 = acc[ai][bj][m][0], v1 = acc[ai][bj][m][1];
                    if (act) {
#pragma unroll
                        for (int j = 0; j < 4; ++j) { v0[j] = siluf_(v0[j]); v1[j] = siluf_(v1[j]); } }
                    v4u w; w.x = pk2(v0[0], v0[1]); w.y = pk2(v0[2], v0[3]); w.z = pk2(v1[0], v1[1]); w.w = pk2(v1[2], v1[3]);
                    *(v4u*)(rowp + bj * 128) = w; } }
    }
};
struct EpiBf16Plain {
    static constexpr bool PERM = true, AFTER_DRAIN = false;
    bf16* O; int ldc;
    __device__ __forceinline__ void operator()(const f32x4 (&acc)[2][2][4][2], const Unit& u, int wr, int wc, int fr, int fq) const {
        const int col0 = u.pn * BM + wc * 32 + 8 * fq, row0 = u.pm * BM + wr * 64 + fr;
#pragma unroll
        for (int ai = 0; ai < 2; ++ai)
#pragma unroll
            for (int m = 0; m < 4; ++m) { bf16* rowp = O + (size_t)(row0 + ai * 128 + m * 16) * ldc + col0;
#pragma unroll
                for (int bj = 0; bj < 2; ++bj) { const f32x4 v0 = acc[ai][bj][m][0], v1 = acc[ai][bj][m][1];
                    v4u w; w.x = pk2(v0[0], v0[1]); w.y = pk2(v0[2], v0[3]); w.z = pk2(v1[0], v1[1]); w.w = pk2(v1[2], v1[3]);
                    *(v4u*)(rowp + bj * 128) = w; } }
    }
};
struct EpiDown {
    static constexpr bool PERM = true, AFTER_DRAIN = false;
    bf16* O;
    __device__ __forceinline__ void operator()(const f32x4 (&acc)[2][2][4][2], const Unit& u, int wr, int wc, int fr, int fq) const {
        const int col0 = (u.pn & 3) * BM + wc * 32 + 8 * fq, row0 = u.pm * BM + wr * 64 + fr;
#pragma unroll
        for (int ai = 0; ai < 2; ++ai)
#pragma unroll
            for (int m = 0; m < 4; ++m) { bf16* rowp = O + (size_t)(row0 + ai * 128 + m * 16) * D + col0;
#pragma unroll
                for (int bj = 0; bj < 2; ++bj) { const f32x4 v0 = acc[ai][bj][m][0], v1 = acc[ai][bj][m][1];
                    v4u w; w.x = pk2(v0[0], v0[1]); w.y = pk2(v0[2], v0[3]); w.z = pk2(v1[0], v1[1]); w.w = pk2(v1[2], v1[3]);
                    *(v4u*)(rowp + bj * 128) = w; } }
    }
};
struct EpiGateUp {
    static constexpr bool PERM = true, AFTER_DRAIN = false;
    bf16* ACT;
    __device__ __forceinline__ void operator()(const f32x4 (&acc)[2][2][4][2], const Unit& u, int wr, int wc, int fr, int fq) const {
        const int col0 = (u.pn & 1) * 128 + wc * 32 + 8 * fq, row0 = u.pm * BM + wr * 64 + fr;
#pragma unroll
        for (int ai = 0; ai < 2; ++ai)
#pragma unroll
            for (int m = 0; m < 4; ++m) { bf16* rowp = ACT + (size_t)(row0 + ai * 128 + m * 16) * DE + col0;
                f32x4 v0, v1;
#pragma unroll
                for (int j = 0; j < 4; ++j) { v0[j] = siluf_(acc[ai][0][m][0][j]) * acc[ai][1][m][0][j]; v1[j] = siluf_(acc[ai][0][m][1][j]) * acc[ai][1][m][1][j]; }
                v4u w; w.x = pk2(v0[0], v0[1]); w.y = pk2(v0[2], v0[3]); w.z = pk2(v1[0], v1[1]); w.w = pk2(v1[2], v1[3]);
                *(v4u*)rowp = w; }
    }
};
struct EpiGrp {
    static constexpr bool PERM = true, AFTER_DRAIN = false;
    bf16* O; const float* ps;
    __device__ __forceinline__ void operator()(const f32x4 (&acc)[2][2][4][2], const Unit& u, int wr, int wc, int fr, int fq) const {
        const int col0 = u.pn * BM + wc * 32 + 8 * fq, row0 = (u.pm & 63) * BM + wr * 64 + fr;
#pragma unroll
        for (int bj = 0; bj < 2; ++bj) {
            const f32x4 s0 = *(const f32x4*)(ps + col0 + bj * 128), s1 = *(const f32x4*)(ps + col0 + bj * 128 + 4);
#pragma unroll
            for (int ai = 0; ai < 2; ++ai)
#pragma unroll
                for (int m = 0; m < 4; ++m) { bf16* rowp = O + (size_t)(row0 + ai * 128 + m * 16) * D + col0 + bj * 128;
                    const f32x4 v0 = acc[ai][bj][m][0] * s0, v1 = acc[ai][bj][m][1] * s1;
                    v4u w; w.x = pk2(v0[0], v0[1]); w.y = pk2(v0[2], v0[3]); w.z = pk2(v1[0], v1[1]); w.w = pk2(v1[2], v1[3]);
                    *(v4u*)rowp = w; }
        }
    }
};
struct EpiResid {
    static constexpr bool PERM = false, AFTER_DRAIN = false;
    const float* xin_lat; const float* xin_ctx; float* out_lat; float* out_ctx; const float* gate;
    __device__ __forceinline__ void operator()(const f32x4 (&acc)[2][2][4][2], const Unit& u, int wr, int wc, int fr, int fq) const {
        const int col0 = u.pn * BM + wc * 32 + 4 * fq, row0 = u.pm * BM + wr * 64 + fr;
        const bool isctx = row0 >= M_LAT;
        const int bidx = isctx ? 4 : (row0 / SEQ);
        const float* xin = isctx ? xin_ctx - (size_t)M_LAT * D : xin_lat; float* out = isctx ? out_ctx - (size_t)M_LAT * D : out_lat;
        const float* gp = gate + (size_t)bidx * 6144 + col0;
        f32x4 gv[2][2];
#pragma unroll
        for (int bj = 0; bj < 2; ++bj)
#pragma unroll
            for (int n = 0; n < 2; ++n) gv[bj][n] = *(const f32x4*)(gp + bj * 128 + n * 16);
#pragma unroll
        for (int ai = 0; ai < 2; ++ai)
#pragma unroll
            for (int m = 0; m < 4; ++m) { const size_t ro = (size_t)(row0 + ai * 128 + m * 16) * D + col0;
#pragma unroll
                for (int bj = 0; bj < 2; ++bj)
#pragma unroll
                    for (int n = 0; n < 2; ++n) { const f32x4 xv = *(const f32x4*)(xin + ro + bj * 128 + n * 16);
                        *(f32x4*)(out + ro + bj * 128 + n * 16) = xv + gv[bj][n] * acc[ai][bj][m][n]; } }
    }
};

struct Frame {
    LAS unsigned char* lds; volatile LAS unsigned* MISC; gu32* ctl;
    int tid, lane, wave, G, bid;
    const float* in[23]; float* out; unsigned char* ws;
};
__device__ __forceinline__ const float* modv(const Frame& F, int l, int b, int j) { return (const float*)(F.ws + WS_MODV) + ((size_t)l * 5 + b) * 6144 + j * 1024; }

__device__ __forceinline__ void transpose_item(const float* W, int N, int k0, int n0, bf16* WT, int KT, size_t dst_row0, LAS float* scr, int lane) {
#pragma unroll 8
    for (int i = 0; i < 32; ++i) { const int kk = 2 * i + (lane >> 5); scr[kk * 33 + (lane & 31)] = W[(size_t)(k0 + kk) * N + n0 + (lane & 31)]; }
    LDS_WAIT(); asm volatile("" ::: "memory");
    const int c = lane & 7;
#pragma unroll
    for (int j = 0; j < 4; ++j) { const int n = (lane >> 3) + 8 * j; const LAS float* s = scr + (8 * c) * 33 + n;
        v4u o; o.x = pk2(s[0 * 33], s[1 * 33]); o.y = pk2(s[2 * 33], s[3 * 33]); o.z = pk2(s[4 * 33], s[5 * 33]); o.w = pk2(s[6 * 33], s[7 * 33]);
        *(v4u*)(WT + (dst_row0 + n) * KT + k0 + 8 * c) = o; }
    LDS_WAIT(); asm volatile("" ::: "memory");
}
__device__ __forceinline__ void conv_moe_item(const Frame& F, int l, int r, bf16* WGU, bf16* WD, LAS float* scr) {
    const int kind = r >> 11, rr = r & 2047, e = rr >> 7, it = rr & 127;
    if (kind < 2) { const float* W = (kind ? F.in[20] : F.in[19]) + (size_t)(l * NE + e) * D * DE; const int kb = it >> 3, nb = it & 7, n0 = 32 * nb;
        transpose_item(W, DE, 64 * kb, n0, WGU, D, (size_t)e * 512 + (n0 >> 7) * 256 + kind * 128 + (n0 & 127), scr, F.lane); }
    else { const float* W = F.in[21] + (size_t)(l * NE + e) * DE * D; const int kb = it >> 5, nb = it & 31;
        transpose_item(W, D, 64 * kb, 32 * nb, WD, DE, (size_t)e * D + 32 * nb, scr, F.lane); }
}

__device__ __forceinline__ void p0_prep(Frame& F) {
    if (F.bid < 192) {
        LAS float* sil = (LAS float*)(F.lds);
        LAS float* red = (LAS float*)(F.lds + 32768);
        for (int i = F.tid; i < 5 * D; i += NTHR) { const float cv = (i < 4 * D) ? F.in[1][i] : F.in[3][i - 4 * D]; sil[i] = siluf_(cv); }
        __syncthreads();
        const int l = F.bid / 96, col0 = (F.bid % 96) * 64;
        const float* W = F.in[4] + (size_t)l * D * 6144 + col0 + F.lane;
        float a0 = 0.f, a1 = 0.f, a2 = 0.f, a3 = 0.f, a4 = 0.f;
        const int kbeg = F.wave * 128;
#pragma unroll 8
        for (int k = kbeg; k < kbeg + 128; ++k) { const float w = W[(size_t)k * 6144];
            a0 += sil[k] * w; a1 += sil[D + k] * w; a2 += sil[2 * D + k] * w; a3 += sil[3 * D + k] * w; a4 += sil[4 * D + k] * w; }
        red[(F.wave * 5 + 0) * 64 + F.lane] = a0; red[(F.wave * 5 + 1) * 64 + F.lane] = a1; red[(F.wave * 5 + 2) * 64 + F.lane] = a2;
        red[(F.wave * 5 + 3) * 64 + F.lane] = a3; red[(F.wave * 5 + 4) * 64 + F.lane] = a4;
        __syncthreads();
        if (F.tid < 320) { const int b = F.tid >> 6, cc = F.tid & 63; float s = 0.f;
#pragma unroll
            for (int w = 0; w < 8; ++w) s += red[(w * 5 + b) * 64 + cc];
            ((float*)(F.ws + WS_MODV))[((size_t)l * 5 + b) * 6144 + col0 + cc] = s + F.in[5][l * 6144 + col0 + cc]; }
        __syncthreads();
    }
    LAS float* scr = (LAS float*)(F.lds + F.wave * 16384);
    const int gw = F.bid * NWAVES + F.wave, NGW = F.G * NWAVES;
    constexpr int I_IN = 16 * 160, I_OUT = 16 * 32, I_MOE = 6144;
    for (int it = gw; it < I_IN + I_OUT + I_MOE; it += NGW) {
        int r = it;
        if (r < I_IN) { const int kb = r / 160, nb = r % 160; transpose_item(F.in[8], NPROJ * D, 64 * kb, 32 * nb, (bf16*)(F.ws + WS_WHGIN), D, (size_t)32 * nb, scr, F.lane); continue; } r -= I_IN;
        if (r < I_OUT) { const int kb = r >> 5, nb = r & 31; transpose_item(F.in[12], D, 64 * kb, 32 * nb, (bf16*)(F.ws + WS_WHGOUT), D, (size_t)32 * nb, scr, F.lane); continue; } r -= I_OUT;
        conv_moe_item(F, 0, r, (bf16*)(F.ws + WS_WGU0), (bf16*)(F.ws + WS_WD0), scr);
    }
}
__device__ __forceinline__ void conv_layer1(Frame& F) {
    LAS float* scr = (LAS float*)(F.lds + F.wave * 16384);
    const int gw = F.bid * NWAVES + F.wave, NGW = F.G * NWAVES;
    constexpr int I_SQ = 16 * 32, I_GRP = 4 * 4 * 8, I_MOE = 6144;
    for (int it = gw; it < 2 * I_SQ + I_GRP + I_MOE; it += NGW) {
        int r = it;
        if (r < I_SQ) { const int kb = r >> 5, nb = r & 31; transpose_item(F.in[13], D, 64 * kb, 32 * nb, (bf16*)(F.ws + WS_WPIN), D, (size_t)32 * nb, scr, F.lane); continue; } r -= I_SQ;
        if (r < I_SQ) { const int kb = r >> 5, nb = r & 31; transpose_item(F.in[16], D, 64 * kb, 32 * nb, (bf16*)(F.ws + WS_WPOUT), D, (size_t)32 * nb, scr, F.lane); continue; } r -= I_SQ;
        if (r < I_GRP) { const int g = r >> 5, q = r & 31, kb = q >> 3, nb = q & 7;
            transpose_item(F.in[14] + (size_t)g * 256 * 256, 256, 64 * kb, 32 * nb, (bf16*)(F.ws + WS_WGRP), 256, (size_t)g * 256 + 32 * nb, scr, F.lane); continue; } r -= I_GRP;
        conv_moe_item(F, 1, r, (bf16*)(F.ws + WS_WGU1), (bf16*)(F.ws + WS_WD1), scr);
    }
}

__device__ __forceinline__ void modulate_row(const f32x4 (&v)[4], const float* g, const float* sh, const float* sc, bf16* orow, int lane) {
    float s2 = 0.f;
#pragma unroll
    for (int j = 0; j < 4; ++j) s2 += (v[j].x * v[j].x + v[j].y * v[j].y) + (v[j].z * v[j].z + v[j].w * v[j].w);
    const float rstd = 1.f / sqrtf(wave_sum(s2) * (1.f / D) + EPS);
    unsigned long long* o8 = (unsigned long long*)orow + lane;
#pragma unroll
    for (int j = 0; j < 4; ++j) { const int c = 4 * lane + 256 * j;
        const f32x4 gv = *(const f32x4*)(g + c), shv = *(const f32x4*)(sh + c), scv = *(const f32x4*)(sc + c);
        const f32x4 h = v[j] * rstd * gv * (scv + 1.f) + shv;
        o8[64 * j] = (unsigned long long)pk2(h.x, h.y) | ((unsigned long long)pk2(h.z, h.w) << 32); }
}
__device__ __forceinline__ void p1_modulate0(Frame& F) {
    const int gw = F.bid * NWAVES + F.wave, NGW = F.G * NWAVES;
    bf16* H = (bf16*)(F.ws + WS_H);
    for (int row = gw; row < M_ALL; row += NGW) {
        const bool isctx = row >= M_LAT; const int b = isctx ? 4 : row / SEQ;
        const float* xr = isctx ? F.in[2] + (size_t)(row - M_LAT) * D : F.in[0] + (size_t)row * D;
        f32x4 v[4];
#pragma unroll
        for (int j = 0; j < 4; ++j) v[j] = ((const f32x4*)xr)[F.lane + 64 * j];
        modulate_row(v, F.in[6], modv(F, 0, b, 0), modv(F, 0, b, 1), H + (size_t)row * D, F.lane);
    }
}

__device__ __forceinline__ void p3_scan_naive(Frame& F) {
    if (F.bid >= 64) return;
    const int b = F.bid >> 4, h = (F.bid >> 1) & 7, dir = F.bid & 1;
    const bf16* PQ = (const bf16*)(F.ws + WS_PL), *PV = PQ + (size_t)M_ALL * D, *PZ = PQ + (size_t)(2 + dir) * M_ALL * D;
    bf16* OL = (bf16*)F.out + (size_t)dir * M_LAT * D; bf16* OC = (bf16*)(F.ws + (dir ? WS_OBC : WS_OFC));
    LAS float* fl = (LAS float*)F.lds, *kl = fl + 128, *ql = fl + 256, *ored = fl + 384;
    const int v = F.tid & 127, kq = F.tid >> 7;
    float lbv = 0.f;
    if (F.tid < 128) { const float* lb = dir ? F.in[10] : F.in[9]; lbv = sigmoidf_(lb[h * DH + F.tid] - lb[D + h * DH + F.tid]); }
    float S[32];
#pragma unroll
    for (int j = 0; j < 32; ++j) S[j] = 0.f;
    for (int s = 0; s < CTXL + SEQ; ++s) {
        int row;
        if (s < CTXL) row = M_LAT + b * CTXL + (dir ? CTXL - 1 - s : s);
        else row = b * SEQ + (dir ? SEQ - 1 - (s - CTXL) : s - CTXL);
        const size_t off = (size_t)row * D + h * DH;
        if (F.tid < 128) { const float z = bf2f(PZ[off + F.tid]); const float sg = sigmoidf_(z);
            fl[F.tid] = lbv + (1.f - lbv) * sg; kl[F.tid] = (1.f - lbv) * (1.f - sg); ql[F.tid] = bf2f(PQ[off + F.tid]); }
        const float vv = bf2f(PV[off + v]);
        __syncthreads();
        float po = 0.f;
#pragma unroll
        for (int j = 0; j < 32; ++j) { const int k = 32 * kq + j; S[j] = fl[k] * S[j] + kl[k] * vv; po += S[j] * ql[k]; }
        ored[kq * 128 + v] = po;
        __syncthreads();
        if (kq == 0) { const float o = (ored[v] + ored[128 + v]) + (ored[256 + v] + ored[384 + v]);
            if (s >= CTXL) OL[(size_t)row * D + h * DH + v] = (bf16)f2bf(o);
            else if (CTX_FULL) OC[(size_t)(row - M_LAT) * D + h * DH + v] = (bf16)f2bf(o); }
    }
}

typedef float f32x16 __attribute__((ext_vector_type(16)));
typedef float f32x2 __attribute__((ext_vector_type(2)));
#define MFMA32(a, b, c) __builtin_amdgcn_mfma_f32_32x32x16_bf16((a), (b), (c), 0, 0, 0)
__device__ __forceinline__ int crow(int reg, int h) { return (reg & 3) + 8 * (reg >> 2) + 4 * h; }
__device__ __forceinline__ int t256_off(int row, int cb) { return row * 256 + ((((cb >> 4) ^ (row & 15)) << 4) | (cb & 15)); }
__device__ __forceinline__ int t128_off(int row, int cb) { return row * 128 + ((((cb >> 4) ^ ((row >> 1) & 7)) << 4) | (cb & 15)); }
__device__ __forceinline__ bf16x8 pack8(const f32x16& x, int s) {
    v4u p; p.x = pk2(x[8 * s], x[8 * s + 1]); p.y = pk2(x[8 * s + 2], x[8 * s + 3]); p.z = pk2(x[8 * s + 4], x[8 * s + 5]); p.w = pk2(x[8 * s + 6], x[8 * s + 7]);
    return __builtin_bit_cast(bf16x8, p);
}
__device__ __forceinline__ void p3_scan(Frame& F) {
    constexpr int SC_QE = 0, SC_QC = 16384, SC_KR = 32768, SC_KRT = 49152, SC_VT = 65536, SC_ST = 69632, SC_TOT = 77824, SC_VEC = 81920, SC_SLOT = 83968;
    constexpr int NCH = (CTXL + SEQ) / 64;
    LAS unsigned char* L = F.lds;
    const int tid = F.tid, lane = F.lane, w = F.wave, r = lane & 31, hh = lane >> 5;
    const bf16* PQ = (const bf16*)(F.ws + WS_PL); const bf16* PV = PQ + (size_t)M_ALL * D;
    f32x16 zero16;
#pragma unroll
    for (int i = 0; i < 16; ++i) zero16[i] = 0.f;
    for (int item = F.bid; item < 256; item += F.G) {
        const int dvs = (item >> 3) & 3, bhd = (item >> 5) * 8 + (item & 7), b = bhd >> 4, h = (bhd >> 1) & 7, dir = bhd & 1;
        const bf16* PZ = PQ + (size_t)(2 + dir) * M_ALL * D;
        const float* lbp = dir ? F.in[10] : F.in[9];
        const int c0 = 2 * lane, colq = h * DH + c0, colv = h * DH + dvs * 32;
        const float lb0 = sigmoidf_(lbp[colq] - lbp[D + colq]), lb1 = sigmoidf_(lbp[colq + 1] - lbp[D + colq + 1]);
        bf16* OL = (bf16*)F.out + (size_t)dir * M_LAT * D; bf16* OC = (bf16*)(F.ws + (dir ? WS_OBC : WS_OFC));
        const int sgn = dir ? -1 : 1;
        __syncthreads();
        for (int i = tid; i < 8192 / 16; i += NTHR) ((LAS v4u*)(L + SC_ST))[i] = (v4u){0u, 0u, 0u, 0u};
        f32x16 S0 = zero16, S1 = zero16;
        unsigned zr[8], qr[8]; v4u vr = {0u, 0u, 0u, 0u};
#define SCAN_BASE(n) (((n) < 4) ? (M_LAT + b * CTXL + (dir ? CTXL - 1 - 64 * (n) : 64 * (n))) : (b * SEQ + (dir ? SEQ - 1 - 64 * ((n) - 4) : 64 * ((n) - 4))))
#define SCAN_LOAD(n) do { const int _base = SCAN_BASE(n); \
            _Pragma("unroll") for (int _i = 0; _i < 8; ++_i) { const size_t _o = (size_t)(_base + sgn * (8 * w + _i)) * D + colq; zr[_i] = *(const unsigned*)(PZ + _o); qr[_i] = *(const unsigned*)(PQ + _o); } \
            if (tid < 256) vr = *(const v4u*)(PV + (size_t)(_base + sgn * (tid >> 2)) * D + colv + 8 * (tid & 3)); } while (0)
        SCAN_LOAD(0);
        for (int n = 0; n < NCH; ++n) {
            float cs0[8], cs1[8], kk0[8], kk1[8], q0[8], q1[8];
            float run0 = 0.f, run1 = 0.f;
#pragma unroll
            for (int i = 0; i < 8; ++i) { const float sg0 = sigmoidf_(bflo(zr[i])), sg1 = sigmoidf_(bfhi(zr[i]));
                run0 += __logf(lb0 + (1.f - lb0) * sg0); run1 += __logf(lb1 + (1.f - lb1) * sg1); cs0[i] = run0; cs1[i] = run1;
                kk0[i] = (1.f - lb0) * (1.f - sg0); kk1[i] = (1.f - lb1) * (1.f - sg1); q0[i] = bflo(qr[i]); q1[i] = bfhi(qr[i]); }
            *(LAS f32x2*)(L + SC_TOT + (w * 128 + c0) * 4) = (f32x2){run0, run1};
            if (tid < 256) { const int p = tid >> 2, c8 = tid & 3;
#pragma unroll
                for (int j = 0; j < 8; ++j) { const unsigned hv = (vr[j >> 1] >> (16 * (j & 1))) & 0xffffu; *(LAS unsigned short*)(L + SC_VT + t128_off(8 * c8 + j, 2 * p)) = (unsigned short)hv; } }
            __syncthreads();
            float off0 = 0.f, off1 = 0.f, ref0 = 0.f, ref1 = 0.f, last0 = 0.f, last1 = 0.f;
#pragma unroll
            for (int ww = 0; ww < 8; ++ww) { const f32x2 t2 = *(const LAS f32x2*)(L + SC_TOT + (ww * 128 + c0) * 4); const float t0 = t2.x, t1 = t2.y;
                off0 += (ww < w) ? t0 : 0.f; off1 += (ww < w) ? t1 : 0.f; if (ww < 4) { ref0 += t0; ref1 += t1; } last0 += t0; last1 += t1; }
            unsigned krp0[4], krp1[4];
#pragma unroll
            for (int i = 0; i < 8; i += 2) {
                float kra[2], krb[2];
#pragma unroll
                for (int u = 0; u < 2; ++u) { const int ii = i + u, srow = 8 * w + ii;
                    const float cum0 = off0 + cs0[ii], cum1 = off1 + cs1[ii];
                    const float E0 = __expf(cum0 - ref0), E1 = __expf(cum1 - ref1), R0 = __expf(ref0 - cum0), R1 = __expf(ref1 - cum1), C0 = __expf(cum0), C1 = __expf(cum1);
                    kra[u] = kk0[ii] * R0; krb[u] = kk1[ii] * R1;
                    *(LAS unsigned*)(L + SC_QE + t256_off(srow, 2 * c0)) = pk2(q0[ii] * E0, q1[ii] * E1);
                    *(LAS unsigned*)(L + SC_QC + t256_off(srow, 2 * c0)) = pk2(q0[ii] * C0, q1[ii] * C1);
                    *(LAS unsigned*)(L + SC_KR + t256_off(srow, 2 * c0)) = pk2(kra[u], krb[u]); }
                krp0[i >> 1] = pk2(kra[0], kra[1]); krp1[i >> 1] = pk2(krb[0], krb[1]);
            }
            *(LAS v4u*)(L + SC_KRT + t128_off(c0, 16 * w)) = (v4u){krp0[0], krp0[1], krp0[2], krp0[3]};
            *(LAS v4u*)(L + SC_KRT + t128_off(c0 + 1, 16 * w)) = (v4u){krp1[0], krp1[1], krp1[2], krp1[3]};
            if (w == 0) { *(LAS f32x2*)(L + SC_VEC + c0 * 4) = (f32x2){__expf(last0), __expf(last1)};
                *(LAS f32x2*)(L + SC_VEC + 512 + c0 * 4) = (f32x2){__expf(last0 - ref0), __expf(last1 - ref1)}; }
            if (n + 1 < NCH) SCAN_LOAD(n + 1);
            __syncthreads();
            if (w < 3) {
                const int sb = (w == 2) ? 1 : 0, cb = (w == 0) ? 0 : 1;
                f32x16 x = zero16;
#pragma unroll
                for (int ks = 0; ks < 8; ++ks) { const int cbyte = (16 * ks + 8 * hh) * 2;
                    const bf16x8 a = *(const LAS bf16x8*)(L + SC_KR + t256_off(32 * sb + r, cbyte)), bq = *(const LAS bf16x8*)(L + SC_QE + t256_off(32 * cb + r, cbyte));
                    x = MFMA32(a, bq, x); }
                if (sb == cb) {
#pragma unroll
                    for (int g = 0; g < 16; ++g) x[g] = (crow(g, hh) > r) ? 0.f : x[g]; }
                f32x16 o = zero16;
#pragma unroll
                for (int sp = 0; sp < 2; ++sp) { const bf16x8 pa = pack8(x, sp); const int s0 = 32 * sb + 16 * sp + 4 * hh;
                    const v2u lo = *(const LAS v2u*)(L + SC_VT + t128_off(r, 2 * s0)), hi = *(const LAS v2u*)(L + SC_VT + t128_off(r, 2 * (s0 + 8)));
                    const bf16x8 vb = __builtin_bit_cast(bf16x8, ((v4u){lo.x, lo.y, hi.x, hi.y}));
                    o = MFMA32(pa, vb, o); }
#pragma unroll
                for (int g = 0; g < 16; ++g) *(LAS float*)(L + SC_SLOT + w * 4096 + (crow(g, hh) * 32 + r) * 4) = o[g];
            } else if (w < 5) {
                const int cb = w - 3; f32x16 o = zero16;
#pragma unroll
                for (int ks = 0; ks < 8; ++ks) { const int cbyte = (16 * ks + 8 * hh) * 2;
                    const bf16x8 a = *(const LAS bf16x8*)(L + SC_QC + t256_off(32 * cb + r, cbyte)), bs = *(const LAS bf16x8*)(L + SC_ST + t256_off(r, cbyte));
                    o = MFMA32(a, bs, o); }
#pragma unroll
                for (int g = 0; g < 16; ++g) *(LAS float*)(L + SC_SLOT + w * 4096 + (crow(g, hh) * 32 + r) * 4) = o[g];
            } else if (w < 7) {
#define SCAN_KV(ST_, kb_) do { f32x16 kv = zero16; \
                    _Pragma("unroll") for (int ks = 0; ks < 4; ++ks) { const int sbyte = (16 * ks + 8 * hh) * 2; \
                        const bf16x8 a = *(const LAS bf16x8*)(L + SC_KRT + t128_off(32 * (kb_) + r, sbyte)), bv = *(const LAS bf16x8*)(L + SC_VT + t128_off(r, sbyte)); \
                        kv = MFMA32(a, bv, kv); } \
                    _Pragma("unroll") for (int g = 0; g < 16; ++g) { const int k = 32 * (kb_) + crow(g, hh); \
                        ST_[g] = *(const LAS float*)(L + SC_VEC + k * 4) * ST_[g] + *(const LAS float*)(L + SC_VEC + 512 + k * 4) * kv[g]; } } while (0)
                const int kb0 = 2 * (w - 5);
                SCAN_KV(S0, kb0); SCAN_KV(S1, kb0 + 1);
            }
            __syncthreads();
            { const int c = tid >> 3, v0 = (tid & 7) * 4, cl = c & 31; const int so = (cl * 32 + v0) * 4;
              f32x4 o;
              if (c < 32) o = *(const LAS f32x4*)(L + SC_SLOT + so) + *(const LAS f32x4*)(L + SC_SLOT + 3 * 4096 + so);
              else o = *(const LAS f32x4*)(L + SC_SLOT + 4096 + so) + *(const LAS f32x4*)(L + SC_SLOT + 2 * 4096 + so) + *(const LAS f32x4*)(L + SC_SLOT + 4 * 4096 + so);
              const int row = SCAN_BASE(n) + sgn * c;
              const v2u ov = {pk2(o.x, o.y), pk2(o.z, o.w)};
              if (n >= 4) *(v2u*)(OL + (size_t)row * D + colv + v0) = ov;
              else if (CTX_FULL) *(v2u*)(OC + (size_t)(row - M_LAT) * D + colv + v0) = ov; }
            if (w == 5 || w == 6) { const int kb0 = 2 * (w - 5);
#pragma unroll
                for (int g = 0; g < 4; ++g) {
                    *(LAS v2u*)(L + SC_ST + t256_off(r, 2 * (32 * kb0 + 8 * g + 4 * hh))) = (v2u){pk2(S0[4 * g], S0[4 * g + 1]), pk2(S0[4 * g + 2], S0[4 * g + 3])};
                    *(LAS v2u*)(L + SC_ST + t256_off(r, 2 * (32 * (kb0 + 1) + 8 * g + 4 * hh))) = (v2u){pk2(S1[4 * g], S1[4 * g + 1]), pk2(S1[4 * g + 2], S1[4 * g + 3])}; } }
        }
#undef SCAN_KV
#undef SCAN_LOAD
#undef SCAN_BASE
    }
}

__device__ __forceinline__ void p4_readout_prep(Frame& F) {
    const int gw = F.bid * NWAVES + F.wave, NGW = F.G * NWAVES;
    const bf16* SG = (const bf16*)(F.ws + WS_PL) + (size_t)4 * M_ALL * D; bf16* YP = (bf16*)(F.ws + WS_H);
    const int nrows = CTX_FULL ? M_ALL : M_LAT;
    for (int row = gw; row < nrows; row += NGW) {
        const bf16 *ofp, *obp;
        if (row < M_LAT) { ofp = (const bf16*)F.out + (size_t)row * D; obp = ofp + (size_t)M_LAT * D; }
        else { ofp = (const bf16*)(F.ws + WS_OFC) + (size_t)(row - M_LAT) * D; obp = (const bf16*)(F.ws + WS_OBC) + (size_t)(row - M_LAT) * D; }
        const int c0 = 16 * F.lane;
        const v4u f0 = *(const v4u*)(ofp + c0), f1 = *(const v4u*)(ofp + c0 + 8), b0 = *(const v4u*)(obp + c0), b1 = *(const v4u*)(obp + c0 + 8);
        const v4u g0 = *(const v4u*)(SG + (size_t)row * D + c0), g1 = *(const v4u*)(SG + (size_t)row * D + c0 + 8);
        float o[16]; float ss = 0.f;
#pragma unroll
        for (int q = 0; q < 4; ++q) { o[2 * q] = bflo(f0[q]) + bflo(b0[q]); o[2 * q + 1] = bfhi(f0[q]) + bfhi(b0[q]); o[8 + 2 * q] = bflo(f1[q]) + bflo(b1[q]); o[8 + 2 * q + 1] = bfhi(f1[q]) + bfhi(b1[q]); }
#pragma unroll
        for (int j = 0; j < 16; ++j) ss += o[j] * o[j];
        ss += __shfl_xor(ss, 1); ss += __shfl_xor(ss, 2); ss += __shfl_xor(ss, 4);
        const float rstd = 1.f / sqrtf(ss * (1.f / DH) + EPS);
        const float* gn = F.in[11] + (c0 & 127);
        float y[16];
#pragma unroll
        for (int q = 0; q < 4; ++q) { y[2 * q] = o[2 * q] * rstd * gn[2 * q] * bflo(g0[q]); y[2 * q + 1] = o[2 * q + 1] * rstd * gn[2 * q + 1] * bfhi(g0[q]);
            y[8 + 2 * q] = o[8 + 2 * q] * rstd * gn[8 + 2 * q] * bflo(g1[q]); y[8 + 2 * q + 1] = o[8 + 2 * q + 1] * rstd * gn[8 + 2 * q + 1] * bfhi(g1[q]); }
        v4u w0, w1;
#pragma unroll
        for (int q = 0; q < 4; ++q) { w0[q] = pk2(y[2 * q], y[2 * q + 1]); w1[q] = pk2(y[8 + 2 * q], y[8 + 2 * q + 1]); }
        *(v4u*)(YP + (size_t)row * D + c0) = w0; *(v4u*)(YP + (size_t)row * D + c0 + 8) = w1;
    }
    conv_layer1(F);
}

__device__ __forceinline__ void top2_of4(float a0, float a1, float a2, float a3, int& i1, int& i2, float& sum) {
    i1 = 0; float v1 = a0;
    if (a1 > v1) { v1 = a1; i1 = 1; }
    if (a2 > v1) { v1 = a2; i1 = 2; }
    if (a3 > v1) { v1 = a3; i1 = 3; }
    const float c0 = (i1 == 0) ? -1e30f : a0, c1 = (i1 == 1) ? -1e30f : a1, c2 = (i1 == 2) ? -1e30f : a2, c3 = (i1 == 3) ? -1e30f : a3;
    i2 = 0; float v2 = c0;
    if (c1 > v2) { v2 = c1; i2 = 1; }
    if (c2 > v2) { v2 = c2; i2 = 2; }
    if (c3 > v2) { v2 = c3; i2 = 3; }
    sum = v1 + v2;
}
__device__ __forceinline__ void route_row(Frame& F, int l, int row, const f32x4 (&v)[4], int b, LAS float* rw  ) {
    float s2 = 0.f;
#pragma unroll
    for (int j = 0; j < 4; ++j) s2 += (v[j].x * v[j].x + v[j].y * v[j].y) + (v[j].z * v[j].z + v[j].w * v[j].w);
    const float rstd = 1.f / sqrtf(wave_sum(s2) * (1.f / D) + EPS);
    const float* g = F.in[7] + l * D; const float* sh = modv(F, l, b, 3); const float* sc = modv(F, l, b, 4);
    unsigned long long* o8 = (unsigned long long*)((bf16*)(F.ws + WS_H) + (size_t)row * D) + F.lane;
    LAS float* hl = rw + D * NE + F.wave * D;
#pragma unroll
    for (int j = 0; j < 4; ++j) { const int c = 4 * F.lane + 256 * j;
        const f32x4 gv = *(const f32x4*)(g + c), shv = *(const f32x4*)(sh + c), scv = *(const f32x4*)(sc + c);
        const f32x4 h = v[j] * rstd * gv * (scv + 1.f) + shv;
        o8[64 * j] = (unsigned long long)pk2(h.x, h.y) | ((unsigned long long)pk2(h.z, h.w) << 32);
        *(LAS f32x4*)(hl + c) = h; }
    LDS_WAIT(); asm volatile("" ::: "memory");
    float part = 0.f;
    { const int e = F.lane & 15, k0 = (F.lane >> 4) * 256;
#pragma unroll 8
      for (int k = 0; k < 256; ++k) part += hl[k0 + k] * rw[(k0 + k) * 16 + e]; }
    part += __shfl_xor(part, 16); part += __shfl_xor(part, 32);
    LDS_WAIT(); asm volatile("" ::: "memory");
    float s[16], sel[16];
#pragma unroll
    for (int e = 0; e < 16; ++e) { s[e] = sigmoidf_(__shfl(part, e)); sel[e] = s[e] + F.in[18][e]; }
    int i1a, i2a, i1b, i2b, i1c, i2c, i1d, i2d; float gsa, gsb, gsc, gsd;
    top2_of4(sel[0], sel[1], sel[2], sel[3], i1a, i2a, gsa); top2_of4(sel[4], sel[5], sel[6], sel[7], i1b, i2b, gsb);
    top2_of4(sel[8], sel[9], sel[10], sel[11], i1c, i2c, gsc); top2_of4(sel[12], sel[13], sel[14], sel[15], i1d, i2d, gsd);
    int bpk = i1a | (i2a << 2); float bestv = gsa;
    { const bool c = gsb > bestv; bestv = c ? gsb : bestv; bpk = c ? (i1b | (i2b << 2) | 16) : bpk; }
    { const bool c = gsc > bestv; bestv = c ? gsc : bestv; bpk = c ? (i1c | (i2c << 2) | 32) : bpk; }
    { const bool c = gsd > bestv; bestv = c ? gsd : bestv; bpk = c ? (i1d | (i2d << 2) | 48) : bpk; }
    const int e1 = (bpk >> 4) * 4 + (bpk & 3), e2 = (bpk >> 4) * 4 + ((bpk >> 2) & 3);
    float s1 = 0.f, s2v = 0.f;
#pragma unroll
    for (int e = 0; e < 16; ++e) { s1 = (e == e1) ? s[e] : s1; s2v = (e == e2) ? s[e] : s2v; }
    const float inv = 1.f / (s1 + s2v);
    if (F.lane == 0) {
        unsigned* cnt = (unsigned*)(F.ctl + CW_CNT + 64 * l); unsigned* list = (unsigned*)(F.ws + WS_LIST);
        unsigned* slote = (unsigned*)(F.ws + WS_SLOTE); float* slotw = (float*)(F.ws + WS_SLOTW);
        const unsigned p1 = atomicAdd(cnt + e1, 1u); list[(size_t)e1 * LIST_CAP + p1] = (unsigned)row * 2u;
        const unsigned p2 = atomicAdd(cnt + e2, 1u); list[(size_t)e2 * LIST_CAP + p2] = (unsigned)row * 2u + 1u;
        slote[row * 2] = (unsigned)e1 | (p1 << 8); slote[row * 2 + 1] = (unsigned)e2 | (p2 << 8);
        slotw[row * 2] = s1 * inv; slotw[row * 2 + 1] = s2v * inv;
    }
}
__device__ __forceinline__ void p_route(Frame& F, int l) {
    LAS float* rw = (LAS float*)F.lds;
    for (int i = F.tid; i < D * NE / 4; i += NTHR) ((LAS f32x4*)rw)[i] = ((const f32x4*)F.in[17])[i];
    __syncthreads();
    const int gw = F.bid * NWAVES + F.wave, NGW = F.G * NWAVES;
    const int nrows = (l == 0 && CTX_FULL) ? M_ALL : M_LAT;
    for (int row = gw; row < nrows; row += NGW) {
        const bool isctx = row >= M_LAT; const int b = isctx ? 4 : row / SEQ;
        const float* xr = isctx ? (const float*)(F.ws + WS_XC) + (size_t)(row - M_LAT) * D : F.out + (size_t)row * D;
        f32x4 v[4];
#pragma unroll
        for (int j = 0; j < 4; ++j) v[j] = ((const f32x4*)xr)[F.lane + 64 * j];
        route_row(F, l, row, v, b, rw);
    }
    __syncthreads();
}
__device__ __forceinline__ void moe_prefix(Frame& F, int l) {
    if (F.tid == 0) { unsigned acc = 0;
        for (int e = 0; e < 16; ++e) { const unsigned c = __hip_atomic_load((unsigned*)(F.ctl + CW_CNT + 64 * l + e), RLX_AGENT); F.MISC[32 + e] = acc; F.MISC[32 + 17 + e] = c; acc += (c + 255u) >> 8; }
        F.MISC[32 + 16] = acc; }
    __syncthreads();
}
__device__ __forceinline__ void combine_row(Frame& F, int l, int row, int b, const volatile LAS unsigned* tb, f32x4 (&v)[4]) {
    const unsigned se0 = ((const unsigned*)(F.ws + WS_SLOTE))[row * 2], se1 = ((const unsigned*)(F.ws + WS_SLOTE))[row * 2 + 1];
    const float w0 = ((const float*)(F.ws + WS_SLOTW))[row * 2], w1 = ((const float*)(F.ws + WS_SLOTW))[row * 2 + 1];
    const size_t p0 = (size_t)tb[se0 & 255u] * 256 + (se0 >> 8), p1 = (size_t)tb[se1 & 255u] * 256 + (se1 >> 8);
    const bf16* Y2 = (const bf16*)(F.ws + WS_Y2);
    const v2u* y0 = (const v2u*)(Y2 + p0 * D) + F.lane; const v2u* y1 = (const v2u*)(Y2 + p1 * D) + F.lane;
    const float* g2 = modv(F, l, b, 5);
#pragma unroll
    for (int j = 0; j < 4; ++j) { const v2u a = y0[64 * j], c = y1[64 * j]; const f32x4 gv = *(const f32x4*)(g2 + 4 * F.lane + 256 * j);
        f32x4 ff; ff.x = w0 * bflo(a.x) + w1 * bflo(c.x); ff.y = w0 * bfhi(a.x) + w1 * bfhi(c.x); ff.z = w0 * bflo(a.y) + w1 * bflo(c.y); ff.w = w0 * bfhi(a.y) + w1 * bfhi(c.y);
        v[j] = v[j] + gv * ff; }
}
__device__ __forceinline__ void p9_combine_mod(Frame& F) {
    moe_prefix(F, 0);
    const volatile LAS unsigned* tb = F.MISC + 32;
    const int gw = F.bid * NWAVES + F.wave, NGW = F.G * NWAVES;
    const int nrows = CTX_FULL ? M_ALL : M_LAT;
    for (int row = gw; row < nrows; row += NGW) {
        const bool isctx = row >= M_LAT; const int b = isctx ? 4 : row / SEQ;
        float* xr = isctx ? (float*)(F.ws + WS_XC) + (size_t)(row - M_LAT) * D : F.out + (size_t)row * D;
        f32x4 v[4];
#pragma unroll
        for (int j = 0; j < 4; ++j) v[j] = ((const f32x4*)xr)[F.lane + 64 * j];
        combine_row(F, 0, row, b, tb, v);
#pragma unroll
        for (int j = 0; j < 4; ++j) ((f32x4*)xr)[F.lane + 64 * j] = v[j];
        if (!isctx) modulate_row(v, F.in[6] + D, modv(F, 1, b, 0), modv(F, 1, b, 1), (bf16*)(F.ws + WS_H) + (size_t)row * D, F.lane);
    }
}
__device__ __forceinline__ void p11_pool_naive(Frame& F) {
    const bf16* U = (const bf16*)(F.ws + WS_U); bf16* DP = (bf16*)(F.ws + WS_DP);
    const long total = (long)M_LAT * 128;
    for (long idx = (long)F.bid * NTHR + F.tid; idx < total; idx += (long)F.G * NTHR) {
        const int tok = (int)(idx >> 7), ch8 = (int)(idx & 127), b = tok / SEQ, t = tok % SEQ, r = t / GRIDW, c = t % GRIDW;
        const int g = ch8 >> 5, win = 2 << g, half = win >> 1;
        const int rlo = max(r - half, 0), rhi = min(r - half + win, GRIDW), clo = max(c - half, 0), chi = min(c - half + win, GRIDW);
        float acc[8];
#pragma unroll
        for (int j = 0; j < 8; ++j) acc[j] = 0.f;
        for (int rr = rlo; rr < rhi; ++rr)
            for (int cc = clo; cc < chi; ++cc) { const v4u w = *(const v4u*)(U + (size_t)(b * SEQ + rr * GRIDW + cc) * D + ch8 * 8);
#pragma unroll
                for (int q = 0; q < 4; ++q) { acc[2 * q] += bflo(w[q]); acc[2 * q + 1] += bfhi(w[q]); } }
        const float inv = 1.f / (float)((rhi - rlo) * (chi - clo));
        const v4u w = *(const v4u*)(U + (size_t)tok * D + ch8 * 8);
        v4u o;
#pragma unroll
        for (int q = 0; q < 4; ++q) o[q] = pk2(acc[2 * q] * inv - bflo(w[q]), acc[2 * q + 1] * inv - bfhi(w[q]));
        *(v4u*)(DP + ((size_t)g * M_LAT + tok) * 256 + (ch8 & 31) * 8) = o;
    }
}
__device__ __forceinline__ void p11_pool(Frame& F) {
    LAS float* I = (LAS float*)F.lds;
    const bf16* U = (const bf16*)(F.ws + WS_U); bf16* DP = (bf16*)(F.ws + WS_DP);
    const int t = F.tid;
    for (int item = F.bid; item < 512; item += F.G) {
        const int b = item >> 7, slab = item & 127, g = slab >> 5, win = 2 << g, half = win >> 1;
        const bf16* Ub = U + (size_t)b * SEQ * D + slab * 8;
        __syncthreads();
#pragma unroll
        for (int j = 0; j < 8; ++j) { const int tok = t + 512 * j, r = tok >> 6, c = tok & 63; const v4u w = *(const v4u*)(Ub + (size_t)tok * D);
            LAS f32x4* dst = (LAS f32x4*)(I + r * 512 + ((c ^ (r & 3)) * 8));
            dst[0] = (f32x4){bflo(w.x), bfhi(w.x), bflo(w.y), bfhi(w.y)}; dst[1] = (f32x4){bflo(w.z), bfhi(w.z), bflo(w.w), bfhi(w.w)}; }
        __syncthreads();
        { const int r = t >> 3, ch = t & 7; float run = 0.f;
#pragma unroll 16
          for (int c = 0; c < 64; ++c) { LAS float* p = I + r * 512 + ((c ^ (r & 3)) * 8) + ch; run += *p; *p = run; } }
        __syncthreads();
        { const int c = t >> 3, ch = t & 7; float run = 0.f;
#pragma unroll 16
          for (int r = 0; r < 64; ++r) { LAS float* p = I + r * 512 + ((c ^ (r & 3)) * 8) + ch; run += *p; *p = run; } }
        __syncthreads();
#pragma unroll 2
        for (int j = 0; j < 8; ++j) { const int tok = t + 512 * j, r = tok >> 6, c = tok & 63;
            const int rlo = max(r - half, 0), rhi = min(r - half + win, GRIDW), clo = max(c - half, 0), chi = min(c - half + win, GRIDW);
            const int r1 = rhi - 1, c1 = chi - 1, r0 = rlo - 1, c0 = clo - 1;
            const LAS f32x4* p11 = (const LAS f32x4*)(I + r1 * 512 + ((c1 ^ (r1 & 3)) * 8));
            f32x4 s0 = p11[0], s1 = p11[1];
            if (r0 >= 0) { const LAS f32x4* q = (const LAS f32x4*)(I + r0 * 512 + ((c1 ^ (r0 & 3)) * 8)); s0 -= q[0]; s1 -= q[1]; }
            if (c0 >= 0) { const LAS f32x4* q = (const LAS f32x4*)(I + r1 * 512 + ((c0 ^ (r1 & 3)) * 8)); s0 -= q[0]; s1 -= q[1]; }
            if (r0 >= 0 && c0 >= 0) { const LAS f32x4* q = (const LAS f32x4*)(I + r0 * 512 + ((c0 ^ (r0 & 3)) * 8)); s0 += q[0]; s1 += q[1]; }
            const float inv = 1.f / (float)((rhi - rlo) * (chi - clo));
            const v4u w = *(const v4u*)(Ub + (size_t)tok * D);
            v4u o; o.x = pk2(s0.x * inv - bflo(w.x), s0.y * inv - bfhi(w.x)); o.y = pk2(s0.z * inv - bflo(w.y), s0.w * inv - bfhi(w.y));
            o.z = pk2(s1.x * inv - bflo(w.z), s1.y * inv - bfhi(w.z)); o.w = pk2(s1.z * inv - bflo(w.w), s1.w * inv - bfhi(w.w));
            *(v4u*)(DP + ((size_t)g * M_LAT + (size_t)b * SEQ + tok) * 256 + (slab & 31) * 8) = o; }
    }
}
__device__ __forceinline__ void p17_final(Frame& F) {
    moe_prefix(F, 1);
    const volatile LAS unsigned* tb = F.MISC + 32;
    const int gw = F.bid * NWAVES + F.wave, NGW = F.G * NWAVES;
    for (int row = gw; row < M_LAT; row += NGW) {
        float* xr = F.out + (size_t)row * D;
        f32x4 v[4];
#pragma unroll
        for (int j = 0; j < 4; ++j) v[j] = ((const f32x4*)xr)[F.lane + 64 * j];
        combine_row(F, 1, row, row / SEQ, tb, v);
        float s2 = 0.f;
#pragma unroll
        for (int j = 0; j < 4; ++j) s2 += (v[j].x * v[j].x + v[j].y * v[j].y) + (v[j].z * v[j].z + v[j].w * v[j].w);
        const float rstd = 1.f / sqrtf(wave_sum(s2) * (1.f / D) + EPS);
#pragma unroll
        for (int j = 0; j < 4; ++j) { const f32x4 gv = *(const f32x4*)(F.in[22] + 4 * F.lane + 256 * j); ((f32x4*)xr)[F.lane + 64 * j] = v[j] * rstd * gv; }
    }
}

struct Args { const float* in[23]; float* out; unsigned char* ws; int ph_lo, ph_hi; };
#ifndef NAIVE_GEMM
#define RUN_GEMM(EpiT, SchedT, g, S, E) gemm_phase<EpiT, SchedT, true, true>(F.lds, g, S, E)
#else
#define RUN_GEMM(EpiT, SchedT, g, S, E) gemm_naive<EpiT, SchedT>(g, S, E)
#endif

__global__ void __launch_bounds__(NTHR, 2) fwd_kernel(Args args) {
    extern __shared__ __attribute__((aligned(16))) unsigned char lds[];
    Frame F;
    F.lds = (LAS unsigned char*)lds; F.MISC = (volatile LAS unsigned*)(F.lds + MISC_OFF);
    F.tid = threadIdx.x; F.lane = F.tid & 63; F.wave = __builtin_amdgcn_readfirstlane(F.tid >> 6);
    F.G = gridDim.x; F.bid = blockIdx.x;
#pragma unroll
    for (int i = 0; i < 23; ++i) F.in[i] = args.in[i];
    F.out = args.out; F.ws = args.ws; F.ctl = (gu32*)(args.ws + WS_CTL);
    for (int u = F.tid; u < (LDS_BYTES - LDSCTL_OFF) / 4; u += NTHR) ((LAS unsigned*)(F.lds + LDSCTL_OFF))[u] = 0u;
    __syncthreads();
    XcdBarrier bar; bar.bar = (unsigned*)(F.ctl + CW_BAR); bar.x = 0; bar.st = nullptr;
    if (MK_ONE_LAUNCH) bar = xcd_barrier_post((unsigned*)(F.ctl + CW_BAR), F.MISC + 8);
    const int lo = args.ph_lo, hi = args.ph_hi;
#ifndef PHMASK
#define PHMASK 0x3ffff
#endif
#define IN(k) (((PHMASK >> (k)) & 1) && lo <= (k) && (k) < hi)
#define SEAM(k) do { if (IN(k) && IN((k) + 1)) xcd_barrier(bar); } while (0)
    bf16* const PL = (bf16*)(F.ws + WS_PL);

    if (IN(0)) { p0_prep(F); } SEAM(0);
    if (IN(1)) { p1_modulate0(F); } SEAM(1);
    if (IN(2)) {
        Gemm g{(const bf16*)(F.ws + WS_H), (const bf16*)(F.ws + WS_WHGIN), D}; StaticOrder S; S.init(M_ALL, NPROJ * D, F.G, F.bid);
        EpiInProj E{PL}; RUN_GEMM(EpiInProj, StaticOrder, g, S, E); } SEAM(2);
    #ifdef SCAN_NAIVE
    if (IN(3)) { p3_scan_naive(F); } SEAM(3);
#else
    if (IN(3)) { p3_scan(F); } SEAM(3);
#endif
    if (IN(4)) { p4_readout_prep(F); } SEAM(4);
    if (IN(5)) {
        Gemm g{(const bf16*)(F.ws + WS_H), (const bf16*)(F.ws + WS_WHGOUT), D}; StaticOrder S; S.init(CTX_FULL ? M_ALL : M_LAT, D, F.G, F.bid);
        EpiResid E{F.in[0], F.in[2], F.out, (float*)(F.ws + WS_XC), modv(F, 0, 0, 2)}; RUN_GEMM(EpiResid, StaticOrder, g, S, E); } SEAM(5);
    if (IN(6)) { p_route(F, 0); } SEAM(6);
    if (IN(7)) { moe_prefix(F, 0);
        Gemm g{(const bf16*)(F.ws + WS_H), (const bf16*)(F.ws + WS_WGU0), D}; MoeOrder S{F.G, F.bid, 2, 1, F.MISC + 32, (const unsigned*)(F.ws + WS_LIST)};
        EpiGateUp E{(bf16*)(F.ws + WS_ACT)}; RUN_GEMM(EpiGateUp, MoeOrder, g, S, E); } SEAM(7);
    if (IN(8)) { moe_prefix(F, 0);
        Gemm g{(const bf16*)(F.ws + WS_ACT), (const bf16*)(F.ws + WS_WD0), DE}; MoeOrder S{F.G, F.bid, 4, 0, F.MISC + 32, (const unsigned*)(F.ws + WS_LIST)};
        EpiDown E{(bf16*)(F.ws + WS_Y2)}; RUN_GEMM(EpiDown, MoeOrder, g, S, E); } SEAM(8);
    if (IN(9)) { p9_combine_mod(F); } SEAM(9);
    if (IN(10)) {
        Gemm g{(const bf16*)(F.ws + WS_H), (const bf16*)(F.ws + WS_WPIN), D}; StaticOrder S; S.init(M_LAT, D, F.G, F.bid);
        EpiBf16Plain E{(bf16*)(F.ws + WS_U), D}; RUN_GEMM(EpiBf16Plain, StaticOrder, g, S, E); } SEAM(10);
    #ifdef POOL_NAIVE
    if (IN(11)) { p11_pool_naive(F); } SEAM(11);
#else
    if (IN(11)) { p11_pool(F); } SEAM(11);
#endif
    if (IN(12)) {
        Gemm g{(const bf16*)(F.ws + WS_DP), (const bf16*)(F.ws + WS_WGRP), 256}; GroupOrder S{F.G, F.bid};
        EpiGrp E{(bf16*)(F.ws + WS_E), F.in[15]}; RUN_GEMM(EpiGrp, GroupOrder, g, S, E); } SEAM(12);
    if (IN(13)) {
        Gemm g{(const bf16*)(F.ws + WS_E), (const bf16*)(F.ws + WS_WPOUT), D}; StaticOrder S; S.init(M_LAT, D, F.G, F.bid);
        EpiResid E{F.out, nullptr, F.out, nullptr, modv(F, 1, 0, 2)}; RUN_GEMM(EpiResid, StaticOrder, g, S, E); } SEAM(13);
    if (IN(14)) { p_route(F, 1); } SEAM(14);
    if (IN(15)) { moe_prefix(F, 1);
        Gemm g{(const bf16*)(F.ws + WS_H), (const bf16*)(F.ws + WS_WGU1), D}; MoeOrder S{F.G, F.bid, 2, 1, F.MISC + 32, (const unsigned*)(F.ws + WS_LIST)};
        EpiGateUp E{(bf16*)(F.ws + WS_ACT)}; RUN_GEMM(EpiGateUp, MoeOrder, g, S, E); } SEAM(15);
    if (IN(16)) { moe_prefix(F, 1);
        Gemm g{(const bf16*)(F.ws + WS_ACT), (const bf16*)(F.ws + WS_WD1), DE}; MoeOrder S{F.G, F.bid, 4, 0, F.MISC + 32, (const unsigned*)(F.ws + WS_LIST)};
        EpiDown E{(bf16*)(F.ws + WS_Y2)}; RUN_GEMM(EpiDown, MoeOrder, g, S, E); } SEAM(16);
    if (IN(17)) { p17_final(F); }
#undef IN
#undef SEAM
}

extern "C" void kernel_launch(void* const* d_in, const int* in_sizes, int n_in, void* d_out, int out_size, void* d_ws, size_t ws_size, hipStream_t stream) {
    static int grid = 0;
    if (grid == 0) {
        if (n_in != 23 || in_sizes[0] != M_LAT * D || out_size != M_LAT * D || ws_size < WS_END) { fprintf(stderr, "kernel_launch: unexpected shapes (n_in %d, in0 %d, out %d, ws %zu); nothing launched\n", n_in, n_in > 0 ? in_sizes[0] : -1, out_size, ws_size); grid = -1; return; }
        int dev = 0, cus = 0, per_cu = 0;
        if (hipGetDevice(&dev) != hipSuccess || hipDeviceGetAttribute(&cus, hipDeviceAttributeMultiprocessorCount, dev) != hipSuccess) { grid = -1; return; }
        if (hipFuncSetAttribute((const void*)fwd_kernel, hipFuncAttributeMaxDynamicSharedMemorySize, LDS_BYTES) != hipSuccess) { fprintf(stderr, "kernel_launch: hipFuncSetAttribute failed\n"); grid = -1; return; }
        if (hipOccupancyMaxActiveBlocksPerMultiprocessor(&per_cu, (const void*)fwd_kernel, NTHR, LDS_BYTES) != hipSuccess || per_cu < 1) { fprintf(stderr, "kernel_launch: occupancy query says %d blocks per CU\n", per_cu); per_cu = 1; }
        (void)hipGetLastError();
        grid = cus;
    }
    if (grid < 0) return;
    if (hipMemsetAsync((char*)d_ws + WS_CTL, 0, CTL_ZERO_BYTES, stream) != hipSuccess) return;
    Args a{};
    for (int i = 0; i < 23; ++i) a.in[i] = (const float*)d_in[i];
    a.out = (float*)d_out; a.ws = (unsigned char*)d_ws;
    if (MK_ONE_LAUNCH) { a.ph_lo = 0; a.ph_hi = NPHASE; hipLaunchKernelGGL(fwd_kernel, dim3(grid), dim3(NTHR), LDS_BYTES, stream, a); }
    else for (int p = 0; p < NPHASE; ++p) { a.ph_lo = p; a.ph_hi = p + 1; hipLaunchKernelGGL(fwd_kernel, dim3(grid), dim3(NTHR), LDS_BYTES, stream, a); }
}
```

```cpp
#include <hip/hip_runtime.h>
#include <cstdio>
#include <cstdint>

#ifndef MK_ONE_LAUNCH
#define MK_ONE_LAUNCH 1
#endif
#ifndef CTX_FULL
#define CTX_FULL 1
#endif

constexpr int D = 1024, NB = 4, SEQ = 4096, CTXL = 256;
constexpr int M_LAT = NB * SEQ, M_CTX = NB * CTXL, M_ALL = M_LAT + M_CTX;
constexpr int NH = 8, DH = 128, NPROJ = 5;
constexpr int NE = 16, DE = 256, NGRP = 4, EPG = 4;
constexpr int GRIDW = 64;
constexpr float EPS = 1e-6f;
constexpr int NWAVES = 8, NTHR = 512;
constexpr int NPHASE = 18;

constexpr size_t MiB = 1u << 20;
constexpr size_t WS_CTL = 0, CTL_ZERO_BYTES = 1 * MiB;
constexpr size_t WS_MODV = 1 * MiB;
constexpr size_t WS_LBV = 1 * MiB + 256 * 1024;
constexpr size_t WS_LIST = 2 * MiB;
constexpr size_t WS_SLOTE = 2 * MiB + 1280 * 1024;
constexpr size_t WS_SLOTW = 2 * MiB + 1536 * 1024;
constexpr size_t WS_WHGIN = 4 * MiB;
constexpr size_t WS_WHGOUT = 14 * MiB;
constexpr size_t WS_WGU0 = 16 * MiB;
constexpr size_t WS_WD0 = 32 * MiB;
constexpr size_t WS_XC = 40 * MiB;
constexpr size_t WS_H = 44 * MiB;
constexpr size_t WS_PL = 78 * MiB;
constexpr size_t PLANE = (size_t)M_ALL * D * 2;
constexpr size_t WS_OFC = 248 * MiB, WS_OBC = 250 * MiB;
constexpr size_t WS_WPIN = 78 * MiB, WS_WGRP = 80 * MiB, WS_WPOUT = 81 * MiB;
constexpr size_t WS_WGU1 = 83 * MiB, WS_WD1 = 99 * MiB;
constexpr size_t WS_ACT = 108 * MiB;
constexpr size_t WS_Y2 = 128 * MiB;
constexpr size_t WS_U = 204 * MiB;
constexpr size_t WS_DP = 108 * MiB;
constexpr size_t WS_E = 140 * MiB;
constexpr size_t WS_END = 256 * MiB;
static_assert(WS_PL + 5 * PLANE <= WS_OFC && WS_H + PLANE <= WS_PL && WS_Y2 + (size_t)38912 * 2048 <= WS_U && WS_U + (size_t)M_LAT * 2048 <= WS_OFC, "ws map");
static_assert(WS_ACT + (size_t)38912 * 512 <= WS_Y2 && WS_DP + (size_t)M_LAT * 2048 <= WS_E && WS_E + (size_t)M_LAT * 2048 <= WS_U && WS_WD1 + 8 * MiB <= WS_ACT, "ws map 2");
constexpr int CW_BAR = 4096;
constexpr int CW_CNT = 8192;
constexpr int LIST_CAP = M_ALL;

constexpr int RING_BYTES = 131072;
constexpr int LDSCTL_OFF = RING_BYTES, MISC_OFF = LDSCTL_OFF + 320;
constexpr int LDS_BYTES = 147456;

#define GAS __attribute__((address_space(1)))
#define LAS __attribute__((address_space(3)))
typedef unsigned short bf16;
typedef unsigned v4u __attribute__((ext_vector_type(4)));
typedef unsigned v2u __attribute__((ext_vector_type(2)));
typedef float f32x4 __attribute__((ext_vector_type(4)));
typedef short bf16x8 __attribute__((ext_vector_type(8)));
typedef GAS unsigned gu32;
#define RLX_AGENT __ATOMIC_RELAXED, __HIP_MEMORY_SCOPE_AGENT
#define LDS_WAIT() asm volatile("s_waitcnt lgkmcnt(0)" ::: "memory")
#define VM_WAIT() asm volatile("s_waitcnt vmcnt(0)" ::: "memory")

__device__ __forceinline__ unsigned f2bf(float f) { unsigned u = __builtin_bit_cast(unsigned, f); return (u + 0x7fffu + ((u >> 16) & 1u)) >> 16; }
typedef float f32x2_t __attribute__((ext_vector_type(2)));
typedef __bf16 bf16x2_t __attribute__((ext_vector_type(2)));
__device__ __forceinline__ unsigned pk2(float lo, float hi) { const f32x2_t v = {lo, hi}; const bf16x2_t b = __builtin_convertvector(v, bf16x2_t); return __builtin_bit_cast(unsigned, b); }
__device__ __forceinline__ float bf2f(unsigned b) { return __builtin_bit_cast(float, b << 16); }
__device__ __forceinline__ float bflo(unsigned w) { return __builtin_bit_cast(float, w << 16); }
__device__ __forceinline__ float bfhi(unsigned w) { return __builtin_bit_cast(float, w & 0xffff0000u); }
__device__ __forceinline__ float sigmoidf_(float x) { return 1.f / (1.f + __expf(-x)); }
__device__ __forceinline__ float siluf_(float x) { return x / (1.f + __expf(-x)); }
__device__ __forceinline__ float wave_sum(float v) {
#pragma unroll
    for (int o = 1; o < 64; o <<= 1) v += __shfl_xor(v, o);
    return v;
}

#define XB_TMO      128
#define XB_XCNT(j)  (256  + 64 * (j))
#define XB_XSUB(j)  (1280 + 64 * (j))
#define XB_XGEN(j)  (2304 + 64 * (j))
#define XB_TOP      3328
#define XB_TOPGEN   3392
#define XCD_BAR_WORDS 3456
#define XB_SPIN_CAP (1u << 18)
__device__ __forceinline__ unsigned xb_ld(unsigned* p)              { return __hip_atomic_load(p, __ATOMIC_RELAXED, __HIP_MEMORY_SCOPE_AGENT); }
__device__ __forceinline__ unsigned xb_add(unsigned* p, unsigned v) { return __hip_atomic_fetch_add(p, v, __ATOMIC_RELAXED, __HIP_MEMORY_SCOPE_AGENT); }
__device__ __forceinline__ unsigned xb_xcc_id() { return (unsigned)__builtin_amdgcn_s_getreg((3 << 11) | 20) & 0xFu; }
#define XB_SPIN(cond, bar) do { unsigned _sp = 0; while (cond) { __builtin_amdgcn_s_sleep(1); \
    if ((++_sp & 255u) == 0u) { if (xb_ld(&(bar)[XB_TMO])) break; if (_sp > XB_SPIN_CAP) { atomicAdd(&(bar)[XB_TMO], 1u); break; } } } } while (0)
struct XcdBarrier { unsigned* bar; unsigned x; volatile LAS unsigned* st; };
__device__ __forceinline__ XcdBarrier xcd_barrier_post(unsigned* bar, volatile LAS unsigned* st) {
    XcdBarrier b; b.bar = bar; b.x = xb_xcc_id(); b.st = st;
    if (threadIdx.x == 0) (void)xb_add(&bar[XB_XCNT(b.x)], 1u);
    return b;
}
__device__ __forceinline__ void xcd_barrier_complete(unsigned* bar, unsigned x, unsigned& nloc, unsigned& nx) {
    const unsigned G = gridDim.x * gridDim.y * gridDim.z;
    unsigned sum, cnt, mine, sp = 0u;
    for (;;) {
        sum = 0u; cnt = 0u; mine = 0u;
#pragma unroll
        for (unsigned j = 0; j < 16; ++j) { const unsigned c = xb_ld(&bar[XB_XCNT(j)]); sum += c; cnt += (c > 0u) ? 1u : 0u; mine = (j == x) ? c : mine; }
        if (sum == G) break;
        __builtin_amdgcn_s_sleep(1);
        if ((++sp & 255u) == 0u) { if (xb_ld(&bar[XB_TMO])) break; if (sp > XB_SPIN_CAP) { atomicAdd(&bar[XB_TMO], 1u); break; } }
    }
    nloc = mine > 0u ? mine : 1u; nx = cnt > 0u ? cnt : 1u;
}
__device__ __forceinline__ void xcd_barrier(const XcdBarrier& b) {
    asm volatile("s_waitcnt vmcnt(0)" ::: "memory");
    __syncthreads();
    if (threadIdx.x == 0) {
        unsigned* bar = b.bar;
        __builtin_amdgcn_s_waitcnt(0);
        unsigned nloc = b.st[0], nx = b.st[1];
        if (nloc == 0u) { xcd_barrier_complete(bar, b.x, nloc, nx); b.st[0] = nloc; b.st[1] = nx; }
        const unsigned old = xb_add(&bar[XB_XSUB(b.x)], 1u);
        const unsigned gen = old / nloc;
        if (old + 1u == (gen + 1u) * nloc) {
            __builtin_amdgcn_fence(__ATOMIC_RELEASE, "agent");
            asm volatile("s_waitcnt vmcnt(0)" ::: "memory");
            const unsigned og = xb_add(&bar[XB_TOP], 1u);
            const unsigned tg = og / nx;
            if (og + 1u == (tg + 1u) * nx) xb_add(&bar[XB_TOPGEN], 1u);
            else XB_SPIN(xb_ld(&bar[XB_TOPGEN]) == tg, bar);
            __builtin_amdgcn_fence(__ATOMIC_ACQUIRE, "agent");
            xb_add(&bar[XB_XGEN(b.x)], 1u);
            asm volatile("s_waitcnt vmcnt(0)" ::: "memory");
        } else {
            XB_SPIN(xb_ld(&bar[XB_XGEN(b.x)]) == gen, bar);
            __builtin_amdgcn_fence(__ATOMIC_ACQUIRE, "agent");
            asm volatile("s_waitcnt vmcnt(0)" ::: "memory");
        }
    }
    __syncthreads();
}

struct Unit { int pm, pn; };
struct Gemm { const bf16* A; const bf16* Bt; int K; };
constexpr int NXCD = 8, WGM = 8, BM = 256;

struct StaticOrder {
    int nM, nN, nwg, G, c;
    __device__ __forceinline__ void init(int M, int N, int G_, int c_) { nM = M / BM; nN = N / BM; nwg = nM * nN; G = G_; c = c_; }
    __device__ __forceinline__ bool next(int i, Unit& u) const {
        const long L = (long)i * G + c; if (L >= nwg) return false;
        int wgid = (int)L; { const int q = nwg / NXCD, r = nwg % NXCD, xcd = wgid % NXCD, off = wgid / NXCD; wgid = (xcd < r ? xcd * (q + 1) : r * (q + 1) + (xcd - r) * q) + off; }
        const int nig = WGM * nN, gid = wgid / nig, fm = gid * WGM, gsz = (nM - fm) < WGM ? (nM - fm) : WGM;
        u.pm = fm + ((wgid % nig) % gsz); u.pn = (wgid % nig) / gsz; return true;
    }
    __device__ __forceinline__ int a_row(const Unit& u, int r) const { return u.pm * BM + r; }
};
struct GroupOrder {
    int G, c;
    __device__ __forceinline__ bool next(int i, Unit& u) const { const int L = i * G + c; if (L >= 256) return false; u.pm = L; u.pn = L >> 6; return true; }
    __device__ __forceinline__ int a_row(const Unit& u, int r) const { return u.pm * BM + r; }
};
struct MoeOrder {
    int G, c, npn, gather; const volatile LAS unsigned* tb; const unsigned* list;
    __device__ __forceinline__ bool next(int i, Unit& u) const {
        const int L = i * G + c; const int nt = (int)tb[16];
        if (L >= nt * npn) return false;
        const int t = L / npn, nl = L % npn; int e = 0;
#pragma unroll
        for (int j = 1; j < 16; ++j) e += (t >= (int)tb[j]) ? 1 : 0;
        u.pm = t; u.pn = e * npn + nl; return true;
    }
    __device__ __forceinline__ int a_row(const Unit& u, int r) const {
        if (!gather) return u.pm * BM + r;
        const int e = u.pn / npn; const int idx = (u.pm - (int)tb[e]) * BM + r;
        const unsigned ent = (idx < (int)tb[17 + e]) ? list[(size_t)e * LIST_CAP + idx] : 0u;
        return (int)(ent >> 1);
    }
};

template <class Epi, class Sched>
__device__ __forceinline__ void gemm_naive(const Gemm g, const Sched& S, const Epi& E) {
    const int tid = threadIdx.x, wid = tid >> 6, lane = tid & 63, wr = wid >> 2, wc = wid & 3, fr = lane & 15, fq = lane >> 4;
    const int K = g.K;
    Unit u;
    for (int i = 0; S.next(i, u); ++i) {
        f32x4 acc[2][2][4][2];
#pragma unroll
        for (int ai = 0; ai < 2; ++ai)
#pragma unroll
            for (int m = 0; m < 4; ++m) {
                const bf16* ar = g.A + (size_t)S.a_row(u, 128 * ai + 64 * wr + 16 * m + fr) * K;
#pragma unroll
                for (int bj = 0; bj < 2; ++bj)
#pragma unroll
                    for (int n = 0; n < 2; ++n) {
                        const int c0 = 128 * bj + 32 * wc + (Epi::PERM ? 8 * fq + 4 * n : 16 * n + 4 * fq);
                        const bf16* br = g.Bt + (size_t)(u.pn * BM + c0) * K;
                        f32x4 a0 = {0.f, 0.f, 0.f, 0.f};
#pragma unroll 1
                        for (int k = 0; k < K; k += 8) {
                            const v4u b0 = *(const v4u*)(br + k), b1 = *(const v4u*)(br + (size_t)K + k), b2 = *(const v4u*)(br + (size_t)2 * K + k), b3 = *(const v4u*)(br + (size_t)3 * K + k);
                            const v4u x0 = *(const v4u*)(ar + k);
#pragma unroll
                            for (int q = 0; q < 4; ++q) {
                                const f32x4 blo = {bflo(b0[q]), bflo(b1[q]), bflo(b2[q]), bflo(b3[q])}, bhi = {bfhi(b0[q]), bfhi(b1[q]), bfhi(b2[q]), bfhi(b3[q])};
                                a0 += blo * bflo(x0[q]) + bhi * bfhi(x0[q]);
                            }
                        }
                        asm volatile("" : "+v"(a0));
                        acc[ai][bj][m][n] = a0;
                    }
            }
        E(acc, u, wr, wc, fr, fq);
    }
}

constexpr int BK = 64, HALF = 128, HTB = HALF * BK * 2;
__device__ __forceinline__ int lds_byte(int r, int c) { const int st = (r >> 4) * 2 + (c >> 5), rr = r & 15, cc = c & 31, ob = rr * 64 + cc * 2; return st * 1024 + (ob ^ (((ob >> 9) & 1) << 5)); }
__device__ __forceinline__ void stage_rc(int b, int& R, int& C) { const int st = b / 1024, sb = b % 1024, swz = sb ^ (((sb >> 9) & 1) << 5); R = (st >> 1) * 16 + swz / 64; C = (st & 1) * 32 + (swz % 64) / 2; }
__device__ __forceinline__ int perm32(int rho) { const int n = rho >> 4, i = rho & 15; return 8 * (i >> 2) + 4 * n + (i & 3); }
template <class Epi, class Sched, bool ALIGN_EPI = false, bool SP2 = false>
__device__ __forceinline__ void gemm_phase(LAS unsigned char* lds, const Gemm g, const Sched& S, const Epi& E) {
    const int tid = threadIdx.x, wid = __builtin_amdgcn_readfirstlane(tid >> 6), lane = tid & 63, wr = wid >> 2, wc = wid & 3, fr = lane & 15, fq = lane >> 4;
    const int K = g.K, nt = K / BK;
    unsigned vAc0[2], vAc1[2], vAn0[2], vAn1[2], voffB[2]; int stR[2], stC[2];
#pragma unroll
    for (int i = 0; i < 2; ++i) { int R, C; stage_rc(tid * 16 + i * 8192, R, C); const int Rb = Epi::PERM ? ((R & ~31) + perm32(R & 31)) : R;
        stR[i] = R; stC[i] = C; voffB[i] = (unsigned)(Rb * K + C) * 2u; }
#define PG8_SETA(v0, v1, U) do { _Pragma("unroll") for (int _i = 0; _i < 2; ++_i) { v0[_i] = (unsigned)(S.a_row(U, stR[_i]) * K + stC[_i]) * 2u; v1[_i] = (unsigned)(S.a_row(U, HALF + stR[_i]) * K + stC[_i]) * 2u; } } while (0)
    const size_t kstep = (size_t)(BK * 2);
    const size_t hstep = (size_t)HALF * K * 2;
    const size_t tstep = 2 * hstep;
    const unsigned ldsw = (unsigned)wid * 1024u;
    const int aoff = lds_byte(wr * 64 + fr, fq * 8), boff = lds_byte(wc * 32 + fr, fq * 8);
#define PG8_SA(b, h) (((b) * 2 + (h)) * HTB)
#define PG8_SB(b, h) ((4 + (b) * 2 + (h)) * HTB)
#define PG8_STAGE(bufoff, gbase, voff) do { _Pragma("unroll") for (int _i = 0; _i < 2; ++_i) \
        __builtin_amdgcn_global_load_lds((const unsigned*)((const char*)(gbase) + (voff)[_i]), (LAS unsigned*)(lds + (bufoff) + ldsw + _i * 8192), 16, 0, 0); } while (0)
#define PG8_LDA(dst, b, h) do { _Pragma("unroll") for (int m = 0; m < 4; ++m) _Pragma("unroll") for (int k = 0; k < 2; ++k) dst[m][k] = *(const LAS bf16x8*)(lds + PG8_SA(b, h) + aoff + m * 2048 + k * 1024); } while (0)
#define PG8_LDB(dst, b, h) do { _Pragma("unroll") for (int n = 0; n < 2; ++n) _Pragma("unroll") for (int k = 0; k < 2; ++k) dst[n][k] = *(const LAS bf16x8*)(lds + PG8_SB(b, h) + boff + n * 2048 + k * 1024); } while (0)
#define PG8_MMA(ai, bj, At, Bt) do { __builtin_amdgcn_s_setprio(1); _Pragma("unroll") for (int m = 0; m < 4; ++m) _Pragma("unroll") for (int n = 0; n < 2; ++n) _Pragma("unroll") for (int k = 0; k < 2; ++k) \
        acc[ai][bj][m][n] = __builtin_amdgcn_mfma_f32_16x16x32_bf16(Bt[n][k], At[m][k], acc[ai][bj][m][n], 0, 0, 0); __builtin_amdgcn_s_setprio(0); } while (0)
#define PG8_WAIT_V(n) asm volatile("s_waitcnt vmcnt(" #n ")" ::: "memory")
#define PG8_WAIT_L(n) asm volatile("s_waitcnt lgkmcnt(" #n ")" ::: "memory")
#define PG8_BAR __builtin_amdgcn_s_barrier()
#define PG8_SCHED __builtin_amdgcn_sched_barrier(0)
    Unit cur, nxt; int ui = 0;
    if (!S.next(0, cur)) return;
    f32x4 acc[2][2][4][2];
#pragma unroll
    for (int a = 0; a < 2; ++a)
#pragma unroll
        for (int b = 0; b < 2; ++b)
#pragma unroll
            for (int m = 0; m < 4; ++m)
#pragma unroll
                for (int n = 0; n < 2; ++n) acc[a][b][m][n] = (f32x4){0.f, 0.f, 0.f, 0.f};
    bf16x8 At[4][2], B0[2][2], B1[2][2];
    const char* const cA = (const char*)g.A; PG8_SETA(vAc0, vAc1, cur); const char* cB = (const char*)g.Bt + (size_t)cur.pn * tstep;
    if constexpr (SP2) {
        PG8_STAGE(PG8_SB(0, 0), cB, voffB); PG8_STAGE(PG8_SB(0, 1), cB + hstep, voffB); PG8_STAGE(PG8_SA(0, 0), cA, vAc0); PG8_STAGE(PG8_SA(0, 1), cA, vAc1);
        if (wr == 1) PG8_BAR;
        PG8_WAIT_V(2); PG8_BAR;
        PG8_STAGE(PG8_SB(1, 0), cB + kstep, voffB); PG8_STAGE(PG8_SA(1, 0), cA + kstep, vAc0); PG8_STAGE(PG8_SB(1, 1), cB + hstep + kstep, voffB);
        PG8_WAIT_V(6); PG8_BAR;
    } else {
        PG8_STAGE(PG8_SB(0, 0), cB, voffB); PG8_STAGE(PG8_SA(0, 0), cA, vAc0); PG8_STAGE(PG8_SB(0, 1), cB + hstep, voffB); PG8_STAGE(PG8_SA(0, 1), cA, vAc1);
        if (wr == 1) PG8_BAR;
        PG8_WAIT_V(4); PG8_BAR;
        PG8_STAGE(PG8_SB(1, 0), cB + kstep, voffB); PG8_STAGE(PG8_SA(1, 0), cA + kstep, vAc0); PG8_STAGE(PG8_SB(1, 1), cB + hstep + kstep, voffB);
        PG8_WAIT_V(6); PG8_BAR;
    }
    for (;;) {
        const bool has_next = S.next(ui + 1, nxt);
        if (has_next) { PG8_SETA(vAn0, vAn1, nxt); } else { vAn0[0] = vAc0[0]; vAn0[1] = vAc0[1]; vAn1[0] = vAc1[0]; vAn1[1] = vAc1[1]; }
        const char* nB = has_next ? (const char*)g.Bt + (size_t)nxt.pn * tstep : cB;
#pragma unroll 1
        for (int t = 0; t < nt; t += 2) {
            const bool last = (t == nt - 2);
            const char* a1 = cA + (size_t)(t + 1) * kstep;
            const char* a2 = last ? cA : cA + (size_t)(t + 2) * kstep; unsigned w0[2], w1[2]; w0[0] = last ? vAn0[0] : vAc0[0]; w0[1] = last ? vAn0[1] : vAc0[1]; w1[0] = last ? vAn1[0] : vAc1[0]; w1[1] = last ? vAn1[1] : vAc1[1]; const char* b2 = last ? nB : cB + (size_t)(t + 2) * kstep;
            const char* a3 = a2 + kstep; const char* b3 = b2 + kstep;
            if constexpr (SP2) {
            PG8_LDB(B0, 0, 0); PG8_LDB(B1, 0, 1); PG8_SCHED; PG8_LDA(At, 0, 0); PG8_STAGE(PG8_SA(1, 1), a1, vAc1);
            PG8_WAIT_V(8); PG8_WAIT_L(0); PG8_BAR; PG8_MMA(0, 0, At, B0); PG8_MMA(0, 1, At, B1); PG8_BAR; PG8_SCHED;
            PG8_LDA(At, 0, 1); PG8_STAGE(PG8_SB(0, 0), b2, voffB); PG8_STAGE(PG8_SB(0, 1), b2 + hstep, voffB); PG8_STAGE(PG8_SA(0, 0), a2, w0);
            PG8_WAIT_V(8); PG8_WAIT_L(0); PG8_BAR; PG8_MMA(1, 0, At, B0); PG8_MMA(1, 1, At, B1); PG8_BAR; PG8_SCHED;
            PG8_LDB(B0, 1, 0); PG8_LDB(B1, 1, 1); PG8_SCHED; PG8_LDA(At, 1, 0); PG8_STAGE(PG8_SA(0, 1), a2, w1);
            PG8_WAIT_V(8); PG8_WAIT_L(0); PG8_BAR; PG8_MMA(0, 0, At, B0); PG8_MMA(0, 1, At, B1); PG8_BAR; PG8_SCHED;
            PG8_LDA(At, 1, 1); PG8_STAGE(PG8_SB(1, 0), b3, voffB); PG8_STAGE(PG8_SB(1, 1), b3 + hstep, voffB); PG8_STAGE(PG8_SA(1, 0), a3, w0);
            PG8_WAIT_V(8); PG8_WAIT_L(0); PG8_BAR; PG8_MMA(1, 0, At, B0); PG8_MMA(1, 1, At, B1); PG8_BAR; PG8_SCHED;
            } else {
            PG8_LDB(B0, 0, 0); PG8_SCHED; PG8_LDA(At, 0, 0); PG8_STAGE(PG8_SA(1, 1), a1, vAc1);
            PG8_WAIT_L(8); PG8_BAR; PG8_WAIT_L(0); PG8_MMA(0, 0, At, B0); PG8_BAR; PG8_SCHED;
            PG8_LDB(B1, 0, 1); PG8_STAGE(PG8_SB(0, 0), b2, voffB);
            PG8_BAR; PG8_WAIT_L(0); PG8_MMA(0, 1, At, B1); PG8_BAR;
            PG8_LDA(At, 0, 1); PG8_STAGE(PG8_SA(0, 0), a2, w0);
            PG8_BAR; PG8_WAIT_L(0); PG8_MMA(1, 0, At, B0); PG8_BAR; PG8_SCHED;
            PG8_STAGE(PG8_SB(0, 1), b2 + hstep, voffB);
            PG8_WAIT_V(6); PG8_BAR; PG8_MMA(1, 1, At, B1); PG8_BAR;
            PG8_LDB(B0, 1, 0); PG8_SCHED; PG8_LDA(At, 1, 0); PG8_STAGE(PG8_SA(0, 1), a2, w1);
            PG8_WAIT_L(8); PG8_BAR; PG8_WAIT_L(0); PG8_MMA(0, 0, At, B0); PG8_BAR; PG8_SCHED;
            PG8_LDB(B1, 1, 1); PG8_STAGE(PG8_SB(1, 0), b3, voffB);
            PG8_BAR; PG8_WAIT_L(0); PG8_MMA(0, 1, At, B1); PG8_BAR;
            PG8_LDA(At, 1, 1); PG8_STAGE(PG8_SA(1, 0), a3, w0);
            PG8_BAR; PG8_WAIT_L(0); PG8_MMA(1, 0, At, B0); PG8_BAR; PG8_SCHED;
            PG8_STAGE(PG8_SB(1, 1), b3 + hstep, voffB);
            PG8_WAIT_V(6); PG8_BAR; PG8_MMA(1, 1, At, B1); PG8_BAR;
            }
        }
        if constexpr (ALIGN_EPI) { if (wr == 0) PG8_BAR; }
        { E(acc, cur, wr, wc, fr, fq); }
        if (!has_next) break;
#pragma unroll
        for (int a = 0; a < 2; ++a)
#pragma unroll
            for (int b = 0; b < 2; ++b)
#pragma unroll
                for (int m = 0; m < 4; ++m)
#pragma unroll
                    for (int n = 0; n < 2; ++n) acc[a][b][m][n] = (f32x4){0.f, 0.f, 0.f, 0.f};
        cur = nxt; cB = nB; ++ui; vAc0[0] = vAn0[0]; vAc0[1] = vAn0[1]; vAc1[0] = vAn1[0]; vAc1[1] = vAn1[1];
        if constexpr (ALIGN_EPI) { if (wr == 1) PG8_BAR; }
    }
    PG8_WAIT_V(0);
    if constexpr (!ALIGN_EPI) { if (wr == 0) PG8_BAR; }
    PG8_BAR;

#undef PG8_SETA
#undef PG8_SA
#undef PG8_SB
#undef PG8_STAGE
#undef PG8_LDA
#undef PG8_LDB
#undef PG8_MMA
#undef PG8_WAIT_V
#undef PG8_WAIT_L
#undef PG8_BAR
#undef PG8_SCHED
}

struct EpiInProj {
    static constexpr bool PERM = true, AFTER_DRAIN = false;
    bf16* PL; const float* lbv;
    __device__ __forceinline__ void operator()(const f32x4 (&acc)[2][2][4][2], const Unit& u, int wr, int wc, int fr, int fq) const {
        const int p = u.pn >> 2; const bool act = (p == 0) || (p == 4), gate = (p == 2) || (p == 3);
        bf16* base = PL + (size_t)p * ((size_t)M_ALL * D);
        const int col0 = (u.pn & 3) * BM + wc * 32 + 8 * fq, row0 = u.pm * BM + wr * 64 + fr;
        f32x4 om[2][2];
#pragma unroll
        for (int bj = 0; bj < 2; ++bj)
#pragma unroll
            for (int n = 0; n < 2; ++n) om[bj][n] = gate ? (1.f - *(const f32x4*)(lbv + (p - 2) * D + col0 + bj * 128 + 4 * n)) : (f32x4){0.f, 0.f, 0.f, 0.f};
#pragma unroll
        for (int ai = 0; ai < 2; ++ai)
#pragma unroll
            for (int m = 0; m < 4; ++m) { bf16* rowp = base + (size_t)(row0 + ai * 128 + m * 16) * D + col0;
#pragma unroll
                for (int bj = 0; bj < 2; ++bj) { f32x4 v0 = acc[ai][bj][m][0], v1 = acc[ai][bj][m][1];
                    if (act) {
#pragma unroll
                        for (int j = 0; j < 4; ++j) { v0[j] = siluf_(v0[j]); v1[j] = siluf_(v1[j]); } }
                    if (gate) {
#pragma unroll
                        for (int j = 0; j < 4; ++j) { v0[j] = om[bj][0][j] / (1.f + __expf(v0[j])); v1[j] = om[bj][1][j] / (1.f + __expf(v1[j])); } }
                    v4u w; w.x = pk2(v0[0], v0[1]); w.y = pk2(v0[2], v0[3]); w.z = pk2(v1[0], v1[1]); w.w = pk2(v1[2], v1[3]);
                    *(v4u*)(rowp + bj * 128) = w; } }
    }
};
struct EpiBf16Plain {
    static constexpr bool PERM = true, AFTER_DRAIN = false;
    bf16* O; int ldc;
    __device__ __forceinline__ void operator()(const f32x4 (&acc)[2][2][4][2], const Unit& u, int wr, int wc, int fr, int fq) const {
        const int col0 = u.pn * BM + wc * 32 + 8 * fq, row0 = u.pm * BM + wr * 64 + fr;
#pragma unroll
        for (int ai = 0; ai < 2; ++ai)
#pragma unroll
            for (int m = 0; m < 4; ++m) { bf16* rowp = O + (size_t)(row0 + ai * 128 + m * 16) * ldc + col0;
#pragma unroll
                for (int bj = 0; bj < 2; ++bj) { const f32x4 v0 = acc[ai][bj][m][0], v1 = acc[ai][bj][m][1];
                    v4u w; w.x = pk2(v0[0], v0[1]); w.y = pk2(v0[2], v0[3]); w.z = pk2(v1[0], v1[1]); w.w = pk2(v1[2], v1[3]);
                    *(v4u*)(rowp + bj * 128) = w; } }
    }
};
struct EpiDown {
    static constexpr bool PERM = true, AFTER_DRAIN = false;
    bf16* O;
    __device__ __forceinline__ void operator()(const f32x4 (&acc)[2][2][4][2], const Unit& u, int wr, int wc, int fr, int fq) const {
        const int col0 = (u.pn & 3) * BM + wc * 32 + 8 * fq, row0 = u.pm * BM + wr * 64 + fr;
#pragma unroll
        for (int ai = 0; ai < 2; ++ai)
#pragma unroll
            for (int m = 0; m < 4; ++m) { bf16* rowp = O + (size_t)(row0 + ai * 128 + m * 16) * D + col0;
#pragma unroll
                for (int bj = 0; bj < 2; ++bj) { const f32x4 v0 = acc[ai][bj][m][0], v1 = acc[ai][bj][m][1];
                    v4u w; w.x = pk2(v0[0], v0[1]); w.y = pk2(v0[2], v0[3]); w.z = pk2(v1[0], v1[1]); w.w = pk2(v1[2], v1[3]);
                    *(v4u*)(rowp + bj * 128) = w; } }
    }
};
struct EpiGateUp {
    static constexpr bool PERM = true, AFTER_DRAIN = false;
    bf16* ACT;
    __device__ __forceinline__ void operator()(const f32x4 (&acc)[2][2][4][2], const Unit& u, int wr, int wc, int fr, int fq) const {
        const int col0 = (u.pn & 1) * 128 + wc * 32 + 8 * fq, row0 = u.pm * BM + wr * 64 + fr;
#pragma unroll
        for (int ai = 0; ai < 2; ++ai)
#pragma unroll
            for (int m = 0; m < 4; ++m) { bf16* rowp = ACT + (size_t)(row0 + ai * 128 + m * 16) * DE + col0;
                f32x4 v0, v1;
#pragma unroll
                for (int j = 0; j < 4; ++j) { v0[j] = siluf_(acc[ai][0][m][0][j]) * acc[ai][1][m][0][j]; v1[j] = siluf_(acc[ai][0][m][1][j]) * acc[ai][1][m][1][j]; }
                v4u w; w.x = pk2(v0[0], v0[1]); w.y = pk2(v0[2], v0[3]); w.z = pk2(v1[0], v1[1]); w.w = pk2(v1[2], v1[3]);
                *(v4u*)rowp = w; }
    }
};
struct EpiGrp {
    static constexpr bool PERM = true, AFTER_DRAIN = false;
    bf16* O; const float* ps;
    __device__ __forceinline__ void operator()(const f32x4 (&acc)[2][2][4][2], const Unit& u, int wr, int wc, int fr, int fq) const {
        const int col0 = u.pn * BM + wc * 32 + 8 * fq, row0 = (u.pm & 63) * BM + wr * 64 + fr;
#pragma unroll
        for (int bj = 0; bj < 2; ++bj) {
            const f32x4 s0 = *(const f32x4*)(ps + col0 + bj * 128), s1 = *(const f32x4*)(ps + col0 + bj * 128 + 4);
#pragma unroll
            for (int ai = 0; ai < 2; ++ai)
#pragma unroll
                for (int m = 0; m < 4; ++m) { bf16* rowp = O + (size_t)(row0 + ai * 128 + m * 16) * D + col0 + bj * 128;
                    const f32x4 v0 = acc[ai][bj][m][0] * s0, v1 = acc[ai][bj][m][1] * s1;
                    v4u w; w.x = pk2(v0[0], v0[1]); w.y = pk2(v0[2], v0[3]); w.z = pk2(v1[0], v1[1]); w.w = pk2(v1[2], v1[3]);
                    *(v4u*)rowp = w; }
        }
    }
};
struct EpiResid {
    static constexpr bool PERM = false, AFTER_DRAIN = false;
    const float* xin_lat; const float* xin_ctx; float* out_lat; float* out_ctx; const float* gate;
    __device__ __forceinline__ void operator()(const f32x4 (&acc)[2][2][4][2], const Unit& u, int wr, int wc, int fr, int fq) const {
        const int col0 = u.pn * BM + wc * 32 + 4 * fq, row0 = u.pm * BM + wr * 64 + fr;
        const bool isctx = row0 >= M_LAT;
        const int bidx = isctx ? 4 : (row0 / SEQ);
        const float* xin = isctx ? xin_ctx - (size_t)M_LAT * D : xin_lat; float* out = isctx ? out_ctx - (size_t)M_LAT * D : out_lat;
        const float* gp = gate + (size_t)bidx * 6144 + col0;
        f32x4 gv[2][2];
#pragma unroll
        for (int bj = 0; bj < 2; ++bj)
#pragma unroll
            for (int n = 0; n < 2; ++n) gv[bj][n] = *(const f32x4*)(gp + bj * 128 + n * 16);
#pragma unroll
        for (int ai = 0; ai < 2; ++ai)
#pragma unroll
            for (int m = 0; m < 4; ++m) { const size_t ro = (size_t)(row0 + ai * 128 + m * 16) * D + col0;
#pragma unroll
                for (int bj = 0; bj < 2; ++bj)
#pragma unroll
                    for (int n = 0; n < 2; ++n) { const f32x4 xv = *(const f32x4*)(xin + ro + bj * 128 + n * 16);
                        *(f32x4*)(out + ro + bj * 128 + n * 16) = xv + gv[bj][n] * acc[ai][bj][m][n]; } }
    }
};

struct Frame {
    LAS unsigned char* lds; volatile LAS unsigned* MISC; gu32* ctl;
    int tid, lane, wave, G, bid;
    const float* in[23]; float* out; unsigned char* ws;
};
__device__ __forceinline__ const float* modv(const Frame& F, int l, int b, int j) { return (const float*)(F.ws + WS_MODV) + ((size_t)l * 5 + b) * 6144 + j * 1024; }

__device__ __forceinline__ void transpose_item(const float* W, int N, int k0, int n0, bf16* WT, int KT, size_t dst_row0, LAS float* scr, int lane) {
#pragma unroll 8
    for (int i = 0; i < 32; ++i) { const int kk = 2 * i + (lane >> 5); scr[kk * 33 + (lane & 31)] = W[(size_t)(k0 + kk) * N + n0 + (lane & 31)]; }
    LDS_WAIT(); asm volatile("" ::: "memory");
    const int c = lane & 7;
#pragma unroll
    for (int j = 0; j < 4; ++j) { const int n = (lane >> 3) + 8 * j; const LAS float* s = scr + (8 * c) * 33 + n;
        v4u o; o.x = pk2(s[0 * 33], s[1 * 33]); o.y = pk2(s[2 * 33], s[3 * 33]); o.z = pk2(s[4 * 33], s[5 * 33]); o.w = pk2(s[6 * 33], s[7 * 33]);
        *(v4u*)(WT + (dst_row0 + n) * KT + k0 + 8 * c) = o; }
    LDS_WAIT(); asm volatile("" ::: "memory");
}
__device__ __forceinline__ void conv_moe_item(const Frame& F, int l, int r, bf16* WGU, bf16* WD, LAS float* scr) {
    const int kind = r >> 11, rr = r & 2047, e = rr >> 7, it = rr & 127;
    if (kind < 2) { const float* W = (kind ? F.in[20] : F.in[19]) + (size_t)(l * NE + e) * D * DE; const int kb = it >> 3, nb = it & 7, n0 = 32 * nb;
        transpose_item(W, DE, 64 * kb, n0, WGU, D, (size_t)e * 512 + (n0 >> 7) * 256 + kind * 128 + (n0 & 127), scr, F.lane); }
    else { const float* W = F.in[21] + (size_t)(l * NE + e) * DE * D; const int kb = it >> 5, nb = it & 31;
        transpose_item(W, D, 64 * kb, 32 * nb, WD, DE, (size_t)e * D + 32 * nb, scr, F.lane); }
}

__device__ __forceinline__ void p0_prep(Frame& F) {
    if (F.bid < 192) {
        LAS float* sil = (LAS float*)(F.lds);
        LAS float* red = (LAS float*)(F.lds + 32768);
        for (int i = F.tid; i < 5 * D; i += NTHR) { const float cv = (i < 4 * D) ? F.in[1][i] : F.in[3][i - 4 * D]; sil[i] = siluf_(cv); }
        __syncthreads();
        const int l = F.bid / 96, col0 = (F.bid % 96) * 64;
        const float* W = F.in[4] + (size_t)l * D * 6144 + col0 + F.lane;
        float a0 = 0.f, a1 = 0.f, a2 = 0.f, a3 = 0.f, a4 = 0.f;
        const int kbeg = F.wave * 128;
#pragma unroll 8
        for (int k = kbeg; k < kbeg + 128; ++k) { const float w = W[(size_t)k * 6144];
            a0 += sil[k] * w; a1 += sil[D + k] * w; a2 += sil[2 * D + k] * w; a3 += sil[3 * D + k] * w; a4 += sil[4 * D + k] * w; }
        red[(F.wave * 5 + 0) * 64 + F.lane] = a0; red[(F.wave * 5 + 1) * 64 + F.lane] = a1; red[(F.wave * 5 + 2) * 64 + F.lane] = a2;
        red[(F.wave * 5 + 3) * 64 + F.lane] = a3; red[(F.wave * 5 + 4) * 64 + F.lane] = a4;
        __syncthreads();
        if (F.tid < 320) { const int b = F.tid >> 6, cc = F.tid & 63; float s = 0.f;
#pragma unroll
            for (int w = 0; w < 8; ++w) s += red[(w * 5 + b) * 64 + cc];
            ((float*)(F.ws + WS_MODV))[((size_t)l * 5 + b) * 6144 + col0 + cc] = s + F.in[5][l * 6144 + col0 + cc]; }
        __syncthreads();
    }
    if (F.bid == 192) for (int i = F.tid; i < 2 * D; i += NTHR) { const float* lb = (i < D) ? F.in[9] : F.in[10]; const int c = i & (D - 1);
        ((float*)(F.ws + WS_LBV))[i] = sigmoidf_(lb[c] - lb[D + c]); }
    LAS float* scr = (LAS float*)(F.lds + F.wave * 16384);
    const int gw = F.bid * NWAVES + F.wave, NGW = F.G * NWAVES;
    constexpr int I_IN = 16 * 160, I_OUT = 16 * 32, I_MOE = 6144;
    for (int it = gw; it < I_IN + I_OUT + I_MOE; it += NGW) {
        int r = it;
        if (r < I_IN) { const int kb = r / 160, nb = r % 160; transpose_item(F.in[8], NPROJ * D, 64 * kb, 32 * nb, (bf16*)(F.ws + WS_WHGIN), D, (size_t)32 * nb, scr, F.lane); continue; } r -= I_IN;
        if (r < I_OUT) { const int kb = r >> 5, nb = r & 31; transpose_item(F.in[12], D, 64 * kb, 32 * nb, (bf16*)(F.ws + WS_WHGOUT), D, (size_t)32 * nb, scr, F.lane); continue; } r -= I_OUT;
        conv_moe_item(F, 0, r, (bf16*)(F.ws + WS_WGU0), (bf16*)(F.ws + WS_WD0), scr);
    }
}
__device__ __forceinline__ void conv_layer1(Frame& F) {
    LAS float* scr = (LAS float*)(F.lds + F.wave * 16384);
    const int gw = F.bid * NWAVES + F.wave, NGW = F.G * NWAVES;
    constexpr int I_SQ = 16 * 32, I_GRP = 4 * 4 * 8, I_MOE = 6144;
    for (int it = gw; it < 2 * I_SQ + I_GRP + I_MOE; it += NGW) {
        int r = it;
        if (r < I_SQ) { const int kb = r >> 5, nb = r & 31; transpose_item(F.in[13], D, 64 * kb, 32 * nb, (bf16*)(F.ws + WS_WPIN), D, (size_t)32 * nb, scr, F.lane); continue; } r -= I_SQ;
        if (r < I_SQ) { const int kb = r >> 5, nb = r & 31; transpose_item(F.in[16], D, 64 * kb, 32 * nb, (bf16*)(F.ws + WS_WPOUT), D, (size_t)32 * nb, scr, F.lane); continue; } r -= I_SQ;
        if (r < I_GRP) { const int g = r >> 5, q = r & 31, kb = q >> 3, nb = q & 7;
            transpose_item(F.in[14] + (size_t)g * 256 * 256, 256, 64 * kb, 32 * nb, (bf16*)(F.ws + WS_WGRP), 256, (size_t)g * 256 + 32 * nb, scr, F.lane); continue; } r -= I_GRP;
        conv_moe_item(F, 1, r, (bf16*)(F.ws + WS_WGU1), (bf16*)(F.ws + WS_WD1), scr);
    }
}

__device__ __forceinline__ void modulate_row(const f32x4 (&v)[4], const float* g, const float* sh, const float* sc, bf16* orow, int lane) {
    float s2 = 0.f;
#pragma unroll
    for (int j = 0; j < 4; ++j) s2 += (v[j].x * v[j].x + v[j].y * v[j].y) + (v[j].z * v[j].z + v[j].w * v[j].w);
    const float rstd = 1.f / sqrtf(wave_sum(s2) * (1.f / D) + EPS);
    unsigned long long* o8 = (unsigned long long*)orow + lane;
#pragma unroll
    for (int j = 0; j < 4; ++j) { const int c = 4 * lane + 256 * j;
        const f32x4 gv = *(const f32x4*)(g + c), shv = *(const f32x4*)(sh + c), scv = *(const f32x4*)(sc + c);
        const f32x4 h = v[j] * rstd * gv * (scv + 1.f) + shv;
        o8[64 * j] = (unsigned long long)pk2(h.x, h.y) | ((unsigned long long)pk2(h.z, h.w) << 32); }
}
__device__ __forceinline__ void p1_modulate0(Frame& F) {
    const int gw = F.bid * NWAVES + F.wave, NGW = F.G * NWAVES;
    bf16* H = (bf16*)(F.ws + WS_H);
    for (int row = gw; row < M_ALL; row += NGW) {
        const bool isctx = row >= M_LAT; const int b = isctx ? 4 : row / SEQ;
        const float* xr = isctx ? F.in[2] + (size_t)(row - M_LAT) * D : F.in[0] + (size_t)row * D;
        f32x4 v[4];
#pragma unroll
        for (int j = 0; j < 4; ++j) v[j] = ((const f32x4*)xr)[F.lane + 64 * j];
        modulate_row(v, F.in[6], modv(F, 0, b, 0), modv(F, 0, b, 1), H + (size_t)row * D, F.lane);
    }
}

__device__ __forceinline__ void p3_scan_naive(Frame& F) {
    if (F.bid >= 64) return;
    const int b = F.bid >> 4, h = (F.bid >> 1) & 7, dir = F.bid & 1;
    const bf16* PQ = (const bf16*)(F.ws + WS_PL), *PV = PQ + (size_t)M_ALL * D, *PZ = PQ + (size_t)(2 + dir) * M_ALL * D;
    bf16* OL = (bf16*)F.out + (size_t)dir * M_LAT * D; bf16* OC = (bf16*)(F.ws + (dir ? WS_OBC : WS_OFC));
    LAS float* fl = (LAS float*)F.lds, *kl = fl + 128, *ql = fl + 256, *ored = fl + 384;
    const int v = F.tid & 127, kq = F.tid >> 7;
    float lbv = 0.f;
    if (F.tid < 128) { const float* lb = dir ? F.in[10] : F.in[9]; lbv = sigmoidf_(lb[h * DH + F.tid] - lb[D + h * DH + F.tid]); }
    float S[32];
#pragma unroll
    for (int j = 0; j < 32; ++j) S[j] = 0.f;
    for (int s = 0; s < CTXL + SEQ; ++s) {
        int row;
        if (s < CTXL) row = M_LAT + b * CTXL + (dir ? CTXL - 1 - s : s);
        else row = b * SEQ + (dir ? SEQ - 1 - (s - CTXL) : s - CTXL);
        const size_t off = (size_t)row * D + h * DH;
        if (F.tid < 128) { const float kk = bf2f(PZ[off + F.tid]);
            fl[F.tid] = 1.f - kk; kl[F.tid] = kk; ql[F.tid] = bf2f(PQ[off + F.tid]); }
        const float vv = bf2f(PV[off + v]);
        __syncthreads();
        float po = 0.f;
#pragma unroll
        for (int j = 0; j < 32; ++j) { const int k = 32 * kq + j; S[j] = fl[k] * S[j] + kl[k] * vv; po += S[j] * ql[k]; }
        ored[kq * 128 + v] = po;
        __syncthreads();
        if (kq == 0) { const float o = (ored[v] + ored[128 + v]) + (ored[256 + v] + ored[384 + v]);
            if (s >= CTXL) OL[(size_t)row * D + h * DH + v] = (bf16)f2bf(o);
            else if (CTX_FULL) OC[(size_t)(row - M_LAT) * D + h * DH + v] = (bf16)f2bf(o); }
    }
}

typedef float f32x16 __attribute__((ext_vector_type(16)));
typedef float f32x2 __attribute__((ext_vector_type(2)));
#define MFMA32(a, b, c) __builtin_amdgcn_mfma_f32_32x32x16_bf16((a), (b), (c), 0, 0, 0)
__device__ __forceinline__ int crow(int reg, int h) { return (reg & 3) + 8 * (reg >> 2) + 4 * h; }
__device__ __forceinline__ int t256_off(int row, int cb) { return row * 256 + ((((cb >> 4) ^ (row & 15)) << 4) | (cb & 15)); }
__device__ __forceinline__ int t128_off(int row, int cb) { return row * 128 + ((((cb >> 4) ^ ((row >> 1) & 7)) << 4) | (cb & 15)); }
__device__ __forceinline__ bf16x8 pack8(const f32x16& x, int s) {
    v4u p; p.x = pk2(x[8 * s], x[8 * s + 1]); p.y = pk2(x[8 * s + 2], x[8 * s + 3]); p.z = pk2(x[8 * s + 4], x[8 * s + 5]); p.w = pk2(x[8 * s + 6], x[8 * s + 7]);
    return __builtin_bit_cast(bf16x8, p);
}
__device__ __forceinline__ void p3_scan(Frame& F) {
    constexpr int SC_QE = 0, SC_QC = 16384, SC_KR = 32768, SC_KRT = 49152, SC_VT = 65536, SC_ST = 69632, SC_TOT = 77824, SC_VEC = 81920, SC_SLOT = 83968;
    constexpr int NCH = (CTXL + SEQ) / 64;
    LAS unsigned char* L = F.lds;
    const int tid = F.tid, lane = F.lane, w = F.wave, r = lane & 31, hh = lane >> 5;
    const bf16* PQ = (const bf16*)(F.ws + WS_PL); const bf16* PV = PQ + (size_t)M_ALL * D;
    f32x16 zero16;
#pragma unroll
    for (int i = 0; i < 16; ++i) zero16[i] = 0.f;
    for (int item = F.bid; item < 256; item += F.G) {
        const int dvs = (item >> 3) & 3, bhd = (item >> 5) * 8 + (item & 7), b = bhd >> 4, h = (bhd >> 1) & 7, dir = bhd & 1;
        const bf16* PZ = PQ + (size_t)(2 + dir) * M_ALL * D;
        const int c0 = 2 * lane, colq = h * DH + c0, colv = h * DH + dvs * 32;
        bf16* OL = (bf16*)F.out + (size_t)dir * M_LAT * D; bf16* OC = (bf16*)(F.ws + (dir ? WS_OBC : WS_OFC));
        const int sgn = dir ? -1 : 1;
        __syncthreads();
        for (int i = tid; i < 8192 / 16; i += NTHR) ((LAS v4u*)(L + SC_ST))[i] = (v4u){0u, 0u, 0u, 0u};
        f32x16 S0 = zero16, S1 = zero16;
        unsigned zr[8], qr[8]; v4u vr = {0u, 0u, 0u, 0u};
#define SCAN_BASE(n) (((n) < 4) ? (M_LAT + b * CTXL + (dir ? CTXL - 1 - 64 * (n) : 64 * (n))) : (b * SEQ + (dir ? SEQ - 1 - 64 * ((n) - 4) : 64 * ((n) - 4))))
#define SCAN_LOAD(n) do { const int _base = SCAN_BASE(n); \
            _Pragma("unroll") for (int _i = 0; _i < 8; ++_i) { const size_t _o = (size_t)(_base + sgn * (8 * w + _i)) * D + colq; zr[_i] = *(const unsigned*)(PZ + _o); qr[_i] = *(const unsigned*)(PQ + _o); } \
            if (tid < 256) vr = *(const v4u*)(PV + (size_t)(_base + sgn * (tid >> 2)) * D + colv + 8 * (tid & 3)); } while (0)
        SCAN_LOAD(0);
        for (int n = 0; n < NCH; ++n) {
            float f0[8], f1[8];
            float pr0 = 1.f, pr1 = 1.f;
#pragma unroll
            for (int i = 0; i < 8; ++i) { f0[i] = 1.f - bflo(zr[i]); f1[i] = 1.f - bfhi(zr[i]); pr0 *= f0[i]; pr1 *= f1[i]; }
            *(LAS f32x2*)(L + SC_TOT + (w * 128 + c0) * 4) = (f32x2){__logf(pr0), __logf(pr1)};
            if (tid < 256) { const int p = tid >> 2, c8 = tid & 3;
#pragma unroll
                for (int j = 0; j < 8; ++j) { const unsigned hv = (vr[j >> 1] >> (16 * (j & 1))) & 0xffffu; *(LAS unsigned short*)(L + SC_VT + t128_off(8 * c8 + j, 2 * p)) = (unsigned short)hv; } }
            __syncthreads();
            float off0 = 0.f, off1 = 0.f, ref0 = 0.f, ref1 = 0.f, last0 = 0.f, last1 = 0.f;
#pragma unroll
            for (int ww = 0; ww < 8; ++ww) { const f32x2 t2 = *(const LAS f32x2*)(L + SC_TOT + (ww * 128 + c0) * 4); const float t0 = t2.x, t1 = t2.y;
                off0 += (ww < w) ? t0 : 0.f; off1 += (ww < w) ? t1 : 0.f; if (ww < 4) { ref0 += t0; ref1 += t1; } last0 += t0; last1 += t1; }
            float E0 = __expf(off0 - ref0), E1 = __expf(off1 - ref1);
            const float er0 = __expf(ref0), er1 = __expf(ref1);
            unsigned krp0[4], krp1[4];
#pragma unroll
            for (int i = 0; i < 8; i += 2) {
                float kra[2], krb[2];
#pragma unroll
                for (int u = 0; u < 2; ++u) { const int ii = i + u, srow = 8 * w + ii;
                    E0 *= f0[ii]; E1 *= f1[ii];
                    const float R0 = __builtin_amdgcn_rcpf(E0), R1 = __builtin_amdgcn_rcpf(E1);
                    const float q0 = bflo(qr[ii]), q1 = bfhi(qr[ii]);
                    kra[u] = (1.f - f0[ii]) * R0; krb[u] = (1.f - f1[ii]) * R1;
                    *(LAS unsigned*)(L + SC_QE + t256_off(srow, 2 * c0)) = pk2(q0 * E0, q1 * E1);
                    *(LAS unsigned*)(L + SC_QC + t256_off(srow, 2 * c0)) = pk2(q0 * E0 * er0, q1 * E1 * er1);
                    *(LAS unsigned*)(L + SC_KR + t256_off(srow, 2 * c0)) = pk2(kra[u], krb[u]); }
                krp0[i >> 1] = pk2(kra[0], kra[1]); krp1[i >> 1] = pk2(krb[0], krb[1]);
            }
            *(LAS v4u*)(L + SC_KRT + t128_off(c0, 16 * w)) = (v4u){krp0[0], krp0[1], krp0[2], krp0[3]};
            *(LAS v4u*)(L + SC_KRT + t128_off(c0 + 1, 16 * w)) = (v4u){krp1[0], krp1[1], krp1[2], krp1[3]};
            if (w == 0) { *(LAS f32x2*)(L + SC_VEC + c0 * 4) = (f32x2){__expf(last0), __expf(last1)};
                *(LAS f32x2*)(L + SC_VEC + 512 + c0 * 4) = (f32x2){__expf(last0 - ref0), __expf(last1 - ref1)}; }
            if (n + 1 < NCH) SCAN_LOAD(n + 1);
            __syncthreads();
            if (w < 3) {
                const int sb = (w == 2) ? 1 : 0, cb = (w == 0) ? 0 : 1;
                f32x16 x = zero16;
#pragma unroll
                for (int ks = 0; ks < 8; ++ks) { const int cbyte = (16 * ks + 8 * hh) * 2;
                    const bf16x8 a = *(const LAS bf16x8*)(L + SC_KR + t256_off(32 * sb + r, cbyte)), bq = *(const LAS bf16x8*)(L + SC_QE + t256_off(32 * cb + r, cbyte));
                    x = MFMA32(a, bq, x); }
                if (sb == cb) {
#pragma unroll
                    for (int g = 0; g < 16; ++g) x[g] = (crow(g, hh) > r) ? 0.f : x[g]; }
                f32x16 o = zero16;
#pragma unroll
                for (int sp = 0; sp < 2; ++sp) { const bf16x8 pa = pack8(x, sp); const int s0 = 32 * sb + 16 * sp + 4 * hh;
                    const v2u lo = *(const LAS v2u*)(L + SC_VT + t128_off(r, 2 * s0)), hi = *(const LAS v2u*)(L + SC_VT + t128_off(r, 2 * (s0 + 8)));
                    const bf16x8 vb = __builtin_bit_cast(bf16x8, ((v4u){lo.x, lo.y, hi.x, hi.y}));
                    o = MFMA32(pa, vb, o); }
#pragma unroll
                for (int g = 0; g < 16; ++g) *(LAS float*)(L + SC_SLOT + w * 4096 + (crow(g, hh) * 32 + r) * 4) = o[g];
            } else if (w < 5) {
                const int cb = w - 3; f32x16 o = zero16;
#pragma unroll
                for (int ks = 0; ks < 8; ++ks) { const int cbyte = (16 * ks + 8 * hh) * 2;
                    const bf16x8 a = *(const LAS bf16x8*)(L + SC_QC + t256_off(32 * cb + r, cbyte)), bs = *(const LAS bf16x8*)(L + SC_ST + t256_off(r, cbyte));
                    o = MFMA32(a, bs, o); }
#pragma unroll
                for (int g = 0; g < 16; ++g) *(LAS float*)(L + SC_SLOT + w * 4096 + (crow(g, hh) * 32 + r) * 4) = o[g];
            } else if (w < 7) {
#define SCAN_KV(ST_, kb_) do { f32x16 kv = zero16; \
                    _Pragma("unroll") for (int ks = 0; ks < 4; ++ks) { const int sbyte = (16 * ks + 8 * hh) * 2; \
                        const bf16x8 a = *(const LAS bf16x8*)(L + SC_KRT + t128_off(32 * (kb_) + r, sbyte)), bv = *(const LAS bf16x8*)(L + SC_VT + t128_off(r, sbyte)); \
                        kv = MFMA32(a, bv, kv); } \
                    _Pragma("unroll") for (int g = 0; g < 16; ++g) { const int k = 32 * (kb_) + crow(g, hh); \
                        ST_[g] = *(const LAS float*)(L + SC_VEC + k * 4) * ST_[g] + *(const LAS float*)(L + SC_VEC + 512 + k * 4) * kv[g]; } } while (0)
                const int kb0 = 2 * (w - 5);
                SCAN_KV(S0, kb0); SCAN_KV(S1, kb0 + 1);
            }
            __syncthreads();
            { const int c = tid >> 3, v0 = (tid & 7) * 4, cl = c & 31; const int so = (cl * 32 + v0) * 4;
              f32x4 o;
              if (c < 32) o = *(const LAS f32x4*)(L + SC_SLOT + so) + *(const LAS f32x4*)(L + SC_SLOT + 3 * 4096 + so);
              else o = *(const LAS f32x4*)(L + SC_SLOT + 4096 + so) + *(const LAS f32x4*)(L + SC_SLOT + 2 * 4096 + so) + *(const LAS f32x4*)(L + SC_SLOT + 4 * 4096 + so);
              const int row = SCAN_BASE(n) + sgn * c;
              const v2u ov = {pk2(o.x, o.y), pk2(o.z, o.w)};
              if (n >= 4) *(v2u*)(OL + (size_t)row * D + colv + v0) = ov;
              else if (CTX_FULL) *(v2u*)(OC + (size_t)(row - M_LAT) * D + colv + v0) = ov; }
            if (w == 5 || w == 6) { const int kb0 = 2 * (w - 5);
#pragma unroll
                for (int g = 0; g < 4; ++g) {
                    *(LAS v2u*)(L + SC_ST + t256_off(r, 2 * (32 * kb0 + 8 * g + 4 * hh))) = (v2u){pk2(S0[4 * g], S0[4 * g + 1]), pk2(S0[4 * g + 2], S0[4 * g + 3])};
                    *(LAS v2u*)(L + SC_ST + t256_off(r, 2 * (32 * (kb0 + 1) + 8 * g + 4 * hh))) = (v2u){pk2(S1[4 * g], S1[4 * g + 1]), pk2(S1[4 * g + 2], S1[4 * g + 3])}; } }
        }
#undef SCAN_KV
#undef SCAN_LOAD
#undef SCAN_BASE
    }
}

__device__ __forceinline__ void p4_readout_prep(Frame& F) {
    const int gw = F.bid * NWAVES + F.wave, NGW = F.G * NWAVES;
    const bf16* SG = (const bf16*)(F.ws + WS_PL) + (size_t)4 * M_ALL * D; bf16* YP = (bf16*)(F.ws + WS_H);
    const int nrows = CTX_FULL ? M_ALL : M_LAT;
    for (int row = gw; row < nrows; row += NGW) {
        const bf16 *ofp, *obp;
        if (row < M_LAT) { ofp = (const bf16*)F.out + (size_t)row * D; obp = ofp + (size_t)M_LAT * D; }
        else { ofp = (const bf16*)(F.ws + WS_OFC) + (size_t)(row - M_LAT) * D; obp = (const bf16*)(F.ws + WS_OBC) + (size_t)(row - M_LAT) * D; }
        const int c0 = 16 * F.lane;
        const v4u f0 = *(const v4u*)(ofp + c0), f1 = *(const v4u*)(ofp + c0 + 8), b0 = *(const v4u*)(obp + c0), b1 = *(const v4u*)(obp + c0 + 8);
        const v4u g0 = *(const v4u*)(SG + (size_t)row * D + c0), g1 = *(const v4u*)(SG + (size_t)row * D + c0 + 8);
        float o[16]; float ss = 0.f;
#pragma unroll
        for (int q = 0; q < 4; ++q) { o[2 * q] = bflo(f0[q]) + bflo(b0[q]); o[2 * q + 1] = bfhi(f0[q]) + bfhi(b0[q]); o[8 + 2 * q] = bflo(f1[q]) + bflo(b1[q]); o[8 + 2 * q + 1] = bfhi(f1[q]) + bfhi(b1[q]); }
#pragma unroll
        for (int j = 0; j < 16; ++j) ss += o[j] * o[j];
        ss += __shfl_xor(ss, 1); ss += __shfl_xor(ss, 2); ss += __shfl_xor(ss, 4);
        const float rstd = 1.f / sqrtf(ss * (1.f / DH) + EPS);
        const float* gn = F.in[11] + (c0 & 127);
        float y[16];
#pragma unroll
        for (int q = 0; q < 4; ++q) { y[2 * q] = o[2 * q] * rstd * gn[2 * q] * bflo(g0[q]); y[2 * q + 1] = o[2 * q + 1] * rstd * gn[2 * q + 1] * bfhi(g0[q]);
            y[8 + 2 * q] = o[8 + 2 * q] * rstd * gn[8 + 2 * q] * bflo(g1[q]); y[8 + 2 * q + 1] = o[8 + 2 * q + 1] * rstd * gn[8 + 2 * q + 1] * bfhi(g1[q]); }
        v4u w0, w1;
#pragma unroll
        for (int q = 0; q < 4; ++q) { w0[q] = pk2(y[2 * q], y[2 * q + 1]); w1[q] = pk2(y[8 + 2 * q], y[8 + 2 * q + 1]); }
        *(v4u*)(YP + (size_t)row * D + c0) = w0; *(v4u*)(YP + (size_t)row * D + c0 + 8) = w1;
    }
    conv_layer1(F);
}

__device__ __forceinline__ void top2_of4(float a0, float a1, float a2, float a3, int& i1, int& i2, float& sum) {
    i1 = 0; float v1 = a0;
    if (a1 > v1) { v1 = a1; i1 = 1; }
    if (a2 > v1) { v1 = a2; i1 = 2; }
    if (a3 > v1) { v1 = a3; i1 = 3; }
    const float c0 = (i1 == 0) ? -1e30f : a0, c1 = (i1 == 1) ? -1e30f : a1, c2 = (i1 == 2) ? -1e30f : a2, c3 = (i1 == 3) ? -1e30f : a3;
    i2 = 0; float v2 = c0;
    if (c1 > v2) { v2 = c1; i2 = 1; }
    if (c2 > v2) { v2 = c2; i2 = 2; }
    if (c3 > v2) { v2 = c3; i2 = 3; }
    sum = v1 + v2;
}
__device__ __forceinline__ void route_row(Frame& F, int l, int row, const f32x4 (&v)[4], int b, LAS float* rw  , int ri) {
    float s2 = 0.f;
#pragma unroll
    for (int j = 0; j < 4; ++j) s2 += (v[j].x * v[j].x + v[j].y * v[j].y) + (v[j].z * v[j].z + v[j].w * v[j].w);
    const float rstd = 1.f / sqrtf(wave_sum(s2) * (1.f / D) + EPS);
    const float* g = F.in[7] + l * D; const float* sh = modv(F, l, b, 3); const float* sc = modv(F, l, b, 4);
    unsigned long long* o8 = (unsigned long long*)((bf16*)(F.ws + WS_H) + (size_t)row * D) + F.lane;
    LAS float* hl = rw + D * NE + F.wave * D;
#pragma unroll
    for (int j = 0; j < 4; ++j) { const int c = 4 * F.lane + 256 * j;
        const f32x4 gv = *(const f32x4*)(g + c), shv = *(const f32x4*)(sh + c), scv = *(const f32x4*)(sc + c);
        const f32x4 h = v[j] * rstd * gv * (scv + 1.f) + shv;
        o8[64 * j] = (unsigned long long)pk2(h.x, h.y) | ((unsigned long long)pk2(h.z, h.w) << 32);
        *(LAS f32x4*)(hl + c) = h; }
    LDS_WAIT(); asm volatile("" ::: "memory");
    float part = 0.f;
    { const int e = F.lane & 15, k0 = (F.lane >> 4) * 256;
#pragma unroll 8
      for (int k = 0; k < 256; ++k) part += hl[k0 + k] * rw[(k0 + k) * 16 + e]; }
    part += __shfl_xor(part, 16); part += __shfl_xor(part, 32);
    LDS_WAIT(); asm volatile("" ::: "memory");
    float s[16], sel[16];
#pragma unroll
    for (int e = 0; e < 16; ++e) { s[e] = sigmoidf_(__shfl(part, e)); sel[e] = s[e] + F.in[18][e]; }
    int i1a, i2a, i1b, i2b, i1c, i2c, i1d, i2d; float gsa, gsb, gsc, gsd;
    top2_of4(sel[0], sel[1], sel[2], sel[3], i1a, i2a, gsa); top2_of4(sel[4], sel[5], sel[6], sel[7], i1b, i2b, gsb);
    top2_of4(sel[8], sel[9], sel[10], sel[11], i1c, i2c, gsc); top2_of4(sel[12], sel[13], sel[14], sel[15], i1d, i2d, gsd);
    int bpk = i1a | (i2a << 2); float bestv = gsa;
    { const bool c = gsb > bestv; bestv = c ? gsb : bestv; bpk = c ? (i1b | (i2b << 2) | 16) : bpk; }
    { const bool c = gsc > bestv; bestv = c ? gsc : bestv; bpk = c ? (i1c | (i2c << 2) | 32) : bpk; }
    { const bool c = gsd > bestv; bestv = c ? gsd : bestv; bpk = c ? (i1d | (i2d << 2) | 48) : bpk; }
    const int e1 = (bpk >> 4) * 4 + (bpk & 3), e2 = (bpk >> 4) * 4 + ((bpk >> 2) & 3);
    float s1 = 0.f, s2v = 0.f;
#pragma unroll
    for (int e = 0; e < 16; ++e) { s1 = (e == e1) ? s[e] : s1; s2v = (e == e2) ? s[e] : s2v; }
    const float inv = 1.f / (s1 + s2v);
    if (F.lane == 0) {
        LAS unsigned* lcnt = (LAS unsigned*)(rw + D * NE + NWAVES * D);
        const unsigned p1 = __hip_atomic_fetch_add(lcnt + e1, 1u, __ATOMIC_RELAXED, __HIP_MEMORY_SCOPE_WORKGROUP);
        const unsigned p2 = __hip_atomic_fetch_add(lcnt + e2, 1u, __ATOMIC_RELAXED, __HIP_MEMORY_SCOPE_WORKGROUP);
        lcnt[32 + ri] = (unsigned)e1 | (p1 << 4) | ((unsigned)e2 << 16) | (p2 << 20);
        float* slotw = (float*)(F.ws + WS_SLOTW);
        slotw[row * 2] = s1 * inv; slotw[row * 2 + 1] = s2v * inv;
    }
}
__device__ __forceinline__ void p_route(Frame& F, int l, int bank) {
    LAS float* rw = (LAS float*)F.lds;
    LAS unsigned* lcnt = (LAS unsigned*)(rw + D * NE + NWAVES * D);
    for (int i = F.tid; i < D * NE / 4; i += NTHR) ((LAS f32x4*)rw)[i] = ((const f32x4*)F.in[17])[i];
    if (F.tid < 32) lcnt[F.tid] = 0u;
    __syncthreads();
    const int gw = F.bid * NWAVES + F.wave, NGW = F.G * NWAVES;
    const int nrows = (l == 0 && CTX_FULL) ? M_ALL : M_LAT;
    int ri = F.wave * 16;
    for (int row = gw; row < nrows; row += NGW, ++ri) {
        const bool isctx = row >= M_LAT; const int b = isctx ? 4 : row / SEQ;
        const float* xr = isctx ? (const float*)(F.ws + WS_XC) + (size_t)(row - M_LAT) * D : F.out + (size_t)row * D;
        f32x4 v[4];
#pragma unroll
        for (int j = 0; j < 4; ++j) v[j] = ((const f32x4*)xr)[F.lane + 64 * j];
        route_row(F, l, row, v, b, rw, ri);
    }
    __syncthreads();
    if (F.tid < 16) lcnt[16 + F.tid] = atomicAdd((unsigned*)(F.ctl + CW_CNT + 1024 * bank + 64 * F.tid), lcnt[F.tid]);
    __syncthreads();
    if (F.tid < 128) { const int row = F.bid * NWAVES + (F.tid >> 4) + NGW * (F.tid & 15);
        if ((F.tid & 15) < 12 && row < nrows) { const unsigned en = lcnt[32 + F.tid];
            const unsigned e1 = en & 15u, p1 = ((en >> 4) & 0xfffu) + lcnt[16 + e1], e2 = (en >> 16) & 15u, p2 = (en >> 20) + lcnt[16 + e2];
            unsigned* list = (unsigned*)(F.ws + WS_LIST); unsigned* slote = (unsigned*)(F.ws + WS_SLOTE);
            list[(size_t)e1 * LIST_CAP + p1] = (unsigned)row * 2u; list[(size_t)e2 * LIST_CAP + p2] = (unsigned)row * 2u + 1u;
            slote[row * 2] = e1 | (p1 << 8); slote[row * 2 + 1] = e2 | (p2 << 8); } }
    __syncthreads();
}
__device__ __forceinline__ void moe_prefix(Frame& F, int l) {
    if (F.tid == 0) { unsigned acc = 0;
        for (int e = 0; e < 16; ++e) { const unsigned c = __hip_atomic_load((unsigned*)(F.ctl + CW_CNT + 1024 * l + 64 * e), RLX_AGENT); F.MISC[32 + e] = acc; F.MISC[32 + 17 + e] = c; acc += (c + 255u) >> 8; }
        F.MISC[32 + 16] = acc; }
    __syncthreads();
}
__device__ __forceinline__ void combine_row(Frame& F, int l, int row, int b, const volatile LAS unsigned* tb, f32x4 (&v)[4]) {
    const unsigned se0 = ((const unsigned*)(F.ws + WS_SLOTE))[row * 2], se1 = ((const unsigned*)(F.ws + WS_SLOTE))[row * 2 + 1];
    const float w0 = ((const float*)(F.ws + WS_SLOTW))[row * 2], w1 = ((const float*)(F.ws + WS_SLOTW))[row * 2 + 1];
    const size_t p0 = (size_t)tb[se0 & 255u] * 256 + (se0 >> 8), p1 = (size_t)tb[se1 & 255u] * 256 + (se1 >> 8);
    const bf16* Y2 = (const bf16*)(F.ws + WS_Y2);
    const v2u* y0 = (const v2u*)(Y2 + p0 * D) + F.lane; const v2u* y1 = (const v2u*)(Y2 + p1 * D) + F.lane;
    const float* g2 = modv(F, l, b, 5);
#pragma unroll
    for (int j = 0; j < 4; ++j) { const v2u a = y0[64 * j], c = y1[64 * j]; const f32x4 gv = *(const f32x4*)(g2 + 4 * F.lane + 256 * j);
        f32x4 ff; ff.x = w0 * bflo(a.x) + w1 * bflo(c.x); ff.y = w0 * bfhi(a.x) + w1 * bfhi(c.x); ff.z = w0 * bflo(a.y) + w1 * bflo(c.y); ff.w = w0 * bfhi(a.y) + w1 * bfhi(c.y);
        v[j] = v[j] + gv * ff; }
}
__device__ __forceinline__ void p9_combine_mod(Frame& F) {
    moe_prefix(F, 0);
    const volatile LAS unsigned* tb = F.MISC + 32;
    const int gw = F.bid * NWAVES + F.wave, NGW = F.G * NWAVES;
    const int nrows = CTX_FULL ? M_ALL : M_LAT;
    for (int row = gw; row < nrows; row += NGW) {
        const bool isctx = row >= M_LAT; const int b = isctx ? 4 : row / SEQ;
        float* xr = isctx ? (float*)(F.ws + WS_XC) + (size_t)(row - M_LAT) * D : F.out + (size_t)row * D;
        f32x4 v[4];
#pragma unroll
        for (int j = 0; j < 4; ++j) v[j] = ((const f32x4*)xr)[F.lane + 64 * j];
        combine_row(F, 0, row, b, tb, v);
#pragma unroll
        for (int j = 0; j < 4; ++j) ((f32x4*)xr)[F.lane + 64 * j] = v[j];
        if (!isctx) modulate_row(v, F.in[6] + D, modv(F, 1, b, 0), modv(F, 1, b, 1), (bf16*)(F.ws + WS_H) + (size_t)row * D, F.lane);
    }
}
__device__ __forceinline__ void p11_pool_naive(Frame& F) {
    const bf16* U = (const bf16*)(F.ws + WS_U); bf16* DP = (bf16*)(F.ws + WS_DP);
    const long total = (long)M_LAT * 128;
    for (long idx = (long)F.bid * NTHR + F.tid; idx < total; idx += (long)F.G * NTHR) {
        const int tok = (int)(idx >> 7), ch8 = (int)(idx & 127), b = tok / SEQ, t = tok % SEQ, r = t / GRIDW, c = t % GRIDW;
        const int g = ch8 >> 5, win = 2 << g, half = win >> 1;
        const int rlo = max(r - half, 0), rhi = min(r - half + win, GRIDW), clo = max(c - half, 0), chi = min(c - half + win, GRIDW);
        float acc[8];
#pragma unroll
        for (int j = 0; j < 8; ++j) acc[j] = 0.f;
        for (int rr = rlo; rr < rhi; ++rr)
            for (int cc = clo; cc < chi; ++cc) { const v4u w = *(const v4u*)(U + (size_t)(b * SEQ + rr * GRIDW + cc) * D + ch8 * 8);
#pragma unroll
                for (int q = 0; q < 4; ++q) { acc[2 * q] += bflo(w[q]); acc[2 * q + 1] += bfhi(w[q]); } }
        const float inv = 1.f / (float)((rhi - rlo) * (chi - clo));
        const v4u w = *(const v4u*)(U + (size_t)tok * D + ch8 * 8);
        v4u o;
#pragma unroll
        for (int q = 0; q < 4; ++q) o[q] = pk2(acc[2 * q] * inv - bflo(w[q]), acc[2 * q + 1] * inv - bfhi(w[q]));
        *(v4u*)(DP + ((size_t)g * M_LAT + tok) * 256 + (ch8 & 31) * 8) = o;
    }
}
__device__ __forceinline__ void p11_pool(Frame& F) {
    LAS float* I = (LAS float*)F.lds;
    const bf16* U = (const bf16*)(F.ws + WS_U); bf16* DP = (bf16*)(F.ws + WS_DP);
    const int t = F.tid;
    for (int item = F.bid; item < 512; item += F.G) {
        const int b = item >> 7, slab = item & 127, g = slab >> 5, win = 2 << g, half = win >> 1;
        const bf16* Ub = U + (size_t)b * SEQ * D + slab * 8;
        __syncthreads();
#pragma unroll
        for (int j = 0; j < 8; ++j) { const int tok = t + 512 * j, r = tok >> 6, c = tok & 63; const v4u w = *(const v4u*)(Ub + (size_t)tok * D);
            LAS f32x4* dst = (LAS f32x4*)(I + r * 512 + ((c ^ (r & 3)) * 8));
            dst[0] = (f32x4){bflo(w.x), bfhi(w.x), bflo(w.y), bfhi(w.y)}; dst[1] = (f32x4){bflo(w.z), bfhi(w.z), bflo(w.w), bfhi(w.w)}; }
        __syncthreads();
        { const int r = t >> 3, ch = t & 7; float run = 0.f;
#pragma unroll 16
          for (int c = 0; c < 64; ++c) { LAS float* p = I + r * 512 + ((c ^ (r & 3)) * 8) + ch; run += *p; *p = run; } }
        __syncthreads();
        { const int c = t >> 3, ch = t & 7; float run = 0.f;
#pragma unroll 16
          for (int r = 0; r < 64; ++r) { LAS float* p = I + r * 512 + ((c ^ (r & 3)) * 8) + ch; run += *p; *p = run; } }
        __syncthreads();
#pragma unroll 2
        for (int j = 0; j < 8; ++j) { const int tok = t + 512 * j, r = tok >> 6, c = tok & 63;
            const int rlo = max(r - half, 0), rhi = min(r - half + win, GRIDW), clo = max(c - half, 0), chi = min(c - half + win, GRIDW);
            const int r1 = rhi - 1, c1 = chi - 1, r0 = rlo - 1, c0 = clo - 1;
            const LAS f32x4* p11 = (const LAS f32x4*)(I + r1 * 512 + ((c1 ^ (r1 & 3)) * 8));
            f32x4 s0 = p11[0], s1 = p11[1];
            if (r0 >= 0) { const LAS f32x4* q = (const LAS f32x4*)(I + r0 * 512 + ((c1 ^ (r0 & 3)) * 8)); s0 -= q[0]; s1 -= q[1]; }
            if (c0 >= 0) { const LAS f32x4* q = (const LAS f32x4*)(I + r1 * 512 + ((c0 ^ (r1 & 3)) * 8)); s0 -= q[0]; s1 -= q[1]; }
            if (r0 >= 0 && c0 >= 0) { const LAS f32x4* q = (const LAS f32x4*)(I + r0 * 512 + ((c0 ^ (r0 & 3)) * 8)); s0 += q[0]; s1 += q[1]; }
            const float inv = 1.f / (float)((rhi - rlo) * (chi - clo));
            const v4u w = *(const v4u*)(Ub + (size_t)tok * D);
            v4u o; o.x = pk2(s0.x * inv - bflo(w.x), s0.y * inv - bfhi(w.x)); o.y = pk2(s0.z * inv - bflo(w.y), s0.w * inv - bfhi(w.y));
            o.z = pk2(s1.x * inv - bflo(w.z), s1.y * inv - bfhi(w.z)); o.w = pk2(s1.z * inv - bflo(w.w), s1.w * inv - bfhi(w.w));
            *(v4u*)(DP + ((size_t)g * M_LAT + (size_t)b * SEQ + tok) * 256 + (slab & 31) * 8) = o; }
    }
}
__device__ __forceinline__ void p17_final(Frame& F) {
    moe_prefix(F, 1);
    const volatile LAS unsigned* tb = F.MISC + 32;
    const int gw = F.bid * NWAVES + F.wave, NGW = F.G * NWAVES;
    for (int row = gw; row < M_LAT; row += NGW) {
        float* xr = F.out + (size_t)row * D;
        f32x4 v[4];
#pragma unroll
        for (int j = 0; j < 4; ++j) v[j] = ((const f32x4*)xr)[F.lane + 64 * j];
        combine_row(F, 1, row, row / SEQ, tb, v);
        float s2 = 0.f;
#pragma unroll
        for (int j = 0; j < 4; ++j) s2 += (v[j].x * v[j].x + v[j].y * v[j].y) + (v[j].z * v[j].z + v[j].w * v[j].w);
        const float rstd = 1.f / sqrtf(wave_sum(s2) * (1.f / D) + EPS);
#pragma unroll
        for (int j = 0; j < 4; ++j) { const f32x4 gv = *(const f32x4*)(F.in[22] + 4 * F.lane + 256 * j); ((f32x4*)xr)[F.lane + 64 * j] = v[j] * rstd * gv; }
    }
}

struct Args { const float* in[23]; float* out; unsigned char* ws; int ph_lo, ph_hi; };
#ifndef NAIVE_GEMM
#define RUN_GEMM(EpiT, SchedT, g, S, E) gemm_phase<EpiT, SchedT, true, true>(F.lds, g, S, E)
#else
#define RUN_GEMM(EpiT, SchedT, g, S, E) gemm_naive<EpiT, SchedT>(g, S, E)
#endif

__global__ void __launch_bounds__(NTHR, 2) fwd_kernel(Args args) {
    extern __shared__ __attribute__((aligned(16))) unsigned char lds[];
    Frame F;
    F.lds = (LAS unsigned char*)lds; F.MISC = (volatile LAS unsigned*)(F.lds + MISC_OFF);
    F.tid = threadIdx.x; F.lane = F.tid & 63; F.wave = __builtin_amdgcn_readfirstlane(F.tid >> 6);
    F.G = gridDim.x; F.bid = blockIdx.x;
#pragma unroll
    for (int i = 0; i < 23; ++i) F.in[i] = args.in[i];
    F.out = args.out; F.ws = args.ws; F.ctl = (gu32*)(args.ws + WS_CTL);
    for (int u = F.tid; u < (LDS_BYTES - LDSCTL_OFF) / 4; u += NTHR) ((LAS unsigned*)(F.lds + LDSCTL_OFF))[u] = 0u;
    __syncthreads();
    XcdBarrier bar; bar.bar = (unsigned*)(F.ctl + CW_BAR); bar.x = 0; bar.st = nullptr;
    if (MK_ONE_LAUNCH) bar = xcd_barrier_post((unsigned*)(F.ctl + CW_BAR), F.MISC + 8);
    const int lo = args.ph_lo, hi = args.ph_hi;
#ifndef PHMASK
#define PHMASK 0x3ffff
#endif
#define IN(k) (((PHMASK >> (k)) & 1) && lo <= (k) && (k) < hi)
#ifndef REPMASK
#define REPMASK 0
#endif
#define REPLOOP(k) for (int _r = 0; _r <= ((REPMASK >> (k)) & 1); (++_r <= ((REPMASK >> (k)) & 1)) ? xcd_barrier(bar) : (void)0)
#define SEAM(k) do { if (IN(k) && IN((k) + 1)) xcd_barrier(bar); } while (0)
    bf16* const PL = (bf16*)(F.ws + WS_PL);

    if (IN(0)) REPLOOP(0) { p0_prep(F); } SEAM(0);
    if (IN(1)) REPLOOP(1) { p1_modulate0(F); } SEAM(1);
    if (IN(2)) REPLOOP(2) {
        Gemm g{(const bf16*)(F.ws + WS_H), (const bf16*)(F.ws + WS_WHGIN), D}; StaticOrder S; S.init(M_ALL, NPROJ * D, F.G, F.bid);
        EpiInProj E{PL, (const float*)(F.ws + WS_LBV)}; RUN_GEMM(EpiInProj, StaticOrder, g, S, E); } SEAM(2);
    #ifdef SCAN_NAIVE
    if (IN(3)) REPLOOP(3) { p3_scan_naive(F); } SEAM(3);
#else
    if (IN(3)) REPLOOP(3) { p3_scan(F); } SEAM(3);
#endif
    if (IN(4)) REPLOOP(4) { p4_readout_prep(F); } SEAM(4);
    if (IN(5)) REPLOOP(5) {
        Gemm g{(const bf16*)(F.ws + WS_H), (const bf16*)(F.ws + WS_WHGOUT), D}; StaticOrder S; S.init(CTX_FULL ? M_ALL : M_LAT, D, F.G, F.bid);
        EpiResid E{F.in[0], F.in[2], F.out, (float*)(F.ws + WS_XC), modv(F, 0, 0, 2)}; RUN_GEMM(EpiResid, StaticOrder, g, S, E); } SEAM(5);
    if (IN(6)) REPLOOP(6) { p_route(F, 0, (_r < ((REPMASK >> 6) & 1)) ? 2 : 0); } SEAM(6);
    if (IN(7)) REPLOOP(7) { moe_prefix(F, 0);
        Gemm g{(const bf16*)(F.ws + WS_H), (const bf16*)(F.ws + WS_WGU0), D}; MoeOrder S{F.G, F.bid, 2, 1, F.MISC + 32, (const unsigned*)(F.ws + WS_LIST)};
        EpiGateUp E{(bf16*)(F.ws + WS_ACT)}; RUN_GEMM(EpiGateUp, MoeOrder, g, S, E); } SEAM(7);
    if (IN(8)) REPLOOP(8) { moe_prefix(F, 0);
        Gemm g{(const bf16*)(F.ws + WS_ACT), (const bf16*)(F.ws + WS_WD0), DE}; MoeOrder S{F.G, F.bid, 4, 0, F.MISC + 32, (const unsigned*)(F.ws + WS_LIST)};
        EpiDown E{(bf16*)(F.ws + WS_Y2)}; RUN_GEMM(EpiDown, MoeOrder, g, S, E); } SEAM(8);
    if (IN(9)) REPLOOP(9) { p9_combine_mod(F); } SEAM(9);
    if (IN(10)) REPLOOP(10) {
        Gemm g{(const bf16*)(F.ws + WS_H), (const bf16*)(F.ws + WS_WPIN), D}; StaticOrder S; S.init(M_LAT, D, F.G, F.bid);
        EpiBf16Plain E{(bf16*)(F.ws + WS_U), D}; RUN_GEMM(EpiBf16Plain, StaticOrder, g, S, E); } SEAM(10);
    #ifdef POOL_NAIVE
    if (IN(11)) REPLOOP(11) { p11_pool_naive(F); } SEAM(11);
#else
    if (IN(11)) REPLOOP(11) { p11_pool(F); } SEAM(11);
#endif
    if (IN(12)) REPLOOP(12) {
        Gemm g{(const bf16*)(F.ws + WS_DP), (const bf16*)(F.ws + WS_WGRP), 256}; GroupOrder S{F.G, F.bid};
        EpiGrp E{(bf16*)(F.ws + WS_E), F.in[15]}; RUN_GEMM(EpiGrp, GroupOrder, g, S, E); } SEAM(12);
    if (IN(13)) REPLOOP(13) {
        Gemm g{(const bf16*)(F.ws + WS_E), (const bf16*)(F.ws + WS_WPOUT), D}; StaticOrder S; S.init(M_LAT, D, F.G, F.bid);
        EpiResid E{F.out, nullptr, F.out, nullptr, modv(F, 1, 0, 2)}; RUN_GEMM(EpiResid, StaticOrder, g, S, E); } SEAM(13);
    if (IN(14)) REPLOOP(14) { p_route(F, 1, (_r < ((REPMASK >> 14) & 1)) ? 3 : 1); } SEAM(14);
    if (IN(15)) REPLOOP(15) { moe_prefix(F, 1);
        Gemm g{(const bf16*)(F.ws + WS_H), (const bf16*)(F.ws + WS_WGU1), D}; MoeOrder S{F.G, F.bid, 2, 1, F.MISC + 32, (const unsigned*)(F.ws + WS_LIST)};
        EpiGateUp E{(bf16*)(F.ws + WS_ACT)}; RUN_GEMM(EpiGateUp, MoeOrder, g, S, E); } SEAM(15);
    if (IN(16)) REPLOOP(16) { moe_prefix(F, 1);
        Gemm g{(const bf16*)(F.ws + WS_ACT), (const bf16*)(F.ws + WS_WD1), DE}; MoeOrder S{F.G, F.bid, 4, 0, F.MISC + 32, (const unsigned*)(F.ws + WS_LIST)};
        EpiDown E{(bf16*)(F.ws + WS_Y2)}; RUN_GEMM(EpiDown, MoeOrder, g, S, E); } SEAM(16);
    if (IN(17)) REPLOOP(17) { p17_final(F); }
#undef IN
#undef SEAM
}

extern "C" void kernel_launch(void* const* d_in, const int* in_sizes, int n_in, void* d_out, int out_size, void* d_ws, size_t ws_size, hipStream_t stream) {
    static int grid = 0;
    if (grid == 0) {
        if (n_in != 23 || in_sizes[0] != M_LAT * D || out_size != M_LAT * D || ws_size < WS_END) { fprintf(stderr, "kernel_launch: unexpected shapes (n_in %d, in0 %d, out %d, ws %zu); nothing launched\n", n_in, n_in > 0 ? in_sizes[0] : -1, out_size, ws_size); grid = -1; return; }
        int dev = 0, cus = 0, per_cu = 0;
        if (hipGetDevice(&dev) != hipSuccess || hipDeviceGetAttribute(&cus, hipDeviceAttributeMultiprocessorCount, dev) != hipSuccess) { grid = -1; return; }
        if (hipFuncSetAttribute((const void*)fwd_kernel, hipFuncAttributeMaxDynamicSharedMemorySize, LDS_BYTES) != hipSuccess) { fprintf(stderr, "kernel_launch: hipFuncSetAttribute failed\n"); grid = -1; return; }
        if (hipOccupancyMaxActiveBlocksPerMultiprocessor(&per_cu, (const void*)fwd_kernel, NTHR, LDS_BYTES) != hipSuccess || per_cu < 1) { fprintf(stderr, "kernel_launch: occupancy query says %d blocks per CU\n", per_cu); per_cu = 1; }
        (void)hipGetLastError();
        grid = cus;
    }
    if (grid < 0) return;
    if (hipMemsetAsync((char*)d_ws + WS_CTL, 0, CTL_ZERO_BYTES, stream) != hipSuccess) return;
    Args a{};
    for (int i = 0; i < 23; ++i) a.in[i] = (const float*)d_in[i];
    a.out = (float*)d_out; a.ws = (unsigned char*)d_ws;
    if (MK_ONE_LAUNCH) { a.ph_lo = 0; a.ph_hi = NPHASE; hipLaunchKernelGGL(fwd_kernel, dim3(grid), dim3(NTHR), LDS_BYTES, stream, a); }
    else for (int p = 0; p < NPHASE; ++p) { a.ph_lo = p; a.ph_hi = p + 1; hipLaunchKernelGGL(fwd_kernel, dim3(grid), dim3(NTHR), LDS_BYTES, stream, a); }
}
```

```cpp
#include <hip/hip_runtime.h>
#include <cstdio>
#include <cstdint>

#ifndef MK_ONE_LAUNCH
#define MK_ONE_LAUNCH 1
#endif
#ifndef CTX_FULL
#define CTX_FULL 0
#endif

constexpr int D = 1024, NB = 4, SEQ = 4096, CTXL = 256;
constexpr int M_LAT = NB * SEQ, M_CTX = NB * CTXL, M_ALL = M_LAT + M_CTX;
constexpr int NH = 8, DH = 128, NPROJ = 5;
constexpr int NE = 16, DE = 256, NGRP = 4, EPG = 4;
constexpr int GRIDW = 64;
constexpr float EPS = 1e-6f;
constexpr int NWAVES = 8, NTHR = 512;
constexpr int NPHASE = 18;

constexpr size_t MiB = 1u << 20;
constexpr size_t WS_CTL = 0, CTL_ZERO_BYTES = 1 * MiB;
constexpr size_t WS_MODV = 1 * MiB;
constexpr size_t WS_LBV = 1 * MiB + 256 * 1024;
constexpr size_t WS_LIST = 2 * MiB;
constexpr size_t WS_SLOTE = 2 * MiB + 1280 * 1024;
constexpr size_t WS_SLOTW = 2 * MiB + 1536 * 1024;
constexpr size_t WS_WHGIN = 4 * MiB;
constexpr size_t WS_WHGOUT = 14 * MiB;
constexpr size_t WS_WGU0 = 16 * MiB;
constexpr size_t WS_WD0 = 32 * MiB;
constexpr size_t WS_XC = 40 * MiB;
constexpr size_t WS_H = 44 * MiB;
constexpr size_t WS_PL = 78 * MiB;
constexpr size_t PLANE = (size_t)M_ALL * D * 2;
constexpr size_t WS_OFC = 248 * MiB, WS_OBC = 250 * MiB;
constexpr size_t WS_WPIN = 78 * MiB, WS_WGRP = 80 * MiB, WS_WPOUT = 81 * MiB;
constexpr size_t WS_WGU1 = 83 * MiB, WS_WD1 = 99 * MiB;
constexpr size_t WS_ACT = 108 * MiB;
constexpr size_t WS_Y2 = 128 * MiB;
constexpr size_t WS_U = 204 * MiB;
constexpr size_t WS_DP = 108 * MiB;
constexpr size_t WS_E = 140 * MiB;
constexpr size_t WS_END = 256 * MiB;
static_assert(WS_PL + 5 * PLANE <= WS_OFC && WS_H + PLANE <= WS_PL && WS_Y2 + (size_t)38912 * 2048 <= WS_U && WS_U + (size_t)M_LAT * 2048 <= WS_OFC, "ws map");
static_assert(WS_ACT + (size_t)38912 * 512 <= WS_Y2 && WS_DP + (size_t)M_LAT * 2048 <= WS_E && WS_E + (size_t)M_LAT * 2048 <= WS_U && WS_WD1 + 8 * MiB <= WS_ACT, "ws map 2");
constexpr int CW_BAR = 4096;
constexpr int CW_CNT = 8192;
constexpr int LIST_CAP = M_ALL;

constexpr int RING_BYTES = 131072;
constexpr int LDSCTL_OFF = RING_BYTES, MISC_OFF = LDSCTL_OFF + 320;
constexpr int LDS_BYTES = 147456;

#define GAS __attribute__((address_space(1)))
#define LAS __attribute__((address_space(3)))
typedef unsigned short bf16;
typedef unsigned v4u __attribute__((ext_vector_type(4)));
typedef unsigned v2u __attribute__((ext_vector_type(2)));
typedef float f32x4 __attribute__((ext_vector_type(4)));
typedef short bf16x8 __attribute__((ext_vector_type(8)));
typedef GAS unsigned gu32;
#define RLX_AGENT __ATOMIC_RELAXED, __HIP_MEMORY_SCOPE_AGENT
#define LDS_WAIT() asm volatile("s_waitcnt lgkmcnt(0)" ::: "memory")
#define VM_WAIT() asm volatile("s_waitcnt vmcnt(0)" ::: "memory")

__device__ __forceinline__ unsigned f2bf(float f) { unsigned u = __builtin_bit_cast(unsigned, f); return (u + 0x7fffu + ((u >> 16) & 1u)) >> 16; }
typedef float f32x2_t __attribute__((ext_vector_type(2)));
typedef __bf16 bf16x2_t __attribute__((ext_vector_type(2)));
__device__ __forceinline__ unsigned pk2(float lo, float hi) { const f32x2_t v = {lo, hi}; const bf16x2_t b = __builtin_convertvector(v, bf16x2_t); return __builtin_bit_cast(unsigned, b); }
__device__ __forceinline__ float bf2f(unsigned b) { return __builtin_bit_cast(float, b << 16); }
__device__ __forceinline__ float bflo(unsigned w) { return __builtin_bit_cast(float, w << 16); }
__device__ __forceinline__ float bfhi(unsigned w) { return __builtin_bit_cast(float, w & 0xffff0000u); }
__device__ __forceinline__ float sigmoidf_(float x) { return 1.f / (1.f + __expf(-x)); }
__device__ __forceinline__ float siluf_(float x) { return x / (1.f + __expf(-x)); }
__device__ __forceinline__ float wave_sum(float v) {
#pragma unroll
    for (int o = 1; o < 64; o <<= 1) v += __shfl_xor(v, o);
    return v;
}

#define XB_TMO      128
#define XB_XCNT(j)  (256  + 64 * (j))
#define XB_XSUB(j)  (1280 + 64 * (j))
#define XB_XGEN(j)  (2304 + 64 * (j))
#define XB_TOP      3328
#define XB_TOPGEN   3392
#define XCD_BAR_WORDS 3456
#define XB_SPIN_CAP (1u << 18)
__device__ __forceinline__ unsigned xb_ld(unsigned* p)              { return __hip_atomic_load(p, __ATOMIC_RELAXED, __HIP_MEMORY_SCOPE_AGENT); }
__device__ __forceinline__ unsigned xb_add(unsigned* p, unsigned v) { return __hip_atomic_fetch_add(p, v, __ATOMIC_RELAXED, __HIP_MEMORY_SCOPE_AGENT); }
__device__ __forceinline__ unsigned xb_xcc_id() { return (unsigned)__builtin_amdgcn_s_getreg((3 << 11) | 20) & 0xFu; }
#define XB_SPIN(cond, bar) do { unsigned _sp = 0; while (cond) { __builtin_amdgcn_s_sleep(1); \
    if ((++_sp & 255u) == 0u) { if (xb_ld(&(bar)[XB_TMO])) break; if (_sp > XB_SPIN_CAP) { atomicAdd(&(bar)[XB_TMO], 1u); break; } } } } while (0)
struct XcdBarrier { unsigned* bar; unsigned x; volatile LAS unsigned* st; };
__device__ __forceinline__ XcdBarrier xcd_barrier_post(unsigned* bar, volatile LAS unsigned* st) {
    XcdBarrier b; b.bar = bar; b.x = xb_xcc_id(); b.st = st;
    if (threadIdx.x == 0) (void)xb_add(&bar[XB_XCNT(b.x)], 1u);
    return b;
}
__device__ __forceinline__ void xcd_barrier_complete(unsigned* bar, unsigned x, unsigned& nloc, unsigned& nx) {
    const unsigned G = gridDim.x * gridDim.y * gridDim.z;
    unsigned sum, cnt, mine, sp = 0u;
    for (;;) {
        sum = 0u; cnt = 0u; mine = 0u;
#pragma unroll
        for (unsigned j = 0; j < 16; ++j) { const unsigned c = xb_ld(&bar[XB_XCNT(j)]); sum += c; cnt += (c > 0u) ? 1u : 0u; mine = (j == x) ? c : mine; }
        if (sum == G) break;
        __builtin_amdgcn_s_sleep(1);
        if ((++sp & 255u) == 0u) { if (xb_ld(&bar[XB_TMO])) break; if (sp > XB_SPIN_CAP) { atomicAdd(&bar[XB_TMO], 1u); break; } }
    }
    nloc = mine > 0u ? mine : 1u; nx = cnt > 0u ? cnt : 1u;
}
__device__ __forceinline__ void xcd_barrier(const XcdBarrier& b) {
    asm volatile("s_waitcnt vmcnt(0)" ::: "memory");
    __syncthreads();
    if (threadIdx.x == 0) {
        unsigned* bar = b.bar;
        __builtin_amdgcn_s_waitcnt(0);
        unsigned nloc = b.st[0], nx = b.st[1];
        if (nloc == 0u) { xcd_barrier_complete(bar, b.x, nloc, nx); b.st[0] = nloc; b.st[1] = nx; }
        const unsigned old = xb_add(&bar[XB_XSUB(b.x)], 1u);
        const unsigned gen = old / nloc;
        if (old + 1u == (gen + 1u) * nloc) {
            __builtin_amdgcn_fence(__ATOMIC_RELEASE, "agent");
            asm volatile("s_waitcnt vmcnt(0)" ::: "memory");
            const unsigned og = xb_add(&bar[XB_TOP], 1u);
            const unsigned tg = og / nx;
            if (og + 1u == (tg + 1u) * nx) xb_add(&bar[XB_TOPGEN], 1u);
            else XB_SPIN(xb_ld(&bar[XB_TOPGEN]) == tg, bar);
            __builtin_amdgcn_fence(__ATOMIC_ACQUIRE, "agent");
            xb_add(&bar[XB_XGEN(b.x)], 1u);
            asm volatile("s_waitcnt vmcnt(0)" ::: "memory");
        } else {
            XB_SPIN(xb_ld(&bar[XB_XGEN(b.x)]) == gen, bar);
            __builtin_amdgcn_fence(__ATOMIC_ACQUIRE, "agent");
            asm volatile("s_waitcnt vmcnt(0)" ::: "memory");
        }
    }
    __syncthreads();
}

struct Unit { int pm, pn; };
struct Gemm { const bf16* A; const bf16* Bt; int K; size_t kstepA; };
constexpr int NXCD = 8, WGM = 8, BM = 256;

struct StaticOrder {
    int nM, nN, nwg, G, c;
    __device__ __forceinline__ void init(int M, int N, int G_, int c_) { nM = M / BM; nN = N / BM; nwg = nM * nN; G = G_; c = c_; }
    __device__ __forceinline__ bool next(int i, Unit& u) const {
        const long L = (long)i * G + c; if (L >= nwg) return false;
        int wgid = (int)L; { const int q = nwg / NXCD, r = nwg % NXCD, xcd = wgid % NXCD, off = wgid / NXCD; wgid = (xcd < r ? xcd * (q + 1) : r * (q + 1) + (xcd - r) * q) + off; }
        const int nig = WGM * nN, gid = wgid / nig, fm = gid * WGM, gsz = (nM - fm) < WGM ? (nM - fm) : WGM;
        u.pm = fm + ((wgid % nig) % gsz); u.pn = (wgid % nig) / gsz; return true;
    }
    __device__ __forceinline__ int a_row(const Unit& u, int r) const { return u.pm * BM + r; }
    __device__ __forceinline__ unsigned a_off(const Unit& u, int r, int c, int K) const { return (unsigned)((u.pm * BM + r) * K + c) * 2u; }
};
struct GroupOrder {
    int G, c;
    __device__ __forceinline__ bool next(int i, Unit& u) const { const int L = i * G + c; if (L >= 256) return false; u.pm = L; u.pn = L >> 6; return true; }
    __device__ __forceinline__ int a_row(const Unit& u, int r) const { return u.pm * BM + r; }
    __device__ __forceinline__ unsigned a_off(const Unit& u, int r, int c, int K) const { return (unsigned)(((u.pn * 32 + (c >> 3)) * M_LAT + (u.pm & 63) * BM + r) * 8 + (c & 7)) * 2u; }
};
struct MoeOrder {
    int G, c, npn, gather; const volatile LAS unsigned* tb; const unsigned* list;
    __device__ __forceinline__ bool next(int i, Unit& u) const {
        const int L = i * G + c; const int nt = (int)tb[16];
        if (L >= nt * npn) return false;
        const int t = L / npn, nl = L % npn; int e = 0;
#pragma unroll
        for (int j = 1; j < 16; ++j) e += (t >= (int)tb[j]) ? 1 : 0;
        u.pm = t; u.pn = e * npn + nl; return true;
    }
    __device__ __forceinline__ int a_row(const Unit& u, int r) const {
        if (!gather) return u.pm * BM + r;
        const int e = u.pn / npn; const int idx = (u.pm - (int)tb[e]) * BM + r;
        const unsigned ent = (idx < (int)tb[17 + e]) ? list[(size_t)e * LIST_CAP + idx] : 0u;
        return (int)(ent >> 1);
    }
    __device__ __forceinline__ unsigned a_off(const Unit& u, int r, int c, int K) const { return (unsigned)(a_row(u, r) * K + c) * 2u; }
};

template <class Epi, class Sched>
__device__ __forceinline__ void gemm_naive(const Gemm g, const Sched& S, const Epi& E) {
    const int tid = threadIdx.x, wid = tid >> 6, lane = tid & 63, wr = wid >> 2, wc = wid & 3, fr = lane & 15, fq = lane >> 4;
    const int K = g.K;
    Unit u;
    for (int i = 0; S.next(i, u); ++i) {
        f32x4 acc[2][2][4][2];
#pragma unroll
        for (int ai = 0; ai < 2; ++ai)
#pragma unroll
            for (int m = 0; m < 4; ++m) {
                const bf16* ar = g.A + (size_t)S.a_row(u, 128 * ai + 64 * wr + 16 * m + fr) * K;
#pragma unroll
                for (int bj = 0; bj < 2; ++bj)
#pragma unroll
                    for (int n = 0; n < 2; ++n) {
                        const int c0 = 128 * bj + 32 * wc + (Epi::PERM ? 8 * fq + 4 * n : 16 * n + 4 * fq);
                        const bf16* br = g.Bt + (size_t)(u.pn * BM + c0) * K;
                        f32x4 a0 = {0.f, 0.f, 0.f, 0.f};
#pragma unroll 1
                        for (int k = 0; k < K; k += 8) {
                            const v4u b0 = *(const v4u*)(br + k), b1 = *(const v4u*)(br + (size_t)K + k), b2 = *(const v4u*)(br + (size_t)2 * K + k), b3 = *(const v4u*)(br + (size_t)3 * K + k);
                            const v4u x0 = *(const v4u*)(ar + k);
#pragma unroll
                            for (int q = 0; q < 4; ++q) {
                                const f32x4 blo = {bflo(b0[q]), bflo(b1[q]), bflo(b2[q]), bflo(b3[q])}, bhi = {bfhi(b0[q]), bfhi(b1[q]), bfhi(b2[q]), bfhi(b3[q])};
                                a0 += blo * bflo(x0[q]) + bhi * bfhi(x0[q]);
                            }
                        }
                        asm volatile("" : "+v"(a0));
                        acc[ai][bj][m][n] = a0;
                    }
            }
        E(acc, u, wr, wc, fr, fq);
    }
}

constexpr int BK = 64, HALF = 128, HTB = HALF * BK * 2;
__device__ __forceinline__ int lds_byte(int r, int c) { const int st = (r >> 4) * 2 + (c >> 5), rr = r & 15, cc = c & 31, ob = rr * 64 + cc * 2; return st * 1024 + (ob ^ (((ob >> 9) & 1) << 5)); }
__device__ __forceinline__ void stage_rc(int b, int& R, int& C) { const int st = b / 1024, sb = b % 1024, swz = sb ^ (((sb >> 9) & 1) << 5); R = (st >> 1) * 16 + swz / 64; C = (st & 1) * 32 + (swz % 64) / 2; }
__device__ __forceinline__ int perm32(int rho) { const int n = rho >> 4, i = rho & 15; return 8 * (i >> 2) + 4 * n + (i & 3); }
template <class Epi, class Sched, bool ALIGN_EPI = false, bool SP2 = false>
__device__ __forceinline__ void gemm_phase(LAS unsigned char* lds, const Gemm g, const Sched& S, const Epi& E) {
    const int tid = threadIdx.x, wid = __builtin_amdgcn_readfirstlane(tid >> 6), lane = tid & 63, wr = wid >> 2, wc = wid & 3, fr = lane & 15, fq = lane >> 4;
    const int K = g.K, nt = K / BK;
    unsigned vAc0[2], vAc1[2], vAn0[2], vAn1[2], voffB[2]; int stR[2], stC[2];
#pragma unroll
    for (int i = 0; i < 2; ++i) { int R, C; stage_rc(tid * 16 + i * 8192, R, C); const int Rb = Epi::PERM ? ((R & ~31) + perm32(R & 31)) : R;
        stR[i] = R; stC[i] = C; voffB[i] = (unsigned)(Rb * K + C) * 2u; }
#define PG8_SETA(v0, v1, U) do { _Pragma("unroll") for (int _i = 0; _i < 2; ++_i) { v0[_i] = S.a_off(U, stR[_i], stC[_i], K); v1[_i] = S.a_off(U, HALF + stR[_i], stC[_i], K); } } while (0)
    const size_t kstep = (size_t)(BK * 2);
    const size_t kstepA = g.kstepA;
    const size_t hstep = (size_t)HALF * K * 2;
    const size_t tstep = 2 * hstep;
    const unsigned ldsw = (unsigned)wid * 1024u;
    const int aoff = lds_byte(wr * 64 + fr, fq * 8), boff = lds_byte(wc * 32 + fr, fq * 8);
#define PG8_SA(b, h) (((b) * 2 + (h)) * HTB)
#define PG8_SB(b, h) ((4 + (b) * 2 + (h)) * HTB)
#define PG8_STAGE(bufoff, gbase, voff) do { _Pragma("unroll") for (int _i = 0; _i < 2; ++_i) \
        __builtin_amdgcn_global_load_lds((const unsigned*)((const char*)(gbase) + (voff)[_i]), (LAS unsigned*)(lds + (bufoff) + ldsw + _i * 8192), 16, 0, 0); } while (0)
#define PG8_LDA(dst, b, h) do { _Pragma("unroll") for (int m = 0; m < 4; ++m) _Pragma("unroll") for (int k = 0; k < 2; ++k) dst[m][k] = *(const LAS bf16x8*)(lds + PG8_SA(b, h) + aoff + m * 2048 + k * 1024); } while (0)
#define PG8_LDB(dst, b, h) do { _Pragma("unroll") for (int n = 0; n < 2; ++n) _Pragma("unroll") for (int k = 0; k < 2; ++k) dst[n][k] = *(const LAS bf16x8*)(lds + PG8_SB(b, h) + boff + n * 2048 + k * 1024); } while (0)
#define PG8_MMA(ai, bj, At, Bt) do { __builtin_amdgcn_s_setprio(1); _Pragma("unroll") for (int m = 0; m < 4; ++m) _Pragma("unroll") for (int n = 0; n < 2; ++n) _Pragma("unroll") for (int k = 0; k < 2; ++k) \
        acc[ai][bj][m][n] = __builtin_amdgcn_mfma_f32_16x16x32_bf16(Bt[n][k], At[m][k], acc[ai][bj][m][n], 0, 0, 0); __builtin_amdgcn_s_setprio(0); } while (0)
#define PG8_WAIT_V(n) asm volatile("s_waitcnt vmcnt(" #n ")" ::: "memory")
#define PG8_WAIT_L(n) asm volatile("s_waitcnt lgkmcnt(" #n ")" ::: "memory")
#define PG8_BAR __builtin_amdgcn_s_barrier()
#define PG8_SCHED __builtin_amdgcn_sched_barrier(0)
    Unit cur, nxt; int ui = 0;
    if (!S.next(0, cur)) return;
    f32x4 acc[2][2][4][2];
#pragma unroll
    for (int a = 0; a < 2; ++a)
#pragma unroll
        for (int b = 0; b < 2; ++b)
#pragma unroll
            for (int m = 0; m < 4; ++m)
#pragma unroll
                for (int n = 0; n < 2; ++n) acc[a][b][m][n] = (f32x4){0.f, 0.f, 0.f, 0.f};
    bf16x8 At[4][2], B0[2][2], B1[2][2];
    const char* const cA = (const char*)g.A; PG8_SETA(vAc0, vAc1, cur); const char* cB = (const char*)g.Bt + (size_t)cur.pn * tstep;
    if constexpr (SP2) {
        PG8_STAGE(PG8_SB(0, 0), cB, voffB); PG8_STAGE(PG8_SB(0, 1), cB + hstep, voffB); PG8_STAGE(PG8_SA(0, 0), cA, vAc0); PG8_STAGE(PG8_SA(0, 1), cA, vAc1);
        if (wr == 1) PG8_BAR;
        PG8_WAIT_V(2); PG8_BAR;
        PG8_STAGE(PG8_SB(1, 0), cB + kstep, voffB); PG8_STAGE(PG8_SA(1, 0), cA + kstepA, vAc0); PG8_STAGE(PG8_SB(1, 1), cB + hstep + kstep, voffB);
        PG8_WAIT_V(6); PG8_BAR;
    } else {
        PG8_STAGE(PG8_SB(0, 0), cB, voffB); PG8_STAGE(PG8_SA(0, 0), cA, vAc0); PG8_STAGE(PG8_SB(0, 1), cB + hstep, voffB); PG8_STAGE(PG8_SA(0, 1), cA, vAc1);
        if (wr == 1) PG8_BAR;
        PG8_WAIT_V(4); PG8_BAR;
        PG8_STAGE(PG8_SB(1, 0), cB + kstep, voffB); PG8_STAGE(PG8_SA(1, 0), cA + kstepA, vAc0); PG8_STAGE(PG8_SB(1, 1), cB + hstep + kstep, voffB);
        PG8_WAIT_V(6); PG8_BAR;
    }
    for (;;) {
        const bool has_next = S.next(ui + 1, nxt);
        if (has_next) { PG8_SETA(vAn0, vAn1, nxt); } else { vAn0[0] = vAc0[0]; vAn0[1] = vAc0[1]; vAn1[0] = vAc1[0]; vAn1[1] = vAc1[1]; }
        const char* nB = has_next ? (const char*)g.Bt + (size_t)nxt.pn * tstep : cB;
#pragma unroll 1
        for (int t = 0; t < nt; t += 2) {
            const bool last = (t == nt - 2);
            const char* a1 = cA + (size_t)(t + 1) * kstepA;
            const char* a2 = last ? cA : cA + (size_t)(t + 2) * kstepA; unsigned w0[2], w1[2]; w0[0] = last ? vAn0[0] : vAc0[0]; w0[1] = last ? vAn0[1] : vAc0[1]; w1[0] = last ? vAn1[0] : vAc1[0]; w1[1] = last ? vAn1[1] : vAc1[1]; const char* b2 = last ? nB : cB + (size_t)(t + 2) * kstep;
            const char* a3 = a2 + kstepA; const char* b3 = b2 + kstep;
            if constexpr (SP2) {
            PG8_LDB(B0, 0, 0); PG8_LDB(B1, 0, 1); PG8_SCHED; PG8_LDA(At, 0, 0); PG8_STAGE(PG8_SA(1, 1), a1, vAc1);
            PG8_WAIT_V(8); PG8_WAIT_L(0); PG8_BAR; PG8_MMA(0, 0, At, B0); PG8_MMA(0, 1, At, B1); PG8_BAR; PG8_SCHED;
            PG8_LDA(At, 0, 1); PG8_STAGE(PG8_SB(0, 0), b2, voffB); PG8_STAGE(PG8_SB(0, 1), b2 + hstep, voffB); PG8_STAGE(PG8_SA(0, 0), a2, w0);
            PG8_WAIT_V(8); PG8_WAIT_L(0); PG8_BAR; PG8_MMA(1, 0, At, B0); PG8_MMA(1, 1, At, B1); PG8_BAR; PG8_SCHED;
            PG8_LDB(B0, 1, 0); PG8_LDB(B1, 1, 1); PG8_SCHED; PG8_LDA(At, 1, 0); PG8_STAGE(PG8_SA(0, 1), a2, w1);
            PG8_WAIT_V(8); PG8_WAIT_L(0); PG8_BAR; PG8_MMA(0, 0, At, B0); PG8_MMA(0, 1, At, B1); PG8_BAR; PG8_SCHED;
            PG8_LDA(At, 1, 1); PG8_STAGE(PG8_SB(1, 0), b3, voffB); PG8_STAGE(PG8_SB(1, 1), b3 + hstep, voffB); PG8_STAGE(PG8_SA(1, 0), a3, w0);
            PG8_WAIT_V(8); PG8_WAIT_L(0); PG8_BAR; PG8_MMA(1, 0, At, B0); PG8_MMA(1, 1, At, B1); PG8_BAR; PG8_SCHED;
            } else {
            PG8_LDB(B0, 0, 0); PG8_SCHED; PG8_LDA(At, 0, 0); PG8_STAGE(PG8_SA(1, 1), a1, vAc1);
            PG8_WAIT_L(8); PG8_BAR; PG8_WAIT_L(0); PG8_MMA(0, 0, At, B0); PG8_BAR; PG8_SCHED;
            PG8_LDB(B1, 0, 1); PG8_STAGE(PG8_SB(0, 0), b2, voffB);
            PG8_BAR; PG8_WAIT_L(0); PG8_MMA(0, 1, At, B1); PG8_BAR;
            PG8_LDA(At, 0, 1); PG8_STAGE(PG8_SA(0, 0), a2, w0);
            PG8_BAR; PG8_WAIT_L(0); PG8_MMA(1, 0, At, B0); PG8_BAR; PG8_SCHED;
            PG8_STAGE(PG8_SB(0, 1), b2 + hstep, voffB);
            PG8_WAIT_V(6); PG8_BAR; PG8_MMA(1, 1, At, B1); PG8_BAR;
            PG8_LDB(B0, 1, 0); PG8_SCHED; PG8_LDA(At, 1, 0); PG8_STAGE(PG8_SA(0, 1), a2, w1);
            PG8_WAIT_L(8); PG8_BAR; PG8_WAIT_L(0); PG8_MMA(0, 0, At, B0); PG8_BAR; PG8_SCHED;
            PG8_LDB(B1, 1, 1); PG8_STAGE(PG8_SB(1, 0), b3, voffB);
            PG8_BAR; PG8_WAIT_L(0); PG8_MMA(0, 1, At, B1); PG8_BAR;
            PG8_LDA(At, 1, 1); PG8_STAGE(PG8_SA(1, 0), a3, w0);
            PG8_BAR; PG8_WAIT_L(0); PG8_MMA(1, 0, At, B0); PG8_BAR; PG8_SCHED;
            PG8_STAGE(PG8_SB(1, 1), b3 + hstep, voffB);
            PG8_WAIT_V(6); PG8_BAR; PG8_MMA(1, 1, At, B1); PG8_BAR;
            }
        }
        if constexpr (ALIGN_EPI) { if (wr == 0) PG8_BAR; }
        { E(acc, cur, wr, wc, fr, fq); }
        if (!has_next) break;
#pragma unroll
        for (int a = 0; a < 2; ++a)
#pragma unroll
            for (int b = 0; b < 2; ++b)
#pragma unroll
                for (int m = 0; m < 4; ++m)
#pragma unroll
                    for (int n = 0; n < 2; ++n) acc[a][b][m][n] = (f32x4){0.f, 0.f, 0.f, 0.f};
        cur = nxt; cB = nB; ++ui; vAc0[0] = vAn0[0]; vAc0[1] = vAn0[1]; vAc1[0] = vAn1[0]; vAc1[1] = vAn1[1];
        if constexpr (ALIGN_EPI) { if (wr == 1) PG8_BAR; }
    }
    PG8_WAIT_V(0);
    if constexpr (!ALIGN_EPI) { if (wr == 0) PG8_BAR; }
    PG8_BAR;

#undef PG8_SETA
#undef PG8_SA
#undef PG8_SB
#undef PG8_STAGE
#undef PG8_LDA
#undef PG8_LDB
#undef PG8_MMA
#undef PG8_WAIT_V
#undef PG8_WAIT_L
#undef PG8_BAR
#undef PG8_SCHED
}

struct EpiInProj {
    static constexpr bool PERM = true, AFTER_DRAIN = false;
    bf16* PL; const float* lbv;
    __device__ __forceinline__ void operator()(const f32x4 (&acc)[2][2][4][2], const Unit& u, int wr, int wc, int fr, int fq) const {
        const int p = u.pn >> 2; const bool act = (p == 0) || (p == 4), gate = (p == 2) || (p == 3);
        bf16* base = PL + (size_t)p * ((size_t)M_ALL * D);
        const int col0 = (u.pn & 3) * BM + wc * 32 + 8 * fq, row0 = u.pm * BM + wr * 64 + fr;
        f32x4 om[2][2];
#pragma unroll
        for (int bj = 0; bj < 2; ++bj)
#pragma unroll
            for (int n = 0; n < 2; ++n) om[bj][n] = gate ? (1.f - *(const f32x4*)(lbv + (p - 2) * D + col0 + bj * 128 + 4 * n)) : (f32x4){0.f, 0.f, 0.f, 0.f};
#pragma unroll
        for (int ai = 0; ai < 2; ++ai)
#pragma unroll
            for (int m = 0; m < 4; ++m) { bf16* rowp = base + (size_t)(row0 + ai * 128 + m * 16) * D + col0;
#pragma unroll
                for (int bj = 0; bj < 2; ++bj) { f32x4 v0 = acc[ai][bj][m][0], v1 = acc[ai][bj][m][1];
                    if (act) {
#pragma unroll
                        for (int j = 0; j < 4; ++j) { v0[j] = siluf_(v0[j]); v1[j] = siluf_(v1[j]); } }
                    if (gate) {
#pragma unroll
                        for (int j = 0; j < 4; ++j) { v0[j] = om[bj][0][j] / (1.f + __expf(v0[j])); v1[j] = om[bj][1][j] / (1.f + __expf(v1[j])); } }
                    v4u w; w.x = pk2(v0[0], v0[1]); w.y = pk2(v0[2], v0[3]); w.z = pk2(v1[0], v1[1]); w.w = pk2(v1[2], v1[3]);
                    *(v4u*)(rowp + bj * 128) = w; } }
    }
};
struct EpiPoolIn {
    static constexpr bool PERM = true, AFTER_DRAIN = false;
    bf16* O;
    __device__ __forceinline__ void operator()(const f32x4 (&acc)[2][2][4][2], const Unit& u, int wr, int wc, int fr, int fq) const {
        const int slab0 = (u.pn * BM + wc * 32 + 8 * fq) >> 3, row0 = u.pm * BM + wr * 64 + fr;
#pragma unroll
        for (int ai = 0; ai < 2; ++ai)
#pragma unroll
            for (int m = 0; m < 4; ++m) { const int row = row0 + ai * 128 + m * 16, b = row / SEQ, t = row % SEQ;
#pragma unroll
                for (int bj = 0; bj < 2; ++bj) { const f32x4 v0 = acc[ai][bj][m][0], v1 = acc[ai][bj][m][1];
                    v4u w; w.x = pk2(v0[0], v0[1]); w.y = pk2(v0[2], v0[3]); w.z = pk2(v1[0], v1[1]); w.w = pk2(v1[2], v1[3]);
                    *(v4u*)(O + (((size_t)b * 128 + slab0 + bj * 16) * SEQ + t) * 8) = w; } }
    }
};
struct EpiDown {
    static constexpr bool PERM = true, AFTER_DRAIN = false;
    bf16* O;
    __device__ __forceinline__ void operator()(const f32x4 (&acc)[2][2][4][2], const Unit& u, int wr, int wc, int fr, int fq) const {
        const int col0 = (u.pn & 3) * BM + wc * 32 + 8 * fq, row0 = u.pm * BM + wr * 64 + fr;
#pragma unroll
        for (int ai = 0; ai < 2; ++ai)
#pragma unroll
            for (int m = 0; m < 4; ++m) { bf16* rowp = O + (size_t)(row0 + ai * 128 + m * 16) * D + col0;
#pragma unroll
                for (int bj = 0; bj < 2; ++bj) { const f32x4 v0 = acc[ai][bj][m][0], v1 = acc[ai][bj][m][1];
                    v4u w; w.x = pk2(v0[0], v0[1]); w.y = pk2(v0[2], v0[3]); w.z = pk2(v1[0], v1[1]); w.w = pk2(v1[2], v1[3]);
                    *(v4u*)(rowp + bj * 128) = w; } }
    }
};
struct EpiGateUp {
    static constexpr bool PERM = true, AFTER_DRAIN = false;
    bf16* ACT;
    __device__ __forceinline__ void operator()(const f32x4 (&acc)[2][2][4][2], const Unit& u, int wr, int wc, int fr, int fq) const {
        const int col0 = (u.pn & 1) * 128 + wc * 32 + 8 * fq, row0 = u.pm * BM + wr * 64 + fr;
#pragma unroll
        for (int ai = 0; ai < 2; ++ai)
#pragma unroll
            for (int m = 0; m < 4; ++m) { bf16* rowp = ACT + (size_t)(row0 + ai * 128 + m * 16) * DE + col0;
                f32x4 v0, v1;
#pragma unroll
                for (int j = 0; j < 4; ++j) { v0[j] = siluf_(acc[ai][0][m][0][j]) * acc[ai][1][m][0][j]; v1[j] = siluf_(acc[ai][0][m][1][j]) * acc[ai][1][m][1][j]; }
                v4u w; w.x = pk2(v0[0], v0[1]); w.y = pk2(v0[2], v0[3]); w.z = pk2(v1[0], v1[1]); w.w = pk2(v1[2], v1[3]);
                *(v4u*)rowp = w; }
    }
};
struct EpiGrp {
    static constexpr bool PERM = true, AFTER_DRAIN = false;
    bf16* O; const float* ps;
    __device__ __forceinline__ void operator()(const f32x4 (&acc)[2][2][4][2], const Unit& u, int wr, int wc, int fr, int fq) const {
        const int col0 = u.pn * BM + wc * 32 + 8 * fq, row0 = (u.pm & 63) * BM + wr * 64 + fr;
#pragma unroll
        for (int bj = 0; bj < 2; ++bj) {
            const f32x4 s0 = *(const f32x4*)(ps + col0 + bj * 128), s1 = *(const f32x4*)(ps + col0 + bj * 128 + 4);
#pragma unroll
            for (int ai = 0; ai < 2; ++ai)
#pragma unroll
                for (int m = 0; m < 4; ++m) { bf16* rowp = O + (size_t)(row0 + ai * 128 + m * 16) * D + col0 + bj * 128;
                    const f32x4 v0 = acc[ai][bj][m][0] * s0, v1 = acc[ai][bj][m][1] * s1;
                    v4u w; w.x = pk2(v0[0], v0[1]); w.y = pk2(v0[2], v0[3]); w.z = pk2(v1[0], v1[1]); w.w = pk2(v1[2], v1[3]);
                    *(v4u*)rowp = w; }
        }
    }
};
struct EpiResid {
    static constexpr bool PERM = false, AFTER_DRAIN = false;
    const float* xin_lat; const float* xin_ctx; float* out_lat; float* out_ctx; const float* gate;
    __device__ __forceinline__ void operator()(const f32x4 (&acc)[2][2][4][2], const Unit& u, int wr, int wc, int fr, int fq) const {
        const int col0 = u.pn * BM + wc * 32 + 4 * fq, row0 = u.pm * BM + wr * 64 + fr;
        const bool isctx = row0 >= M_LAT;
        const int bidx = isctx ? 4 : (row0 / SEQ);
        const float* xin = isctx ? xin_ctx - (size_t)M_LAT * D : xin_lat; float* out = isctx ? out_ctx - (size_t)M_LAT * D : out_lat;
        const float* gp = gate + (size_t)bidx * 6144 + col0;
        f32x4 gv[2][2];
#pragma unroll
        for (int bj = 0; bj < 2; ++bj)
#pragma unroll
            for (int n = 0; n < 2; ++n) gv[bj][n] = *(const f32x4*)(gp + bj * 128 + n * 16);
#pragma unroll
        for (int ai = 0; ai < 2; ++ai)
#pragma unroll
            for (int m = 0; m < 4; ++m) { const size_t ro = (size_t)(row0 + ai * 128 + m * 16) * D + col0;
#pragma unroll
                for (int bj = 0; bj < 2; ++bj)
#pragma unroll
                    for (int n = 0; n < 2; ++n) { const f32x4 xv = *(const f32x4*)(xin + ro + bj * 128 + n * 16);
                        *(f32x4*)(out + ro + bj * 128 + n * 16) = xv + gv[bj][n] * acc[ai][bj][m][n]; } }
    }
};

struct Frame {
    LAS unsigned char* lds; volatile LAS unsigned* MISC; gu32* ctl;
    int tid, lane, wave, G, bid;
    const float* in[23]; float* out; unsigned char* ws;
};
__device__ __forceinline__ const float* modv(const Frame& F, int l, int b, int j) { return (const float*)(F.ws + WS_MODV) + ((size_t)l * 5 + b) * 6144 + j * 1024; }

__device__ __forceinline__ void transpose_item(const float* W, int N, int k0, int n0, bf16* WT, int KT, size_t dst_row0, LAS float* scr, int lane) {
#pragma unroll 8
    for (int i = 0; i < 32; ++i) { const int kk = 2 * i + (lane >> 5); scr[kk * 33 + (lane & 31)] = W[(size_t)(k0 + kk) * N + n0 + (lane & 31)]; }
    LDS_WAIT(); asm volatile("" ::: "memory");
    const int c = lane & 7;
#pragma unroll
    for (int j = 0; j < 4; ++j) { const int n = (lane >> 3) + 8 * j; const LAS float* s = scr + (8 * c) * 33 + n;
        v4u o; o.x = pk2(s[0 * 33], s[1 * 33]); o.y = pk2(s[2 * 33], s[3 * 33]); o.z = pk2(s[4 * 33], s[5 * 33]); o.w = pk2(s[6 * 33], s[7 * 33]);
        *(v4u*)(WT + (dst_row0 + n) * KT + k0 + 8 * c) = o; }
    LDS_WAIT(); asm volatile("" ::: "memory");
}
__device__ __forceinline__ void conv_moe_item(const Frame& F, int l, int r, bf16* WGU, bf16* WD, LAS float* scr) {
    const int kind = r >> 11, rr = r & 2047, e = rr >> 7, it = rr & 127;
    if (kind < 2) { const float* W = (kind ? F.in[20] : F.in[19]) + (size_t)(l * NE + e) * D * DE; const int kb = it >> 3, nb = it & 7, n0 = 32 * nb;
        transpose_item(W, DE, 64 * kb, n0, WGU, D, (size_t)e * 512 + (n0 >> 7) * 256 + kind * 128 + (n0 & 127), scr, F.lane); }
    else { const float* W = F.in[21] + (size_t)(l * NE + e) * DE * D; const int kb = it >> 5, nb = it & 31;
        transpose_item(W, D, 64 * kb, 32 * nb, WD, DE, (size_t)e * D + 32 * nb, scr, F.lane); }
}

__device__ __forceinline__ void p0_prep(Frame& F) {
    if (F.bid < 192) {
        LAS float* sil = (LAS float*)(F.lds);
        LAS float* red = (LAS float*)(F.lds + 32768);
        for (int i = F.tid; i < 5 * D; i += NTHR) { const float cv = (i < 4 * D) ? F.in[1][i] : F.in[3][i - 4 * D]; sil[i] = siluf_(cv); }
        __syncthreads();
        const int l = F.bid / 96, col0 = (F.bid % 96) * 64;
        const float* W = F.in[4] + (size_t)l * D * 6144 + col0 + F.lane;
        float a0 = 0.f, a1 = 0.f, a2 = 0.f, a3 = 0.f, a4 = 0.f;
        const int kbeg = F.wave * 128;
#pragma unroll 8
        for (int k = kbeg; k < kbeg + 128; ++k) { const float w = W[(size_t)k * 6144];
            a0 += sil[k] * w; a1 += sil[D + k] * w; a2 += sil[2 * D + k] * w; a3 += sil[3 * D + k] * w; a4 += sil[4 * D + k] * w; }
        red[(F.wave * 5 + 0) * 64 + F.lane] = a0; red[(F.wave * 5 + 1) * 64 + F.lane] = a1; red[(F.wave * 5 + 2) * 64 + F.lane] = a2;
        red[(F.wave * 5 + 3) * 64 + F.lane] = a3; red[(F.wave * 5 + 4) * 64 + F.lane] = a4;
        __syncthreads();
        if (F.tid < 320) { const int b = F.tid >> 6, cc = F.tid & 63; float s = 0.f;
#pragma unroll
            for (int w = 0; w < 8; ++w) s += red[(w * 5 + b) * 64 + cc];
            ((float*)(F.ws + WS_MODV))[((size_t)l * 5 + b) * 6144 + col0 + cc] = s + F.in[5][l * 6144 + col0 + cc]; }
        __syncthreads();
    }
    if (F.bid == 192) for (int i = F.tid; i < 2 * D; i += NTHR) { const float* lb = (i < D) ? F.in[9] : F.in[10]; const int c = i & (D - 1);
        ((float*)(F.ws + WS_LBV))[i] = sigmoidf_(lb[c] - lb[D + c]); }
    LAS float* scr = (LAS float*)(F.lds + F.wave * 16384);
    const int gw = F.bid * NWAVES + F.wave, NGW = F.G * NWAVES;
    constexpr int I_IN = 16 * 160, I_OUT = 16 * 32, I_MOE = 6144;
    for (int it = gw; it < I_IN + I_OUT + I_MOE; it += NGW) {
        int r = it;
        if (r < I_IN) { const int kb = r / 160, nb = r % 160; transpose_item(F.in[8], NPROJ * D, 64 * kb, 32 * nb, (bf16*)(F.ws + WS_WHGIN), D, (size_t)32 * nb, scr, F.lane); continue; } r -= I_IN;
        if (r < I_OUT) { const int kb = r >> 5, nb = r & 31; transpose_item(F.in[12], D, 64 * kb, 32 * nb, (bf16*)(F.ws + WS_WHGOUT), D, (size_t)32 * nb, scr, F.lane); continue; } r -= I_OUT;
        conv_moe_item(F, 0, r, (bf16*)(F.ws + WS_WGU0), (bf16*)(F.ws + WS_WD0), scr);
    }
}
__device__ __forceinline__ void conv_layer1(Frame& F) {
    LAS float* scr = (LAS float*)(F.lds + F.wave * 16384);
    const int gw = F.bid * NWAVES + F.wave, NGW = F.G * NWAVES;
    constexpr int I_SQ = 16 * 32, I_GRP = 4 * 4 * 8, I_MOE = 6144;
    for (int it = gw; it < 2 * I_SQ + I_GRP + I_MOE; it += NGW) {
        int r = it;
        if (r < I_SQ) { const int kb = r >> 5, nb = r & 31; transpose_item(F.in[13], D, 64 * kb, 32 * nb, (bf16*)(F.ws + WS_WPIN), D, (size_t)32 * nb, scr, F.lane); continue; } r -= I_SQ;
        if (r < I_SQ) { const int kb = r >> 5, nb = r & 31; transpose_item(F.in[16], D, 64 * kb, 32 * nb, (bf16*)(F.ws + WS_WPOUT), D, (size_t)32 * nb, scr, F.lane); continue; } r -= I_SQ;
        if (r < I_GRP) { const int g = r >> 5, q = r & 31, kb = q >> 3, nb = q & 7;
            transpose_item(F.in[14] + (size_t)g * 256 * 256, 256, 64 * kb, 32 * nb, (bf16*)(F.ws + WS_WGRP), 256, (size_t)g * 256 + 32 * nb, scr, F.lane); continue; } r -= I_GRP;
        conv_moe_item(F, 1, r, (bf16*)(F.ws + WS_WGU1), (bf16*)(F.ws + WS_WD1), scr);
    }
}

__device__ __forceinline__ void modulate_row(const f32x4 (&v)[4], const float* g, const float* sh, const float* sc, bf16* orow, int lane) {
    float s2 = 0.f;
#pragma unroll
    for (int j = 0; j < 4; ++j) s2 += (v[j].x * v[j].x + v[j].y * v[j].y) + (v[j].z * v[j].z + v[j].w * v[j].w);
    const float rstd = 1.f / sqrtf(wave_sum(s2) * (1.f / D) + EPS);
    unsigned long long* o8 = (unsigned long long*)orow + lane;
#pragma unroll
    for (int j = 0; j < 4; ++j) { const int c = 4 * lane + 256 * j;
        const f32x4 gv = *(const f32x4*)(g + c), shv = *(const f32x4*)(sh + c), scv = *(const f32x4*)(sc + c);
        const f32x4 h = v[j] * rstd * gv * (scv + 1.f) + shv;
        o8[64 * j] = (unsigned long long)pk2(h.x, h.y) | ((unsigned long long)pk2(h.z, h.w) << 32); }
}
__device__ __forceinline__ void p1_modulate0(Frame& F) {
    const int gw = F.bid * NWAVES + F.wave, NGW = F.G * NWAVES;
    bf16* H = (bf16*)(F.ws + WS_H);
    for (int row = gw; row < M_ALL; row += NGW) {
        const bool isctx = row >= M_LAT; const int b = isctx ? 4 : row / SEQ;
        const float* xr = isctx ? F.in[2] + (size_t)(row - M_LAT) * D : F.in[0] + (size_t)row * D;
        f32x4 v[4];
#pragma unroll
        for (int j = 0; j < 4; ++j) v[j] = ((const f32x4*)xr)[F.lane + 64 * j];
        modulate_row(v, F.in[6], modv(F, 0, b, 0), modv(F, 0, b, 1), H + (size_t)row * D, F.lane);
    }
}

__device__ __forceinline__ void p3_scan_naive(Frame& F) {
    if (F.bid >= 64) return;
    const int b = F.bid >> 4, h = (F.bid >> 1) & 7, dir = F.bid & 1;
    const bf16* PQ = (const bf16*)(F.ws + WS_PL), *PV = PQ + (size_t)M_ALL * D, *PZ = PQ + (size_t)(2 + dir) * M_ALL * D;
    bf16* OL = (bf16*)F.out + (size_t)dir * M_LAT * D; bf16* OC = (bf16*)(F.ws + (dir ? WS_OBC : WS_OFC));
    LAS float* fl = (LAS float*)F.lds, *kl = fl + 128, *ql = fl + 256, *ored = fl + 384;
    const int v = F.tid & 127, kq = F.tid >> 7;
    float lbv = 0.f;
    if (F.tid < 128) { const float* lb = dir ? F.in[10] : F.in[9]; lbv = sigmoidf_(lb[h * DH + F.tid] - lb[D + h * DH + F.tid]); }
    float S[32];
#pragma unroll
    for (int j = 0; j < 32; ++j) S[j] = 0.f;
    for (int s = 0; s < CTXL + SEQ; ++s) {
        int row;
        if (s < CTXL) row = M_LAT + b * CTXL + (dir ? CTXL - 1 - s : s);
        else row = b * SEQ + (dir ? SEQ - 1 - (s - CTXL) : s - CTXL);
        const size_t off = (size_t)row * D + h * DH;
        if (F.tid < 128) { const float kk = bf2f(PZ[off + F.tid]);
            fl[F.tid] = 1.f - kk; kl[F.tid] = kk; ql[F.tid] = bf2f(PQ[off + F.tid]); }
        const float vv = bf2f(PV[off + v]);
        __syncthreads();
        float po = 0.f;
#pragma unroll
        for (int j = 0; j < 32; ++j) { const int k = 32 * kq + j; S[j] = fl[k] * S[j] + kl[k] * vv; po += S[j] * ql[k]; }
        ored[kq * 128 + v] = po;
        __syncthreads();
        if (kq == 0) { const float o = (ored[v] + ored[128 + v]) + (ored[256 + v] + ored[384 + v]);
            if (s >= CTXL) OL[(size_t)row * D + h * DH + v] = (bf16)f2bf(o);
            else if (CTX_FULL) OC[(size_t)(row - M_LAT) * D + h * DH + v] = (bf16)f2bf(o); }
    }
}

typedef float f32x16 __attribute__((ext_vector_type(16)));
typedef float f32x2 __attribute__((ext_vector_type(2)));
#define MFMA32(a, b, c) __builtin_amdgcn_mfma_f32_32x32x16_bf16((a), (b), (c), 0, 0, 0)
__device__ __forceinline__ int crow(int reg, int h) { return (reg & 3) + 8 * (reg >> 2) + 4 * h; }
__device__ __forceinline__ int t256_off(int row, int cb) { return row * 256 + ((((cb >> 4) ^ (row & 15)) << 4) | (cb & 15)); }
__device__ __forceinline__ int t128_off(int row, int cb) { return row * 128 + ((((cb >> 4) ^ ((row >> 1) & 7)) << 4) | (cb & 15)); }
__device__ __forceinline__ bf16x8 pack8(const f32x16& x, int s) {
    v4u p; p.x = pk2(x[8 * s], x[8 * s + 1]); p.y = pk2(x[8 * s + 2], x[8 * s + 3]); p.z = pk2(x[8 * s + 4], x[8 * s + 5]); p.w = pk2(x[8 * s + 6], x[8 * s + 7]);
    return __builtin_bit_cast(bf16x8, p);
}
__device__ __forceinline__ void p3_scan(Frame& F) {
    constexpr int SC_QE = 0, SC_QC = 16384, SC_KR = 32768, SC_KRT = 49152, SC_VT = 65536, SC_ST = 69632, SC_TOT = 77824, SC_VEC = 81920, SC_SLOT = 83968;
    constexpr int NCH = (CTXL + SEQ) / 64;
    LAS unsigned char* L = F.lds;
    const int tid = F.tid, lane = F.lane, w = F.wave, r = lane & 31, hh = lane >> 5;
    const bf16* PQ = (const bf16*)(F.ws + WS_PL); const bf16* PV = PQ + (size_t)M_ALL * D;
    f32x16 zero16;
#pragma unroll
    for (int i = 0; i < 16; ++i) zero16[i] = 0.f;
    for (int item = F.bid; item < 256; item += F.G) {
        const int dvs = (item >> 3) & 3, bhd = (item >> 5) * 8 + (item & 7), b = bhd >> 4, h = (bhd >> 1) & 7, dir = bhd & 1;
        const bf16* PZ = PQ + (size_t)(2 + dir) * M_ALL * D;
        const int c0 = 2 * lane, colq = h * DH + c0, colv = h * DH + dvs * 32;
        bf16* OL = (bf16*)F.out + (size_t)dir * M_LAT * D; bf16* OC = (bf16*)(F.ws + (dir ? WS_OBC : WS_OFC));
        const int sgn = dir ? -1 : 1;
        __syncthreads();
        for (int i = tid; i < 8192 / 16; i += NTHR) ((LAS v4u*)(L + SC_ST))[i] = (v4u){0u, 0u, 0u, 0u};
        f32x16 S0 = zero16, S1 = zero16;
        unsigned zr[8], qr[8]; v4u vr = {0u, 0u, 0u, 0u};
#define SCAN_BASE(n) (((n) < 4) ? (M_LAT + b * CTXL + (dir ? CTXL - 1 - 64 * (n) : 64 * (n))) : (b * SEQ + (dir ? SEQ - 1 - 64 * ((n) - 4) : 64 * ((n) - 4))))
#define SCAN_LOAD(n) do { const int _base = SCAN_BASE(n); \
            _Pragma("unroll") for (int _i = 0; _i < 8; ++_i) { const size_t _o = (size_t)(_base + sgn * (8 * w + _i)) * D + colq; zr[_i] = *(const unsigned*)(PZ + _o); qr[_i] = *(const unsigned*)(PQ + _o); } \
            if (tid < 256) vr = *(const v4u*)(PV + (size_t)(_base + sgn * (tid >> 2)) * D + colv + 8 * (tid & 3)); } while (0)
        SCAN_LOAD(0);
        for (int n = 0; n < NCH; ++n) {
            float f0[8], f1[8];
            float pr0 = 1.f, pr1 = 1.f;
#pragma unroll
            for (int i = 0; i < 8; ++i) { f0[i] = 1.f - bflo(zr[i]); f1[i] = 1.f - bfhi(zr[i]); pr0 *= f0[i]; pr1 *= f1[i]; }
            *(LAS f32x2*)(L + SC_TOT + (w * 128 + c0) * 4) = (f32x2){__logf(pr0), __logf(pr1)};
            if (tid < 256) { const int p = tid >> 2, c8 = tid & 3;
#pragma unroll
                for (int j = 0; j < 8; ++j) { const unsigned hv = (vr[j >> 1] >> (16 * (j & 1))) & 0xffffu; *(LAS unsigned short*)(L + SC_VT + t128_off(8 * c8 + j, 2 * p)) = (unsigned short)hv; } }
            __syncthreads();
            float off0 = 0.f, off1 = 0.f, ref0 = 0.f, ref1 = 0.f, last0 = 0.f, last1 = 0.f;
#pragma unroll
            for (int ww = 0; ww < 8; ++ww) { const f32x2 t2 = *(const LAS f32x2*)(L + SC_TOT + (ww * 128 + c0) * 4); const float t0 = t2.x, t1 = t2.y;
                off0 += (ww < w) ? t0 : 0.f; off1 += (ww < w) ? t1 : 0.f; if (ww < 4) { ref0 += t0; ref1 += t1; } last0 += t0; last1 += t1; }
            float E0 = __expf(off0 - ref0), E1 = __expf(off1 - ref1);
            const float er0 = __expf(ref0), er1 = __expf(ref1);
            unsigned krp0[4], krp1[4];
#pragma unroll
            for (int i = 0; i < 8; i += 2) {
                float kra[2], krb[2];
#pragma unroll
                for (int u = 0; u < 2; ++u) { const int ii = i + u, srow = 8 * w + ii;
                    E0 *= f0[ii]; E1 *= f1[ii];
                    const float R0 = __builtin_amdgcn_rcpf(E0), R1 = __builtin_amdgcn_rcpf(E1);
                    const float q0 = bflo(qr[ii]), q1 = bfhi(qr[ii]);
                    kra[u] = (1.f - f0[ii]) * R0; krb[u] = (1.f - f1[ii]) * R1;
                    *(LAS unsigned*)(L + SC_QE + t256_off(srow, 2 * c0)) = pk2(q0 * E0, q1 * E1);
                    *(LAS unsigned*)(L + SC_QC + t256_off(srow, 2 * c0)) = pk2(q0 * E0 * er0, q1 * E1 * er1);
                    *(LAS unsigned*)(L + SC_KR + t256_off(srow, 2 * c0)) = pk2(kra[u], krb[u]); }
                krp0[i >> 1] = pk2(kra[0], kra[1]); krp1[i >> 1] = pk2(krb[0], krb[1]);
            }
            *(LAS v4u*)(L + SC_KRT + t128_off(c0, 16 * w)) = (v4u){krp0[0], krp0[1], krp0[2], krp0[3]};
            *(LAS v4u*)(L + SC_KRT + t128_off(c0 + 1, 16 * w)) = (v4u){krp1[0], krp1[1], krp1[2], krp1[3]};
            if (w == 0) { *(LAS f32x2*)(L + SC_VEC + c0 * 4) = (f32x2){__expf(last0), __expf(last1)};
                *(LAS f32x2*)(L + SC_VEC + 512 + c0 * 4) = (f32x2){__expf(last0 - ref0), __expf(last1 - ref1)}; }
            if (n + 1 < NCH) SCAN_LOAD(n + 1);
            __syncthreads();
            if (w < 3) {
                const int sb = (w == 2) ? 1 : 0, cb = (w == 0) ? 0 : 1;
                f32x16 x = zero16;
#pragma unroll
                for (int ks = 0; ks < 8; ++ks) { const int cbyte = (16 * ks + 8 * hh) * 2;
                    const bf16x8 a = *(const LAS bf16x8*)(L + SC_KR + t256_off(32 * sb + r, cbyte)), bq = *(const LAS bf16x8*)(L + SC_QE + t256_off(32 * cb + r, cbyte));
                    x = MFMA32(a, bq, x); }
                if (sb == cb) {
#pragma unroll
                    for (int g = 0; g < 16; ++g) x[g] = (crow(g, hh) > r) ? 0.f : x[g]; }
                f32x16 o = zero16;
#pragma unroll
                for (int sp = 0; sp < 2; ++sp) { const bf16x8 pa = pack8(x, sp); const int s0 = 32 * sb + 16 * sp + 4 * hh;
                    const v2u lo = *(const LAS v2u*)(L + SC_VT + t128_off(r, 2 * s0)), hi = *(const LAS v2u*)(L + SC_VT + t128_off(r, 2 * (s0 + 8)));
                    const bf16x8 vb = __builtin_bit_cast(bf16x8, ((v4u){lo.x, lo.y, hi.x, hi.y}));
                    o = MFMA32(pa, vb, o); }
#pragma unroll
                for (int g = 0; g < 16; ++g) *(LAS float*)(L + SC_SLOT + w * 4096 + (crow(g, hh) * 32 + r) * 4) = o[g];
            } else if (w < 5) {
                const int cb = w - 3; f32x16 o = zero16;
#pragma unroll
                for (int ks = 0; ks < 8; ++ks) { const int cbyte = (16 * ks + 8 * hh) * 2;
                    const bf16x8 a = *(const LAS bf16x8*)(L + SC_QC + t256_off(32 * cb + r, cbyte)), bs = *(const LAS bf16x8*)(L + SC_ST + t256_off(r, cbyte));
                    o = MFMA32(a, bs, o); }
#pragma unroll
                for (int g = 0; g < 16; ++g) *(LAS float*)(L + SC_SLOT + w * 4096 + (crow(g, hh) * 32 + r) * 4) = o[g];
            } else if (w < 7) {
#define SCAN_KV(ST_, kb_) do { f32x16 kv = zero16; \
                    _Pragma("unroll") for (int ks = 0; ks < 4; ++ks) { const int sbyte = (16 * ks + 8 * hh) * 2; \
                        const bf16x8 a = *(const LAS bf16x8*)(L + SC_KRT + t128_off(32 * (kb_) + r, sbyte)), bv = *(const LAS bf16x8*)(L + SC_VT + t128_off(r, sbyte)); \
                        kv = MFMA32(a, bv, kv); } \
                    _Pragma("unroll") for (int g = 0; g < 16; ++g) { const int k = 32 * (kb_) + crow(g, hh); \
                        ST_[g] = *(const LAS float*)(L + SC_VEC + k * 4) * ST_[g] + *(const LAS float*)(L + SC_VEC + 512 + k * 4) * kv[g]; } } while (0)
                const int kb0 = 2 * (w - 5);
                SCAN_KV(S0, kb0); SCAN_KV(S1, kb0 + 1);
            }
            __syncthreads();
            { const int c = tid >> 3, v0 = (tid & 7) * 4, cl = c & 31; const int so = (cl * 32 + v0) * 4;
              f32x4 o;
              if (c < 32) o = *(const LAS f32x4*)(L + SC_SLOT + so) + *(const LAS f32x4*)(L + SC_SLOT + 3 * 4096 + so);
              else o = *(const LAS f32x4*)(L + SC_SLOT + 4096 + so) + *(const LAS f32x4*)(L + SC_SLOT + 2 * 4096 + so) + *(const LAS f32x4*)(L + SC_SLOT + 4 * 4096 + so);
              const int row = SCAN_BASE(n) + sgn * c;
              const v2u ov = {pk2(o.x, o.y), pk2(o.z, o.w)};
              if (n >= 4) *(v2u*)(OL + (size_t)row * D + colv + v0) = ov;
              else if (CTX_FULL) *(v2u*)(OC + (size_t)(row - M_LAT) * D + colv + v0) = ov; }
            if (w == 5 || w == 6) { const int kb0 = 2 * (w - 5);
#pragma unroll
                for (int g = 0; g < 4; ++g) {
                    *(LAS v2u*)(L + SC_ST + t256_off(r, 2 * (32 * kb0 + 8 * g + 4 * hh))) = (v2u){pk2(S0[4 * g], S0[4 * g + 1]), pk2(S0[4 * g + 2], S0[4 * g + 3])};
                    *(LAS v2u*)(L + SC_ST + t256_off(r, 2 * (32 * (kb0 + 1) + 8 * g + 4 * hh))) = (v2u){pk2(S1[4 * g], S1[4 * g + 1]), pk2(S1[4 * g + 2], S1[4 * g + 3])}; } }
        }
#undef SCAN_KV
#undef SCAN_LOAD
#undef SCAN_BASE
    }
}

__device__ __forceinline__ void p4_readout_prep(Frame& F) {
    const int gw = F.bid * NWAVES + F.wave, NGW = F.G * NWAVES;
    const bf16* SG = (const bf16*)(F.ws + WS_PL) + (size_t)4 * M_ALL * D; bf16* YP = (bf16*)(F.ws + WS_H);
    const int nrows = CTX_FULL ? M_ALL : M_LAT;
    for (int row = gw; row < nrows; row += NGW) {
        const bf16 *ofp, *obp;
        if (row < M_LAT) { ofp = (const bf16*)F.out + (size_t)row * D; obp = ofp + (size_t)M_LAT * D; }
        else { ofp = (const bf16*)(F.ws + WS_OFC) + (size_t)(row - M_LAT) * D; obp = (const bf16*)(F.ws + WS_OBC) + (size_t)(row - M_LAT) * D; }
        const int c0 = 16 * F.lane;
        const v4u f0 = *(const v4u*)(ofp + c0), f1 = *(const v4u*)(ofp + c0 + 8), b0 = *(const v4u*)(obp + c0), b1 = *(const v4u*)(obp + c0 + 8);
        const v4u g0 = *(const v4u*)(SG + (size_t)row * D + c0), g1 = *(const v4u*)(SG + (size_t)row * D + c0 + 8);
        float o[16]; float ss = 0.f;
#pragma unroll
        for (int q = 0; q < 4; ++q) { o[2 * q] = bflo(f0[q]) + bflo(b0[q]); o[2 * q + 1] = bfhi(f0[q]) + bfhi(b0[q]); o[8 + 2 * q] = bflo(f1[q]) + bflo(b1[q]); o[8 + 2 * q + 1] = bfhi(f1[q]) + bfhi(b1[q]); }
#pragma unroll
        for (int j = 0; j < 16; ++j) ss += o[j] * o[j];
        ss += __shfl_xor(ss, 1); ss += __shfl_xor(ss, 2); ss += __shfl_xor(ss, 4);
        const float rstd = 1.f / sqrtf(ss * (1.f / DH) + EPS);
        const float* gn = F.in[11] + (c0 & 127);
        float y[16];
#pragma unroll
        for (int q = 0; q < 4; ++q) { y[2 * q] = o[2 * q] * rstd * gn[2 * q] * bflo(g0[q]); y[2 * q + 1] = o[2 * q + 1] * rstd * gn[2 * q + 1] * bfhi(g0[q]);
            y[8 + 2 * q] = o[8 + 2 * q] * rstd * gn[8 + 2 * q] * bflo(g1[q]); y[8 + 2 * q + 1] = o[8 + 2 * q + 1] * rstd * gn[8 + 2 * q + 1] * bfhi(g1[q]); }
        v4u w0, w1;
#pragma unroll
        for (int q = 0; q < 4; ++q) { w0[q] = pk2(y[2 * q], y[2 * q + 1]); w1[q] = pk2(y[8 + 2 * q], y[8 + 2 * q + 1]); }
        *(v4u*)(YP + (size_t)row * D + c0) = w0; *(v4u*)(YP + (size_t)row * D + c0 + 8) = w1;
    }
    conv_layer1(F);
}

__device__ __forceinline__ void top2_of4(float a0, float a1, float a2, float a3, int& i1, int& i2, float& sum) {
    i1 = 0; float v1 = a0;
    if (a1 > v1) { v1 = a1; i1 = 1; }
    if (a2 > v1) { v1 = a2; i1 = 2; }
    if (a3 > v1) { v1 = a3; i1 = 3; }
    const float c0 = (i1 == 0) ? -1e30f : a0, c1 = (i1 == 1) ? -1e30f : a1, c2 = (i1 == 2) ? -1e30f : a2, c3 = (i1 == 3) ? -1e30f : a3;
    i2 = 0; float v2 = c0;
    if (c1 > v2) { v2 = c1; i2 = 1; }
    if (c2 > v2) { v2 = c2; i2 = 2; }
    if (c3 > v2) { v2 = c3; i2 = 3; }
    sum = v1 + v2;
}
__device__ __forceinline__ int rt_swz(int row, int k) { return row * D + ((((k >> 2) ^ row) << 2) | (k & 3)); }
__device__ __forceinline__ void p_route(Frame& F, int l, int bank) {
    LAS float* RWT = (LAS float*)F.lds;
    LAS float* HL = RWT + NE * D;
    LAS float* PART = (LAS float*)(F.lds + LDSCTL_OFF + 1024);
    LAS float* SG = PART + 8 * 256;
    LAS unsigned* lcnt = (LAS unsigned*)(SG + 256);
    const int tid = F.tid, lane = F.lane, w = F.wave;
    for (int i = tid; i < D * NE; i += NTHR) { const int k = i >> 4, e = i & 15; RWT[rt_swz(e, k)] = F.in[17][i]; }
    if (tid < 32) lcnt[tid] = 0u;
    const int nrows = (l == 0 && CTX_FULL) ? M_ALL : M_LAT, ngroups = nrows / 16;
    const float* g = F.in[7] + l * D;
    f32x4 xv[2][4];
#define RT_LOAD(grp) do { _Pragma("unroll") for (int rr = 0; rr < 2; ++rr) { const int row = (grp) * 16 + 2 * w + rr; \
        const float* xr = (row >= M_LAT) ? (const float*)(F.ws + WS_XC) + (size_t)(row - M_LAT) * D : F.out + (size_t)row * D; \
        _Pragma("unroll") for (int j = 0; j < 4; ++j) xv[rr][j] = ((const f32x4*)xr)[lane + 64 * j]; } } while (0)
    if (F.bid < ngroups) RT_LOAD(F.bid);
    int it = 0;
    for (int grp = F.bid; grp < ngroups; grp += F.G, ++it) {
        __syncthreads();
#pragma unroll
        for (int rr = 0; rr < 2; ++rr) { const int rl = 2 * w + rr, row = grp * 16 + rl; const int b = (row >= M_LAT) ? 4 : row / SEQ;
            float s2 = 0.f;
#pragma unroll
            for (int j = 0; j < 4; ++j) s2 += (xv[rr][j].x * xv[rr][j].x + xv[rr][j].y * xv[rr][j].y) + (xv[rr][j].z * xv[rr][j].z + xv[rr][j].w * xv[rr][j].w);
            const float rstd = 1.f / sqrtf(wave_sum(s2) * (1.f / D) + EPS);
            const float* sh = modv(F, l, b, 3); const float* sc = modv(F, l, b, 4);
            unsigned long long* o8 = (unsigned long long*)((bf16*)(F.ws + WS_H) + (size_t)row * D) + lane;
#pragma unroll
            for (int j = 0; j < 4; ++j) { const int c = 4 * lane + 256 * j;
                const f32x4 gv = *(const f32x4*)(g + c), shv = *(const f32x4*)(sh + c), scv = *(const f32x4*)(sc + c);
                const f32x4 h = xv[rr][j] * rstd * gv * (scv + 1.f) + shv;
                o8[64 * j] = (unsigned long long)pk2(h.x, h.y) | ((unsigned long long)pk2(h.z, h.w) << 32);
                *(LAS f32x4*)(HL + rt_swz(rl, c)) = h; } }
        if (grp + F.G < ngroups) RT_LOAD(grp + F.G);
        __syncthreads();
        { f32x4 acc = {0.f, 0.f, 0.f, 0.f}; const int r16 = lane & 15, q = lane >> 4;
#pragma unroll
          for (int j = 0; j < 8; ++j) { const int k = 128 * w + 16 * j + 4 * q;
              const f32x4 a4 = *(const LAS f32x4*)(HL + rt_swz(r16, k)), b4 = *(const LAS f32x4*)(RWT + rt_swz(r16, k));
              acc = __builtin_amdgcn_mfma_f32_16x16x4f32(a4.x, b4.x, acc, 0, 0, 0); acc = __builtin_amdgcn_mfma_f32_16x16x4f32(a4.y, b4.y, acc, 0, 0, 0);
              acc = __builtin_amdgcn_mfma_f32_16x16x4f32(a4.z, b4.z, acc, 0, 0, 0); acc = __builtin_amdgcn_mfma_f32_16x16x4f32(a4.w, b4.w, acc, 0, 0, 0); }
#pragma unroll
          for (int j = 0; j < 4; ++j) PART[w * 256 + (q * 4 + j) * 16 + r16] = acc[j]; }
        __syncthreads();
        if (tid < 256) { float lg = 0.f;
#pragma unroll
            for (int ww = 0; ww < 8; ++ww) lg += PART[ww * 256 + tid];
            SG[tid] = sigmoidf_(lg); }
        __syncthreads();
        if (tid < 16) { const int row = grp * 16 + tid;
            float s[16], sel[16];
#pragma unroll
            for (int e4 = 0; e4 < 4; ++e4) { const f32x4 sv = *(const LAS f32x4*)(SG + tid * 16 + 4 * e4), bv = *(const f32x4*)(F.in[18] + 4 * e4);
                s[4 * e4] = sv.x; s[4 * e4 + 1] = sv.y; s[4 * e4 + 2] = sv.z; s[4 * e4 + 3] = sv.w;
                sel[4 * e4] = sv.x + bv.x; sel[4 * e4 + 1] = sv.y + bv.y; sel[4 * e4 + 2] = sv.z + bv.z; sel[4 * e4 + 3] = sv.w + bv.w; }
            int i1a, i2a, i1b, i2b, i1c, i2c, i1d, i2d; float gsa, gsb, gsc, gsd;
            top2_of4(sel[0], sel[1], sel[2], sel[3], i1a, i2a, gsa); top2_of4(sel[4], sel[5], sel[6], sel[7], i1b, i2b, gsb);
            top2_of4(sel[8], sel[9], sel[10], sel[11], i1c, i2c, gsc); top2_of4(sel[12], sel[13], sel[14], sel[15], i1d, i2d, gsd);
            int bpk = i1a | (i2a << 2); float bestv = gsa;
            { const bool c = gsb > bestv; bestv = c ? gsb : bestv; bpk = c ? (i1b | (i2b << 2) | 16) : bpk; }
            { const bool c = gsc > bestv; bestv = c ? gsc : bestv; bpk = c ? (i1c | (i2c << 2) | 32) : bpk; }
            { const bool c = gsd > bestv; bestv = c ? gsd : bestv; bpk = c ? (i1d | (i2d << 2) | 48) : bpk; }
            const int e1 = (bpk >> 4) * 4 + (bpk & 3), e2 = (bpk >> 4) * 4 + ((bpk >> 2) & 3);
            float s1 = 0.f, s2v = 0.f;
#pragma unroll
            for (int e = 0; e < 16; ++e) { s1 = (e == e1) ? s[e] : s1; s2v = (e == e2) ? s[e] : s2v; }
            const float inv = 1.f / (s1 + s2v);
            const unsigned p1 = __hip_atomic_fetch_add(lcnt + e1, 1u, __ATOMIC_RELAXED, __HIP_MEMORY_SCOPE_WORKGROUP);
            const unsigned p2 = __hip_atomic_fetch_add(lcnt + e2, 1u, __ATOMIC_RELAXED, __HIP_MEMORY_SCOPE_WORKGROUP);
            lcnt[32 + it * 16 + tid] = (unsigned)e1 | (p1 << 4) | ((unsigned)e2 << 16) | (p2 << 20);
            float* slotw = (float*)(F.ws + WS_SLOTW);
            slotw[row * 2] = s1 * inv; slotw[row * 2 + 1] = s2v * inv; }
    }
#undef RT_LOAD
    __syncthreads();
    if (tid < 16) lcnt[16 + tid] = atomicAdd((unsigned*)(F.ctl + CW_CNT + 1024 * bank + 64 * tid), lcnt[tid]);
    __syncthreads();
    if (tid < 16 * it) { const int row = (F.bid + F.G * (tid >> 4)) * 16 + (tid & 15); const unsigned en = lcnt[32 + tid];
        const unsigned e1 = en & 15u, p1 = ((en >> 4) & 0xfffu) + lcnt[16 + e1], e2 = (en >> 16) & 15u, p2 = (en >> 20) + lcnt[16 + e2];
        unsigned* list = (unsigned*)(F.ws + WS_LIST); unsigned* slote = (unsigned*)(F.ws + WS_SLOTE);
        list[(size_t)e1 * LIST_CAP + p1] = (unsigned)row * 2u; list[(size_t)e2 * LIST_CAP + p2] = (unsigned)row * 2u + 1u;
        slote[row * 2] = e1 | (p1 << 8); slote[row * 2 + 1] = e2 | (p2 << 8); }
    __syncthreads();
}
__device__ __forceinline__ void moe_prefix(Frame& F, int l) {
    if (F.tid == 0) { unsigned acc = 0;
        for (int e = 0; e < 16; ++e) { const unsigned c = __hip_atomic_load((unsigned*)(F.ctl + CW_CNT + 1024 * l + 64 * e), RLX_AGENT); F.MISC[32 + e] = acc; F.MISC[32 + 17 + e] = c; acc += (c + 255u) >> 8; }
        F.MISC[32 + 16] = acc; }
    __syncthreads();
}
__device__ __forceinline__ void combine_row(Frame& F, int l, int row, int b, const volatile LAS unsigned* tb, f32x4 (&v)[4]) {
    const unsigned se0 = ((const unsigned*)(F.ws + WS_SLOTE))[row * 2], se1 = ((const unsigned*)(F.ws + WS_SLOTE))[row * 2 + 1];
    const float w0 = ((const float*)(F.ws + WS_SLOTW))[row * 2], w1 = ((const float*)(F.ws + WS_SLOTW))[row * 2 + 1];
    const size_t p0 = (size_t)tb[se0 & 255u] * 256 + (se0 >> 8), p1 = (size_t)tb[se1 & 255u] * 256 + (se1 >> 8);
    const bf16* Y2 = (const bf16*)(F.ws + WS_Y2);
    const v2u* y0 = (const v2u*)(Y2 + p0 * D) + F.lane; const v2u* y1 = (const v2u*)(Y2 + p1 * D) + F.lane;
    const float* g2 = modv(F, l, b, 5);
#pragma unroll
    for (int j = 0; j < 4; ++j) { const v2u a = y0[64 * j], c = y1[64 * j]; const f32x4 gv = *(const f32x4*)(g2 + 4 * F.lane + 256 * j);
        f32x4 ff; ff.x = w0 * bflo(a.x) + w1 * bflo(c.x); ff.y = w0 * bfhi(a.x) + w1 * bfhi(c.x); ff.z = w0 * bflo(a.y) + w1 * bflo(c.y); ff.w = w0 * bfhi(a.y) + w1 * bfhi(c.y);
        v[j] = v[j] + gv * ff; }
}
__device__ __forceinline__ void p9_combine_mod(Frame& F) {
    moe_prefix(F, 0);
    const volatile LAS unsigned* tb = F.MISC + 32;
    const int gw = F.bid * NWAVES + F.wave, NGW = F.G * NWAVES;
    const int nrows = CTX_FULL ? M_ALL : M_LAT;
    for (int row = gw; row < nrows; row += NGW) {
        const bool isctx = row >= M_LAT; const int b = isctx ? 4 : row / SEQ;
        float* xr = isctx ? (float*)(F.ws + WS_XC) + (size_t)(row - M_LAT) * D : F.out + (size_t)row * D;
        f32x4 v[4];
#pragma unroll
        for (int j = 0; j < 4; ++j) v[j] = ((const f32x4*)xr)[F.lane + 64 * j];
        combine_row(F, 0, row, b, tb, v);
#pragma unroll
        for (int j = 0; j < 4; ++j) ((f32x4*)xr)[F.lane + 64 * j] = v[j];
        if (!isctx) modulate_row(v, F.in[6] + D, modv(F, 1, b, 0), modv(F, 1, b, 1), (bf16*)(F.ws + WS_H) + (size_t)row * D, F.lane);
    }
}
__device__ __forceinline__ void p11_pool_naive(Frame& F) {
    const bf16* U = (const bf16*)(F.ws + WS_U); bf16* DP = (bf16*)(F.ws + WS_DP);
    const long total = (long)M_LAT * 128;
    for (long idx = (long)F.bid * NTHR + F.tid; idx < total; idx += (long)F.G * NTHR) {
        const int tok = (int)(idx >> 7), ch8 = (int)(idx & 127), b = tok / SEQ, t = tok % SEQ, r = t / GRIDW, c = t % GRIDW;
        const int g = ch8 >> 5, win = 2 << g, half = win >> 1;
        const int rlo = max(r - half, 0), rhi = min(r - half + win, GRIDW), clo = max(c - half, 0), chi = min(c - half + win, GRIDW);
        float acc[8];
#pragma unroll
        for (int j = 0; j < 8; ++j) acc[j] = 0.f;
        for (int rr = rlo; rr < rhi; ++rr)
            for (int cc = clo; cc < chi; ++cc) { const v4u w = *(const v4u*)(U + (size_t)(b * SEQ + rr * GRIDW + cc) * D + ch8 * 8);
#pragma unroll
                for (int q = 0; q < 4; ++q) { acc[2 * q] += bflo(w[q]); acc[2 * q + 1] += bfhi(w[q]); } }
        const float inv = 1.f / (float)((rhi - rlo) * (chi - clo));
        const v4u w = *(const v4u*)(U + (size_t)tok * D + ch8 * 8);
        v4u o;
#pragma unroll
        for (int q = 0; q < 4; ++q) o[q] = pk2(acc[2 * q] * inv - bflo(w[q]), acc[2 * q + 1] * inv - bfhi(w[q]));
        *(v4u*)(DP + ((size_t)g * M_LAT + tok) * 256 + (ch8 & 31) * 8) = o;
    }
}
__device__ __forceinline__ void p11_pool(Frame& F) {
    LAS float* I = (LAS float*)F.lds;
    const bf16* U = (const bf16*)(F.ws + WS_U); bf16* DP = (bf16*)(F.ws + WS_DP);
    const int t = F.tid;
    for (int item = F.bid; item < 512; item += F.G) {
        const int b = item >> 7, slab = item & 127, g = slab >> 5, win = 2 << g, half = win >> 1;
        const bf16* Ub = U + ((size_t)b * 128 + slab) * SEQ * 8;
        __syncthreads();
#pragma unroll
        for (int j = 0; j < 8; ++j) { const int tok = t + 512 * j, r = tok >> 6, c = tok & 63; const v4u w = *(const v4u*)(Ub + (size_t)tok * 8);
            LAS f32x4* dst = (LAS f32x4*)(I + r * 512 + ((c ^ (r & 3)) * 8));
            dst[0] = (f32x4){bflo(w.x), bfhi(w.x), bflo(w.y), bfhi(w.y)}; dst[1] = (f32x4){bflo(w.z), bfhi(w.z), bflo(w.w), bfhi(w.w)}; }
        __syncthreads();
        { const int r = t >> 3, ch = t & 7; float run = 0.f;
#pragma unroll 16
          for (int c = 0; c < 64; ++c) { LAS float* p = I + r * 512 + ((c ^ (r & 3)) * 8) + ch; run += *p; *p = run; } }
        __syncthreads();
        { const int c = t >> 3, ch = t & 7; float run = 0.f;
#pragma unroll 16
          for (int r = 0; r < 64; ++r) { LAS float* p = I + r * 512 + ((c ^ (r & 3)) * 8) + ch; run += *p; *p = run; } }
        __syncthreads();
#pragma unroll 2
        for (int j = 0; j < 8; ++j) { const int tok = t + 512 * j, r = tok >> 6, c = tok & 63;
            const int rlo = max(r - half, 0), rhi = min(r - half + win, GRIDW), clo = max(c - half, 0), chi = min(c - half + win, GRIDW);
            const int r1 = rhi - 1, c1 = chi - 1, r0 = rlo - 1, c0 = clo - 1;
            const LAS f32x4* p11 = (const LAS f32x4*)(I + r1 * 512 + ((c1 ^ (r1 & 3)) * 8));
            f32x4 s0 = p11[0], s1 = p11[1];
            if (r0 >= 0) { const LAS f32x4* q = (const LAS f32x4*)(I + r0 * 512 + ((c1 ^ (r0 & 3)) * 8)); s0 -= q[0]; s1 -= q[1]; }
            if (c0 >= 0) { const LAS f32x4* q = (const LAS f32x4*)(I + r1 * 512 + ((c0 ^ (r1 & 3)) * 8)); s0 -= q[0]; s1 -= q[1]; }
            if (r0 >= 0 && c0 >= 0) { const LAS f32x4* q = (const LAS f32x4*)(I + r0 * 512 + ((c0 ^ (r0 & 3)) * 8)); s0 += q[0]; s1 += q[1]; }
            const float inv = 1.f / (float)((rhi - rlo) * (chi - clo));
            const v4u w = *(const v4u*)(Ub + (size_t)tok * 8);
            v4u o; o.x = pk2(s0.x * inv - bflo(w.x), s0.y * inv - bfhi(w.x)); o.y = pk2(s0.z * inv - bflo(w.y), s0.w * inv - bfhi(w.y));
            o.z = pk2(s1.x * inv - bflo(w.z), s1.y * inv - bfhi(w.z)); o.w = pk2(s1.z * inv - bflo(w.w), s1.w * inv - bfhi(w.w));
            *(v4u*)(DP + ((size_t)slab * M_LAT + (size_t)b * SEQ + tok) * 8) = o; }
    }
}
__device__ __forceinline__ void p17_final(Frame& F) {
    moe_prefix(F, 1);
    const volatile LAS unsigned* tb = F.MISC + 32;
    const int gw = F.bid * NWAVES + F.wave, NGW = F.G * NWAVES;
    for (int row = gw; row < M_LAT; row += NGW) {
        float* xr = F.out + (size_t)row * D;
        f32x4 v[4];
#pragma unroll
        for (int j = 0; j < 4; ++j) v[j] = ((const f32x4*)xr)[F.lane + 64 * j];
        combine_row(F, 1, row, row / SEQ, tb, v);
        float s2 = 0.f;
#pragma unroll
        for (int j = 0; j < 4; ++j) s2 += (v[j].x * v[j].x + v[j].y * v[j].y) + (v[j].z * v[j].z + v[j].w * v[j].w);
        const float rstd = 1.f / sqrtf(wave_sum(s2) * (1.f / D) + EPS);
#pragma unroll
        for (int j = 0; j < 4; ++j) { const f32x4 gv = *(const f32x4*)(F.in[22] + 4 * F.lane + 256 * j); ((f32x4*)xr)[F.lane + 64 * j] = v[j] * rstd * gv; }
    }
}

struct Args { const float* in[23]; float* out; unsigned char* ws; int ph_lo, ph_hi; };
#ifndef NAIVE_GEMM
#define RUN_GEMM(EpiT, SchedT, g, S, E) gemm_phase<EpiT, SchedT, true, true>(F.lds, g, S, E)
#else
#define RUN_GEMM(EpiT, SchedT, g, S, E) gemm_naive<EpiT, SchedT>(g, S, E)
#endif

__global__ void __launch_bounds__(NTHR, 2) fwd_kernel(Args args) {
    extern __shared__ __attribute__((aligned(16))) unsigned char lds[];
    Frame F;
    F.lds = (LAS unsigned char*)lds; F.MISC = (volatile LAS unsigned*)(F.lds + MISC_OFF);
    F.tid = threadIdx.x; F.lane = F.tid & 63; F.wave = __builtin_amdgcn_readfirstlane(F.tid >> 6);
    F.G = gridDim.x; F.bid = blockIdx.x;
#pragma unroll
    for (int i = 0; i < 23; ++i) F.in[i] = args.in[i];
    F.out = args.out; F.ws = args.ws; F.ctl = (gu32*)(args.ws + WS_CTL);
    for (int u = F.tid; u < (LDS_BYTES - LDSCTL_OFF) / 4; u += NTHR) ((LAS unsigned*)(F.lds + LDSCTL_OFF))[u] = 0u;
    __syncthreads();
    XcdBarrier bar; bar.bar = (unsigned*)(F.ctl + CW_BAR); bar.x = 0; bar.st = nullptr;
    if (MK_ONE_LAUNCH) bar = xcd_barrier_post((unsigned*)(F.ctl + CW_BAR), F.MISC + 8);
    const int lo = args.ph_lo, hi = args.ph_hi;
#ifndef PHMASK
#define PHMASK 0x3ffff
#endif
#define IN(k) (((PHMASK >> (k)) & 1) && lo <= (k) && (k) < hi)
#ifndef REPMASK
#define REPMASK 0
#endif
#define REPLOOP(k) for (int _r = 0; _r <= ((REPMASK >> (k)) & 1); (++_r <= ((REPMASK >> (k)) & 1)) ? xcd_barrier(bar) : (void)0)
#define SEAM(k) do { if (IN(k) && IN((k) + 1)) xcd_barrier(bar); } while (0)
    bf16* const PL = (bf16*)(F.ws + WS_PL);

    if (IN(0)) REPLOOP(0) { p0_prep(F); } SEAM(0);
    if (IN(1)) REPLOOP(1) { p1_modulate0(F); } SEAM(1);
    if (IN(2)) REPLOOP(2) {
        Gemm g{(const bf16*)(F.ws + WS_H), (const bf16*)(F.ws + WS_WHGIN), D, 128}; StaticOrder S; S.init(M_ALL, NPROJ * D, F.G, F.bid);
        EpiInProj E{PL, (const float*)(F.ws + WS_LBV)}; RUN_GEMM(EpiInProj, StaticOrder, g, S, E); } SEAM(2);
    #ifdef SCAN_NAIVE
    if (IN(3)) REPLOOP(3) { p3_scan_naive(F); } SEAM(3);
#else
    if (IN(3)) REPLOOP(3) { p3_scan(F); } SEAM(3);
#endif
    if (IN(4)) REPLOOP(4) { p4_readout_prep(F); } SEAM(4);
    if (IN(5)) REPLOOP(5) {
        Gemm g{(const bf16*)(F.ws + WS_H), (const bf16*)(F.ws + WS_WHGOUT), D, 128}; StaticOrder S; S.init(CTX_FULL ? M_ALL : M_LAT, D, F.G, F.bid);
        EpiResid E{F.in[0], F.in[2], F.out, (float*)(F.ws + WS_XC), modv(F, 0, 0, 2)}; RUN_GEMM(EpiResid, StaticOrder, g, S, E); } SEAM(5);
    if (IN(6)) REPLOOP(6) { p_route(F, 0, (_r < ((REPMASK >> 6) & 1)) ? 2 : 0); } SEAM(6);
    if (IN(7)) REPLOOP(7) { moe_prefix(F, 0);
        Gemm g{(const bf16*)(F.ws + WS_H), (const bf16*)(F.ws + WS_WGU0), D, 128}; MoeOrder S{F.G, F.bid, 2, 1, F.MISC + 32, (const unsigned*)(F.ws + WS_LIST)};
        EpiGateUp E{(bf16*)(F.ws + WS_ACT)}; RUN_GEMM(EpiGateUp, MoeOrder, g, S, E); } SEAM(7);
    if (IN(8)) REPLOOP(8) { moe_prefix(F, 0);
        Gemm g{(const bf16*)(F.ws + WS_ACT), (const bf16*)(F.ws + WS_WD0), DE, 128}; MoeOrder S{F.G, F.bid, 4, 0, F.MISC + 32, (const unsigned*)(F.ws + WS_LIST)};
        EpiDown E{(bf16*)(F.ws + WS_Y2)}; RUN_GEMM(EpiDown, MoeOrder, g, S, E); } SEAM(8);
    if (IN(9)) REPLOOP(9) { p9_combine_mod(F); } SEAM(9);
    if (IN(10)) REPLOOP(10) {
        Gemm g{(const bf16*)(F.ws + WS_H), (const bf16*)(F.ws + WS_WPIN), D, 128}; StaticOrder S; S.init(M_LAT, D, F.G, F.bid);
        EpiPoolIn E{(bf16*)(F.ws + WS_U)}; RUN_GEMM(EpiPoolIn, StaticOrder, g, S, E); } SEAM(10);
    #ifdef POOL_NAIVE
    if (IN(11)) REPLOOP(11) { p11_pool_naive(F); } SEAM(11);
#else
    if (IN(11)) REPLOOP(11) { p11_pool(F); } SEAM(11);
#endif
    if (IN(12)) REPLOOP(12) {
        Gemm g{(const bf16*)(F.ws + WS_DP), (const bf16*)(F.ws + WS_WGRP), 256, (size_t)8 * M_LAT * 16}; GroupOrder S{F.G, F.bid};
        EpiGrp E{(bf16*)(F.ws + WS_E), F.in[15]}; RUN_GEMM(EpiGrp, GroupOrder, g, S, E); } SEAM(12);
    if (IN(13)) REPLOOP(13) {
        Gemm g{(const bf16*)(F.ws + WS_E), (const bf16*)(F.ws + WS_WPOUT), D, 128}; StaticOrder S; S.init(M_LAT, D, F.G, F.bid);
        EpiResid E{F.out, nullptr, F.out, nullptr, modv(F, 1, 0, 2)}; RUN_GEMM(EpiResid, StaticOrder, g, S, E); } SEAM(13);
    if (IN(14)) REPLOOP(14) { p_route(F, 1, (_r < ((REPMASK >> 14) & 1)) ? 3 : 1); } SEAM(14);
    if (IN(15)) REPLOOP(15) { moe_prefix(F, 1);
        Gemm g{(const bf16*)(F.ws + WS_H), (const bf16*)(F.ws + WS_WGU1), D, 128}; MoeOrder S{F.G, F.bid, 2, 1, F.MISC + 32, (const unsigned*)(F.ws + WS_LIST)};
        EpiGateUp E{(bf16*)(F.ws + WS_ACT)}; RUN_GEMM(EpiGateUp, MoeOrder, g, S, E); } SEAM(15);
    if (IN(16)) REPLOOP(16) { moe_prefix(F, 1);
        Gemm g{(const bf16*)(F.ws + WS_ACT), (const bf16*)(F.ws + WS_WD1), DE, 128}; MoeOrder S{F.G, F.bid, 4, 0, F.MISC + 32, (const unsigned*)(F.ws + WS_LIST)};
        EpiDown E{(bf16*)(F.ws + WS_Y2)}; RUN_GEMM(EpiDown, MoeOrder, g, S, E); } SEAM(16);
    if (IN(17)) REPLOOP(17) { p17_final(F); }
#undef IN
#undef SEAM
}

extern "C" void kernel_launch(void* const* d_in, const int* in_sizes, int n_in, void* d_out, int out_size, void* d_ws, size_t ws_size, hipStream_t stream) {
    static int grid = 0;
    if (grid == 0) {
        if (n_in != 23 || in_sizes[0] != M_LAT * D || out_size != M_LAT * D || ws_size < WS_END) { fprintf(stderr, "kernel_launch: unexpected shapes (n_in %d, in0 %d, out %d, ws %zu); nothing launched\n", n_in, n_in > 0 ? in_sizes[0] : -1, out_size, ws_size); grid = -1; return; }
        int dev = 0, cus = 0, per_cu = 0;
        if (hipGetDevice(&dev) != hipSuccess || hipDeviceGetAttribute(&cus, hipDeviceAttributeMultiprocessorCount, dev) != hipSuccess) { grid = -1; return; }
        if (hipFuncSetAttribute((const void*)fwd_kernel, hipFuncAttributeMaxDynamicSharedMemorySize, LDS_BYTES) != hipSuccess) { fprintf(stderr, "kernel_launch: hipFuncSetAttribute failed\n"); grid = -1; return; }
        if (hipOccupancyMaxActiveBlocksPerMultiprocessor(&per_cu, (const void*)fwd_kernel, NTHR, LDS_BYTES) != hipSuccess || per_cu < 1) { fprintf(stderr, "kernel_launch: occupancy query says %d blocks per CU\n", per_cu); per_cu = 1; }
        (void)hipGetLastError();
        grid = cus;
    }
    if (grid < 0) return;
    if (hipMemsetAsync((char*)d_ws + WS_CTL, 0, CTL_ZERO_BYTES, stream) != hipSuccess) return;
    Args a{};
    for (int i = 0; i < 23; ++i) a.in[i] = (const float*)d_in[i];
    a.out = (float*)d_out; a.ws = (unsigned char*)d_ws;
    if (MK_ONE_LAUNCH) { a.ph_lo = 0; a.ph_hi = NPHASE; hipLaunchKernelGGL(fwd_kernel, dim3(grid), dim3(NTHR), LDS_BYTES, stream, a); }
    else for (int p = 0; p < NPHASE; ++p) { a.ph_lo = p; a.ph_hi = p + 1; hipLaunchKernelGGL(fwd_kernel, dim3(grid), dim3(NTHR), LDS_BYTES, stream, a); }
}
```

```cpp
#include <hip/hip_runtime.h>
#include <cstdio>
#include <cstdint>

#ifndef MK_ONE_LAUNCH
#define MK_ONE_LAUNCH 1
#endif
#ifndef CTX_FULL
#define CTX_FULL 0
#endif

constexpr int D = 1024, NB = 4, SEQ = 4096, CTXL = 256;
constexpr int M_LAT = NB * SEQ, M_CTX = NB * CTXL, M_ALL = M_LAT + M_CTX;
constexpr int NH = 8, DH = 128, NPROJ = 5;
constexpr int NE = 16, DE = 256, NGRP = 4, EPG = 4;
constexpr int GRIDW = 64;
constexpr float EPS = 1e-6f;
constexpr int NWAVES = 8, NTHR = 512;
constexpr int NPHASE = 18;

constexpr size_t MiB = 1u << 20;
constexpr size_t WS_CTL = 0, CTL_ZERO_BYTES = 1 * MiB;
constexpr size_t WS_MODV = 1 * MiB;
constexpr size_t WS_LBV = 1 * MiB + 256 * 1024;
constexpr size_t WS_LIST = 2 * MiB;
constexpr size_t WS_SLOTE = 2 * MiB + 1280 * 1024;
constexpr size_t WS_SLOTW = 2 * MiB + 1536 * 1024;
constexpr size_t WS_WHGIN = 4 * MiB;
constexpr size_t WS_WHGOUT = 14 * MiB;
constexpr size_t WS_WGU0 = 16 * MiB;
constexpr size_t WS_WD0 = 32 * MiB;
constexpr size_t WS_XC = 40 * MiB;
constexpr size_t WS_H = 44 * MiB;
constexpr size_t WS_PL = 78 * MiB;
constexpr size_t PLANE = (size_t)M_ALL * D * 2;
constexpr size_t WS_OFC = 248 * MiB, WS_OBC = 250 * MiB;
constexpr size_t WS_WPIN = 78 * MiB, WS_WGRP = 80 * MiB, WS_WPOUT = 81 * MiB;
constexpr size_t WS_WGU1 = 83 * MiB, WS_WD1 = 99 * MiB;
constexpr size_t WS_ACT = 108 * MiB;
constexpr size_t WS_Y2 = 128 * MiB;
constexpr size_t WS_XL = 204 * MiB;
constexpr size_t WS_DP = 108 * MiB;
constexpr size_t WS_E = 140 * MiB;
constexpr size_t WS_END = 256 * MiB;
static_assert(WS_PL + 5 * PLANE <= WS_OFC && WS_H + PLANE <= WS_PL && WS_Y2 + (size_t)38912 * 2048 <= WS_XL && WS_XL + (size_t)M_LAT * 2048 <= WS_OFC, "ws map");
static_assert(WS_ACT + (size_t)38912 * 512 <= WS_Y2 && WS_DP + (size_t)M_LAT * 2048 <= WS_E && WS_E + (size_t)M_LAT * 2048 <= WS_XL && WS_WD1 + 8 * MiB <= WS_ACT, "ws map 2");
constexpr int CW_BAR = 4096;
constexpr int CW_Q = 16384;
constexpr int CW_CNT = 8192;
constexpr int LIST_CAP = M_ALL;

constexpr int RING_BYTES = 147456;
constexpr int LDSCTL_OFF = RING_BYTES, MISC_OFF = LDSCTL_OFF + 320;
constexpr int LDS_BYTES = 163840;

#define GAS __attribute__((address_space(1)))
#define LAS __attribute__((address_space(3)))
typedef unsigned short bf16;
typedef unsigned v4u __attribute__((ext_vector_type(4)));
typedef unsigned v2u __attribute__((ext_vector_type(2)));
typedef float f32x4 __attribute__((ext_vector_type(4)));
typedef short bf16x8 __attribute__((ext_vector_type(8)));
typedef GAS unsigned gu32;
#define RLX_AGENT __ATOMIC_RELAXED, __HIP_MEMORY_SCOPE_AGENT
#define LDS_WAIT() asm volatile("s_waitcnt lgkmcnt(0)" ::: "memory")
#define VM_WAIT() asm volatile("s_waitcnt vmcnt(0)" ::: "memory")

__device__ __forceinline__ unsigned f2bf(float f) { unsigned u = __builtin_bit_cast(unsigned, f); return (u + 0x7fffu + ((u >> 16) & 1u)) >> 16; }
typedef float f32x2_t __attribute__((ext_vector_type(2)));
typedef __bf16 bf16x2_t __attribute__((ext_vector_type(2)));
__device__ __forceinline__ unsigned pk2(float lo, float hi) { const f32x2_t v = {lo, hi}; const bf16x2_t b = __builtin_convertvector(v, bf16x2_t); return __builtin_bit_cast(unsigned, b); }
__device__ __forceinline__ float bf2f(unsigned b) { return __builtin_bit_cast(float, b << 16); }
__device__ __forceinline__ float bflo(unsigned w) { return __builtin_bit_cast(float, w << 16); }
__device__ __forceinline__ float bfhi(unsigned w) { return __builtin_bit_cast(float, w & 0xffff0000u); }
__device__ __forceinline__ float sigmoidf_(float x) { return 1.f / (1.f + __expf(-x)); }
__device__ __forceinline__ float siluf_(float x) { return x / (1.f + __expf(-x)); }
__device__ __forceinline__ float wave_sum(float v) {
#pragma unroll
    for (int o = 1; o < 64; o <<= 1) v += __shfl_xor(v, o);
    return v;
}

#define XB_TMO      128
#define XB_XCNT(j)  (256  + 64 * (j))
#define XB_XSUB(j)  (1280 + 64 * (j))
#define XB_XGEN(j)  (2304 + 64 * (j))
#define XB_TOP      3328
#define XB_TOPGEN   3392
#define XCD_BAR_WORDS 3456
#define XB_SPIN_CAP (1u << 18)
__device__ __forceinline__ unsigned xb_ld(unsigned* p)              { return __hip_atomic_load(p, __ATOMIC_RELAXED, __HIP_MEMORY_SCOPE_AGENT); }
__device__ __forceinline__ unsigned xb_add(unsigned* p, unsigned v) { return __hip_atomic_fetch_add(p, v, __ATOMIC_RELAXED, __HIP_MEMORY_SCOPE_AGENT); }
__device__ __forceinline__ unsigned xb_xcc_id() { return (unsigned)__builtin_amdgcn_s_getreg((3 << 11) | 20) & 0xFu; }
#define XB_SPIN(cond, bar) do { unsigned _sp = 0; while (cond) { __builtin_amdgcn_s_sleep(1); \
    if ((++_sp & 255u) == 0u) { if (xb_ld(&(bar)[XB_TMO])) break; if (_sp > XB_SPIN_CAP) { atomicAdd(&(bar)[XB_TMO], 1u); break; } } } } while (0)
struct XcdBarrier { unsigned* bar; unsigned x; volatile LAS unsigned* st; };
__device__ __forceinline__ XcdBarrier xcd_barrier_post(unsigned* bar, volatile LAS unsigned* st) {
    XcdBarrier b; b.bar = bar; b.x = xb_xcc_id(); b.st = st;
    if (threadIdx.x == 0) (void)xb_add(&bar[XB_XCNT(b.x)], 1u);
    return b;
}
__device__ __forceinline__ void xcd_barrier_complete(unsigned* bar, unsigned x, unsigned& nloc, unsigned& nx) {
    const unsigned G = gridDim.x * gridDim.y * gridDim.z;
    unsigned sum, cnt, mine, sp = 0u;
    for (;;) {
        sum = 0u; cnt = 0u; mine = 0u;
#pragma unroll
        for (unsigned j = 0; j < 16; ++j) { const unsigned c = xb_ld(&bar[XB_XCNT(j)]); sum += c; cnt += (c > 0u) ? 1u : 0u; mine = (j == x) ? c : mine; }
        if (sum == G) break;
        __builtin_amdgcn_s_sleep(1);
        if ((++sp & 255u) == 0u) { if (xb_ld(&bar[XB_TMO])) break; if (sp > XB_SPIN_CAP) { atomicAdd(&bar[XB_TMO], 1u); break; } }
    }
    nloc = mine > 0u ? mine : 1u; nx = cnt > 0u ? cnt : 1u;
}
__device__ __forceinline__ void xcd_barrier(const XcdBarrier& b) {
    asm volatile("s_waitcnt vmcnt(0)" ::: "memory");
    __syncthreads();
    if (threadIdx.x == 0) {
        unsigned* bar = b.bar;
        __builtin_amdgcn_s_waitcnt(0);
        unsigned nloc = b.st[0], nx = b.st[1];
        if (nloc == 0u) { xcd_barrier_complete(bar, b.x, nloc, nx); b.st[0] = nloc; b.st[1] = nx; }
        const unsigned old = xb_add(&bar[XB_XSUB(b.x)], 1u);
        const unsigned gen = old / nloc;
        if (old + 1u == (gen + 1u) * nloc) {
            __builtin_amdgcn_fence(__ATOMIC_RELEASE, "agent");
            asm volatile("s_waitcnt vmcnt(0)" ::: "memory");
            const unsigned og = xb_add(&bar[XB_TOP], 1u);
            const unsigned tg = og / nx;
            if (og + 1u == (tg + 1u) * nx) xb_add(&bar[XB_TOPGEN], 1u);
            else XB_SPIN(xb_ld(&bar[XB_TOPGEN]) == tg, bar);
            __builtin_amdgcn_fence(__ATOMIC_ACQUIRE, "agent");
            xb_add(&bar[XB_XGEN(b.x)], 1u);
            asm volatile("s_waitcnt vmcnt(0)" ::: "memory");
        } else {
            XB_SPIN(xb_ld(&bar[XB_XGEN(b.x)]) == gen, bar);
            __builtin_amdgcn_fence(__ATOMIC_ACQUIRE, "agent");
            asm volatile("s_waitcnt vmcnt(0)" ::: "memory");
        }
    }
    __syncthreads();
}

struct Unit { int pm, pn; };
struct Gemm { const bf16* A; const bf16* Bt; int K; size_t kstepA; };
constexpr int NXCD = 8, WGM = 8, BM = 256;

struct StaticOrder {
    int nM, nN, nwg, G, c;
    __device__ __forceinline__ void init(int M, int N, int G_, int c_) { nM = M / BM; nN = N / BM; nwg = nM * nN; G = G_; c = c_; }
    __device__ __forceinline__ bool next(int i, Unit& u) const {
        const long L = (long)i * G + c; if (L >= nwg) return false;
        int wgid = (int)L; { const int q = nwg / NXCD, r = nwg % NXCD, xcd = wgid % NXCD, off = wgid / NXCD; wgid = (xcd < r ? xcd * (q + 1) : r * (q + 1) + (xcd - r) * q) + off; }
        const int nig = WGM * nN, gid = wgid / nig, fm = gid * WGM, gsz = (nM - fm) < WGM ? (nM - fm) : WGM;
        u.pm = fm + ((wgid % nig) % gsz); u.pn = (wgid % nig) / gsz; return true;
    }
    __device__ __forceinline__ int a_row(const Unit& u, int r) const { return u.pm * BM + r; }
    __device__ __forceinline__ unsigned a_off(const Unit& u, int r, int c, int K) const { return (unsigned)((u.pm * BM + r) * K + c) * 2u; }
};
struct GroupOrder {
    int G, c;
    __device__ __forceinline__ bool next(int i, Unit& u) const { const int L = i * G + c; if (L >= 256) return false; u.pm = L; u.pn = L >> 6; return true; }
    __device__ __forceinline__ int a_row(const Unit& u, int r) const { return u.pm * BM + r; }
    __device__ __forceinline__ unsigned a_off(const Unit& u, int r, int c, int K) const { return (unsigned)(((u.pn * 32 + (c >> 3)) * M_LAT + (u.pm & 63) * BM + r) * 8 + (c & 7)) * 2u; }
};
struct MoeOrder {
    int G, c, npn, gather; const volatile LAS unsigned* tb; const unsigned* list;
    __device__ __forceinline__ bool next(int i, Unit& u) const {
        const int L = i * G + c; const int nt = (int)tb[16];
        if (L >= nt * npn) return false;
        const int t = L / npn, nl = L % npn; int e = 0;
#pragma unroll
        for (int j = 1; j < 16; ++j) e += (t >= (int)tb[j]) ? 1 : 0;
        u.pm = t; u.pn = e * npn + nl; return true;
    }
    __device__ __forceinline__ int a_row(const Unit& u, int r) const {
        if (!gather) return u.pm * BM + r;
        const int e = u.pn / npn; const int idx = (u.pm - (int)tb[e]) * BM + r;
        const unsigned ent = (idx < (int)tb[17 + e]) ? list[(size_t)e * LIST_CAP + idx] : 0u;
        return (int)(ent >> 1);
    }
    __device__ __forceinline__ unsigned a_off(const Unit& u, int r, int c, int K) const { return (unsigned)(a_row(u, r) * K + c) * 2u; }
};

template <class Epi, class Sched>
__device__ __forceinline__ void gemm_naive(const Gemm g, const Sched& S, const Epi& E) {
    const int tid = threadIdx.x, wid = tid >> 6, lane = tid & 63, wr = wid >> 2, wc = wid & 3, fr = lane & 15, fq = lane >> 4;
    const int K = g.K;
    Unit u;
    for (int i = 0; S.next(i, u); ++i) {
        f32x4 acc[2][2][4][2];
#pragma unroll
        for (int ai = 0; ai < 2; ++ai)
#pragma unroll
            for (int m = 0; m < 4; ++m) {
                const bf16* ar = g.A + (size_t)S.a_row(u, 128 * ai + 64 * wr + 16 * m + fr) * K;
#pragma unroll
                for (int bj = 0; bj < 2; ++bj)
#pragma unroll
                    for (int n = 0; n < 2; ++n) {
                        const int c0 = 128 * bj + 32 * wc + (Epi::PERM ? 8 * fq + 4 * n : 16 * n + 4 * fq);
                        const bf16* br = g.Bt + (size_t)(u.pn * BM + c0) * K;
                        f32x4 a0 = {0.f, 0.f, 0.f, 0.f};
#pragma unroll 1
                        for (int k = 0; k < K; k += 8) {
                            const v4u b0 = *(const v4u*)(br + k), b1 = *(const v4u*)(br + (size_t)K + k), b2 = *(const v4u*)(br + (size_t)2 * K + k), b3 = *(const v4u*)(br + (size_t)3 * K + k);
                            const v4u x0 = *(const v4u*)(ar + k);
#pragma unroll
                            for (int q = 0; q < 4; ++q) {
                                const f32x4 blo = {bflo(b0[q]), bflo(b1[q]), bflo(b2[q]), bflo(b3[q])}, bhi = {bfhi(b0[q]), bfhi(b1[q]), bfhi(b2[q]), bfhi(b3[q])};
                                a0 += blo * bflo(x0[q]) + bhi * bfhi(x0[q]);
                            }
                        }
                        asm volatile("" : "+v"(a0));
                        acc[ai][bj][m][n] = a0;
                    }
            }
        E(acc, u, wr, wc, fr, fq);
    }
}

constexpr int BK = 64, HALF = 128, HTB = HALF * BK * 2;
__device__ __forceinline__ int lds_byte(int r, int c) { const int st = (r >> 4) * 2 + (c >> 5), rr = r & 15, cc = c & 31, ob = rr * 64 + cc * 2; return st * 1024 + (ob ^ (((ob >> 9) & 1) << 5)); }
__device__ __forceinline__ void stage_rc(int b, int& R, int& C) { const int st = b / 1024, sb = b % 1024, swz = sb ^ (((sb >> 9) & 1) << 5); R = (st >> 1) * 16 + swz / 64; C = (st & 1) * 32 + (swz % 64) / 2; }
__device__ __forceinline__ int perm32(int rho) { const int n = rho >> 4, i = rho & 15; return 8 * (i >> 2) + 4 * n + (i & 3); }
template <class Epi, class Sched, bool ALIGN_EPI = false, bool SP2 = false>
__device__ __forceinline__ void gemm_phase(LAS unsigned char* lds, const Gemm g, const Sched& S, const Epi& E) {
    const int tid = threadIdx.x, wid = __builtin_amdgcn_readfirstlane(tid >> 6), lane = tid & 63, wr = wid >> 2, wc = wid & 3, fr = lane & 15, fq = lane >> 4;
    const int K = g.K, nt = K / BK;
    unsigned vAc0[2], vAc1[2], vAn0[2], vAn1[2], voffB[2]; int stR[2], stC[2];
#pragma unroll
    for (int i = 0; i < 2; ++i) { int R, C; stage_rc(tid * 16 + i * 8192, R, C); const int Rb = Epi::PERM ? ((R & ~31) + perm32(R & 31)) : R;
        stR[i] = R; stC[i] = C; voffB[i] = (unsigned)(Rb * K + C) * 2u; }
#define PG8_SETA(v0, v1, U) do { _Pragma("unroll") for (int _i = 0; _i < 2; ++_i) { v0[_i] = S.a_off(U, stR[_i], stC[_i], K); v1[_i] = S.a_off(U, HALF + stR[_i], stC[_i], K); } } while (0)
    const size_t kstep = (size_t)(BK * 2);
    const size_t kstepA = g.kstepA;
    const size_t hstep = (size_t)HALF * K * 2;
    const size_t tstep = 2 * hstep;
    const unsigned ldsw = (unsigned)wid * 1024u;
    const int aoff = lds_byte(wr * 64 + fr, fq * 8), boff = lds_byte(wc * 32 + fr, fq * 8);
#define PG8_SA(b, h) (((b) * 2 + (h)) * HTB)
#define PG8_SB(b, h) ((4 + (b) * 2 + (h)) * HTB)
#define PG8_STAGE(bufoff, gbase, voff) do { _Pragma("unroll") for (int _i = 0; _i < 2; ++_i) \
        __builtin_amdgcn_global_load_lds((const unsigned*)((const char*)(gbase) + (voff)[_i]), (LAS unsigned*)(lds + (bufoff) + ldsw + _i * 8192), 16, 0, 0); } while (0)
#define PG8_LDA(dst, b, h) do { _Pragma("unroll") for (int m = 0; m < 4; ++m) _Pragma("unroll") for (int k = 0; k < 2; ++k) dst[m][k] = *(const LAS bf16x8*)(lds + PG8_SA(b, h) + aoff + m * 2048 + k * 1024); } while (0)
#define PG8_LDB(dst, b, h) do { _Pragma("unroll") for (int n = 0; n < 2; ++n) _Pragma("unroll") for (int k = 0; k < 2; ++k) dst[n][k] = *(const LAS bf16x8*)(lds + PG8_SB(b, h) + boff + n * 2048 + k * 1024); } while (0)
#define PG8_MMA(ai, bj, At, Bt) do { __builtin_amdgcn_s_setprio(1); _Pragma("unroll") for (int m = 0; m < 4; ++m) _Pragma("unroll") for (int n = 0; n < 2; ++n) _Pragma("unroll") for (int k = 0; k < 2; ++k) \
        acc[ai][bj][m][n] = __builtin_amdgcn_mfma_f32_16x16x32_bf16(Bt[n][k], At[m][k], acc[ai][bj][m][n], 0, 0, 0); __builtin_amdgcn_s_setprio(0); } while (0)
#define PG8_WAIT_V(n) asm volatile("s_waitcnt vmcnt(" #n ")" ::: "memory")
#define PG8_WAIT_L(n) asm volatile("s_waitcnt lgkmcnt(" #n ")" ::: "memory")
#define PG8_BAR __builtin_amdgcn_s_barrier()
#define PG8_SCHED __builtin_amdgcn_sched_barrier(0)
    Unit cur, nxt; int ui = 0;
    if (!S.next(0, cur)) return;
    f32x4 acc[2][2][4][2];
#pragma unroll
    for (int a = 0; a < 2; ++a)
#pragma unroll
        for (int b = 0; b < 2; ++b)
#pragma unroll
            for (int m = 0; m < 4; ++m)
#pragma unroll
                for (int n = 0; n < 2; ++n) acc[a][b][m][n] = (f32x4){0.f, 0.f, 0.f, 0.f};
    bf16x8 At[4][2], B0[2][2], B1[2][2];
    const char* const cA = (const char*)g.A; PG8_SETA(vAc0, vAc1, cur); const char* cB = (const char*)g.Bt + (size_t)cur.pn * tstep;
    if constexpr (SP2) {
        PG8_STAGE(PG8_SB(0, 0), cB, voffB); PG8_STAGE(PG8_SB(0, 1), cB + hstep, voffB); PG8_STAGE(PG8_SA(0, 0), cA, vAc0); PG8_STAGE(PG8_SA(0, 1), cA, vAc1);
        if (wr == 1) PG8_BAR;
        PG8_WAIT_V(2); PG8_BAR;
        PG8_STAGE(PG8_SB(1, 0), cB + kstep, voffB); PG8_STAGE(PG8_SA(1, 0), cA + kstepA, vAc0); PG8_STAGE(PG8_SB(1, 1), cB + hstep + kstep, voffB);
        PG8_WAIT_V(6); PG8_BAR;
    } else {
        PG8_STAGE(PG8_SB(0, 0), cB, voffB); PG8_STAGE(PG8_SA(0, 0), cA, vAc0); PG8_STAGE(PG8_SB(0, 1), cB + hstep, voffB); PG8_STAGE(PG8_SA(0, 1), cA, vAc1);
        if (wr == 1) PG8_BAR;
        PG8_WAIT_V(4); PG8_BAR;
        PG8_STAGE(PG8_SB(1, 0), cB + kstep, voffB); PG8_STAGE(PG8_SA(1, 0), cA + kstepA, vAc0); PG8_STAGE(PG8_SB(1, 1), cB + hstep + kstep, voffB);
        PG8_WAIT_V(6); PG8_BAR;
    }
    for (;;) {
        const bool has_next = S.next(ui + 1, nxt);
        if (has_next) { PG8_SETA(vAn0, vAn1, nxt); } else { vAn0[0] = vAc0[0]; vAn0[1] = vAc0[1]; vAn1[0] = vAc1[0]; vAn1[1] = vAc1[1]; }
        const char* nB = has_next ? (const char*)g.Bt + (size_t)nxt.pn * tstep : cB;
#pragma unroll 1
        for (int t = 0; t < nt; t += 2) {
            const bool last = (t == nt - 2);
            const char* a1 = cA + (size_t)(t + 1) * kstepA;
            const char* a2 = last ? cA : cA + (size_t)(t + 2) * kstepA; unsigned w0[2], w1[2]; w0[0] = last ? vAn0[0] : vAc0[0]; w0[1] = last ? vAn0[1] : vAc0[1]; w1[0] = last ? vAn1[0] : vAc1[0]; w1[1] = last ? vAn1[1] : vAc1[1]; const char* b2 = last ? nB : cB + (size_t)(t + 2) * kstep;
            const char* a3 = a2 + kstepA; const char* b3 = b2 + kstep;
            if constexpr (SP2) {
            PG8_LDB(B0, 0, 0); PG8_LDB(B1, 0, 1); PG8_SCHED; PG8_LDA(At, 0, 0); PG8_STAGE(PG8_SA(1, 1), a1, vAc1);
            PG8_WAIT_V(8); PG8_WAIT_L(0); PG8_BAR; PG8_MMA(0, 0, At, B0); PG8_MMA(0, 1, At, B1); PG8_BAR; PG8_SCHED;
            PG8_LDA(At, 0, 1); PG8_STAGE(PG8_SB(0, 0), b2, voffB); PG8_STAGE(PG8_SB(0, 1), b2 + hstep, voffB); PG8_STAGE(PG8_SA(0, 0), a2, w0);
            PG8_WAIT_V(8); PG8_WAIT_L(0); PG8_BAR; PG8_MMA(1, 0, At, B0); PG8_MMA(1, 1, At, B1); PG8_BAR; PG8_SCHED;
            PG8_LDB(B0, 1, 0); PG8_LDB(B1, 1, 1); PG8_SCHED; PG8_LDA(At, 1, 0); PG8_STAGE(PG8_SA(0, 1), a2, w1);
            PG8_WAIT_V(8); PG8_WAIT_L(0); PG8_BAR; PG8_MMA(0, 0, At, B0); PG8_MMA(0, 1, At, B1); PG8_BAR; PG8_SCHED;
            PG8_LDA(At, 1, 1); PG8_STAGE(PG8_SB(1, 0), b3, voffB); PG8_STAGE(PG8_SB(1, 1), b3 + hstep, voffB); PG8_STAGE(PG8_SA(1, 0), a3, w0);
            PG8_WAIT_V(8); PG8_WAIT_L(0); PG8_BAR; PG8_MMA(1, 0, At, B0); PG8_MMA(1, 1, At, B1); PG8_BAR; PG8_SCHED;
            } else {
            PG8_LDB(B0, 0, 0); PG8_SCHED; PG8_LDA(At, 0, 0); PG8_STAGE(PG8_SA(1, 1), a1, vAc1);
            PG8_WAIT_L(8); PG8_BAR; PG8_WAIT_L(0); PG8_MMA(0, 0, At, B0); PG8_BAR; PG8_SCHED;
            PG8_LDB(B1, 0, 1); PG8_STAGE(PG8_SB(0, 0), b2, voffB);
            PG8_BAR; PG8_WAIT_L(0); PG8_MMA(0, 1, At, B1); PG8_BAR;
            PG8_LDA(At, 0, 1); PG8_STAGE(PG8_SA(0, 0), a2, w0);
            PG8_BAR; PG8_WAIT_L(0); PG8_MMA(1, 0, At, B0); PG8_BAR; PG8_SCHED;
            PG8_STAGE(PG8_SB(0, 1), b2 + hstep, voffB);
            PG8_WAIT_V(6); PG8_BAR; PG8_MMA(1, 1, At, B1); PG8_BAR;
            PG8_LDB(B0, 1, 0); PG8_SCHED; PG8_LDA(At, 1, 0); PG8_STAGE(PG8_SA(0, 1), a2, w1);
            PG8_WAIT_L(8); PG8_BAR; PG8_WAIT_L(0); PG8_MMA(0, 0, At, B0); PG8_BAR; PG8_SCHED;
            PG8_LDB(B1, 1, 1); PG8_STAGE(PG8_SB(1, 0), b3, voffB);
            PG8_BAR; PG8_WAIT_L(0); PG8_MMA(0, 1, At, B1); PG8_BAR;
            PG8_LDA(At, 1, 1); PG8_STAGE(PG8_SA(1, 0), a3, w0);
            PG8_BAR; PG8_WAIT_L(0); PG8_MMA(1, 0, At, B0); PG8_BAR; PG8_SCHED;
            PG8_STAGE(PG8_SB(1, 1), b3 + hstep, voffB);
            PG8_WAIT_V(6); PG8_BAR; PG8_MMA(1, 1, At, B1); PG8_BAR;
            }
        }
        if constexpr (ALIGN_EPI) { if (wr == 0) PG8_BAR; }
        { E(acc, cur, wr, wc, fr, fq); }
        if (!has_next) break;
#pragma unroll
        for (int a = 0; a < 2; ++a)
#pragma unroll
            for (int b = 0; b < 2; ++b)
#pragma unroll
                for (int m = 0; m < 4; ++m)
#pragma unroll
                    for (int n = 0; n < 2; ++n) acc[a][b][m][n] = (f32x4){0.f, 0.f, 0.f, 0.f};
        cur = nxt; cB = nB; ++ui; vAc0[0] = vAn0[0]; vAc0[1] = vAn0[1]; vAc1[0] = vAn1[0]; vAc1[1] = vAn1[1];
        if constexpr (ALIGN_EPI) { if (wr == 1) PG8_BAR; }
    }
    PG8_WAIT_V(0);
    if constexpr (!ALIGN_EPI) { if (wr == 0) PG8_BAR; }
    PG8_BAR;

#undef PG8_SETA
#undef PG8_SA
#undef PG8_SB
#undef PG8_STAGE
#undef PG8_LDA
#undef PG8_LDB
#undef PG8_MMA
#undef PG8_WAIT_V
#undef PG8_WAIT_L
#undef PG8_BAR
#undef PG8_SCHED
}

struct EpiInProj {
    static constexpr bool PERM = true, AFTER_DRAIN = false;
    bf16* PL; const float* lbv;
    __device__ __forceinline__ void operator()(const f32x4 (&acc)[2][2][4][2], const Unit& u, int wr, int wc, int fr, int fq) const {
        const int p = u.pn >> 2; const bool act = (p == 0) || (p == 4), gate = (p == 2) || (p == 3);
        bf16* base = PL + (size_t)p * ((size_t)M_ALL * D);
        const int col0 = (u.pn & 3) * BM + wc * 32 + 8 * fq, row0 = u.pm * BM + wr * 64 + fr;
        f32x4 om[2][2];
#pragma unroll
        for (int bj = 0; bj < 2; ++bj)
#pragma unroll
            for (int n = 0; n < 2; ++n) om[bj][n] = gate ? (1.f - *(const f32x4*)(lbv + (p - 2) * D + col0 + bj * 128 + 4 * n)) : (f32x4){0.f, 0.f, 0.f, 0.f};
#pragma unroll
        for (int ai = 0; ai < 2; ++ai)
#pragma unroll
            for (int m = 0; m < 4; ++m) { bf16* rowp = base + (size_t)(row0 + ai * 128 + m * 16) * D + col0;
#pragma unroll
                for (int bj = 0; bj < 2; ++bj) { f32x4 v0 = acc[ai][bj][m][0], v1 = acc[ai][bj][m][1];
                    if (act) {
#pragma unroll
                        for (int j = 0; j < 4; ++j) { v0[j] = siluf_(v0[j]); v1[j] = siluf_(v1[j]); } }
                    if (gate) {
#pragma unroll
                        for (int j = 0; j < 4; ++j) { v0[j] = om[bj][0][j] / (1.f + __expf(v0[j])); v1[j] = om[bj][1][j] / (1.f + __expf(v1[j])); } }
                    v4u w; w.x = pk2(v0[0], v0[1]); w.y = pk2(v0[2], v0[3]); w.z = pk2(v1[0], v1[1]); w.w = pk2(v1[2], v1[3]);
                    *(v4u*)(rowp + bj * 128) = w; } }
    }
};
struct EpiPoolIn {
    static constexpr bool PERM = true, AFTER_DRAIN = false;
    bf16* O;
    __device__ __forceinline__ void operator()(const f32x4 (&acc)[2][2][4][2], const Unit& u, int wr, int wc, int fr, int fq) const {
        const int slab0 = (u.pn * BM + wc * 32 + 8 * fq) >> 3, row0 = u.pm * BM + wr * 64 + fr;
#pragma unroll
        for (int ai = 0; ai < 2; ++ai)
#pragma unroll
            for (int m = 0; m < 4; ++m) { const int row = row0 + ai * 128 + m * 16, b = row / SEQ, t = row % SEQ;
#pragma unroll
                for (int bj = 0; bj < 2; ++bj) { const f32x4 v0 = acc[ai][bj][m][0], v1 = acc[ai][bj][m][1];
                    v4u w; w.x = pk2(v0[0], v0[1]); w.y = pk2(v0[2], v0[3]); w.z = pk2(v1[0], v1[1]); w.w = pk2(v1[2], v1[3]);
                    *(v4u*)(O + (((size_t)b * 128 + slab0 + bj * 16) * SEQ + t) * 8) = w; } }
    }
};
struct EpiDown {
    static constexpr bool PERM = true, AFTER_DRAIN = false;
    bf16* O;
    __device__ __forceinline__ void operator()(const f32x4 (&acc)[2][2][4][2], const Unit& u, int wr, int wc, int fr, int fq) const {
        const int col0 = (u.pn & 3) * BM + wc * 32 + 8 * fq, row0 = u.pm * BM + wr * 64 + fr;
#pragma unroll
        for (int ai = 0; ai < 2; ++ai)
#pragma unroll
            for (int m = 0; m < 4; ++m) { bf16* rowp = O + (size_t)(row0 + ai * 128 + m * 16) * D + col0;
#pragma unroll
                for (int bj = 0; bj < 2; ++bj) { const f32x4 v0 = acc[ai][bj][m][0], v1 = acc[ai][bj][m][1];
                    v4u w; w.x = pk2(v0[0], v0[1]); w.y = pk2(v0[2], v0[3]); w.z = pk2(v1[0], v1[1]); w.w = pk2(v1[2], v1[3]);
                    *(v4u*)(rowp + bj * 128) = w; } }
    }
};
struct EpiGateUp {
    static constexpr bool PERM = true, AFTER_DRAIN = false;
    bf16* ACT;
    __device__ __forceinline__ void operator()(const f32x4 (&acc)[2][2][4][2], const Unit& u, int wr, int wc, int fr, int fq) const {
        const int col0 = (u.pn & 1) * 128 + wc * 32 + 8 * fq, row0 = u.pm * BM + wr * 64 + fr;
#pragma unroll
        for (int ai = 0; ai < 2; ++ai)
#pragma unroll
            for (int m = 0; m < 4; ++m) { bf16* rowp = ACT + (size_t)(row0 + ai * 128 + m * 16) * DE + col0;
                f32x4 v0, v1;
#pragma unroll
                for (int j = 0; j < 4; ++j) { v0[j] = siluf_(acc[ai][0][m][0][j]) * acc[ai][1][m][0][j]; v1[j] = siluf_(acc[ai][0][m][1][j]) * acc[ai][1][m][1][j]; }
                v4u w; w.x = pk2(v0[0], v0[1]); w.y = pk2(v0[2], v0[3]); w.z = pk2(v1[0], v1[1]); w.w = pk2(v1[2], v1[3]);
                *(v4u*)rowp = w; }
    }
};
struct EpiGrp {
    static constexpr bool PERM = true, AFTER_DRAIN = false;
    bf16* O; const float* ps;
    __device__ __forceinline__ void operator()(const f32x4 (&acc)[2][2][4][2], const Unit& u, int wr, int wc, int fr, int fq) const {
        const int col0 = u.pn * BM + wc * 32 + 8 * fq, row0 = (u.pm & 63) * BM + wr * 64 + fr;
#pragma unroll
        for (int bj = 0; bj < 2; ++bj) {
            const f32x4 s0 = *(const f32x4*)(ps + col0 + bj * 128), s1 = *(const f32x4*)(ps + col0 + bj * 128 + 4);
#pragma unroll
            for (int ai = 0; ai < 2; ++ai)
#pragma unroll
                for (int m = 0; m < 4; ++m) { bf16* rowp = O + (size_t)(row0 + ai * 128 + m * 16) * D + col0 + bj * 128;
                    const f32x4 v0 = acc[ai][bj][m][0] * s0, v1 = acc[ai][bj][m][1] * s1;
                    v4u w; w.x = pk2(v0[0], v0[1]); w.y = pk2(v0[2], v0[3]); w.z = pk2(v1[0], v1[1]); w.w = pk2(v1[2], v1[3]);
                    *(v4u*)rowp = w; }
        }
    }
};
template <bool XF32> struct EpiResid {
    static constexpr bool PERM = true, AFTER_DRAIN = false;
    const void* xin; bf16* out; const float* gate;
    __device__ __forceinline__ void operator()(const f32x4 (&acc)[2][2][4][2], const Unit& u, int wr, int wc, int fr, int fq) const {
        const int col0 = u.pn * BM + wc * 32 + 8 * fq, row0 = u.pm * BM + wr * 64 + fr;
        const float* gp = gate + (size_t)(row0 / SEQ) * 6144 + col0;
        f32x4 gv[2][2];
#pragma unroll
        for (int bj = 0; bj < 2; ++bj) { gv[bj][0] = *(const f32x4*)(gp + bj * 128); gv[bj][1] = *(const f32x4*)(gp + bj * 128 + 4); }
#pragma unroll
        for (int ai = 0; ai < 2; ++ai)
#pragma unroll
            for (int m = 0; m < 4; ++m) { const size_t ro = (size_t)(row0 + ai * 128 + m * 16) * D + col0;
#pragma unroll
                for (int bj = 0; bj < 2; ++bj) { f32x4 x0, x1;
                    if (XF32) { x0 = *(const f32x4*)((const float*)xin + ro + bj * 128); x1 = *(const f32x4*)((const float*)xin + ro + bj * 128 + 4); }
                    else { const v4u w = *(const v4u*)((const bf16*)xin + ro + bj * 128); x0 = (f32x4){bflo(w.x), bfhi(w.x), bflo(w.y), bfhi(w.y)}; x1 = (f32x4){bflo(w.z), bfhi(w.z), bflo(w.w), bfhi(w.w)}; }
                    const f32x4 y0 = x0 + gv[bj][0] * acc[ai][bj][m][0], y1 = x1 + gv[bj][1] * acc[ai][bj][m][1];
                    v4u o; o.x = pk2(y0[0], y0[1]); o.y = pk2(y0[2], y0[3]); o.z = pk2(y1[0], y1[1]); o.w = pk2(y1[2], y1[3]);
                    *(v4u*)(out + ro + bj * 128) = o; } }
    }
};
static_assert(!CTX_FULL, "the bf16 residual path covers latent rows only");

struct Frame {
    LAS unsigned char* lds; volatile LAS unsigned* MISC; gu32* ctl;
    int tid, lane, wave, G, bid;
    const float* in[23]; float* out; unsigned char* ws;
};
__device__ __forceinline__ const float* modv(const Frame& F, int l, int b, int j) { return (const float*)(F.ws + WS_MODV) + ((size_t)l * 5 + b) * 6144 + j * 1024; }

__device__ __forceinline__ void transpose_item(const float* W, int N, int k0, int n0, bf16* WT, int KT, size_t dst_row0, LAS float* scr, int lane) {
    { const int kr = lane >> 3, ch = lane & 7; f32x4 v[8];
#pragma unroll
      for (int i = 0; i < 8; ++i) v[i] = *(const f32x4*)(W + (size_t)(k0 + 8 * i + kr) * N + n0 + 4 * ch);
#pragma unroll
      for (int i = 0; i < 8; ++i) { LAS float* d = scr + (8 * i + kr) * 33 + 4 * ch; d[0] = v[i].x; d[1] = v[i].y; d[2] = v[i].z; d[3] = v[i].w; } }
    LDS_WAIT(); asm volatile("" ::: "memory");
    const int c = lane & 7;
#pragma unroll
    for (int j = 0; j < 4; ++j) { const int n = (lane >> 3) + 8 * j; const LAS float* s = scr + (8 * c) * 33 + n;
        v4u o; o.x = pk2(s[0 * 33], s[1 * 33]); o.y = pk2(s[2 * 33], s[3 * 33]); o.z = pk2(s[4 * 33], s[5 * 33]); o.w = pk2(s[6 * 33], s[7 * 33]);
        *(v4u*)(WT + (dst_row0 + n) * KT + k0 + 8 * c) = o; }
    LDS_WAIT(); asm volatile("" ::: "memory");
}
__device__ __forceinline__ void conv_moe_item(const Frame& F, int l, int r, bf16* WGU, bf16* WD, LAS float* scr) {
    const int kind = r >> 11, rr = r & 2047, e = rr >> 7, it = rr & 127;
    if (kind < 2) { const float* W = (kind ? F.in[20] : F.in[19]) + (size_t)(l * NE + e) * D * DE; const int kb = it >> 3, nb = it & 7, n0 = 32 * nb;
        transpose_item(W, DE, 64 * kb, n0, WGU, D, (size_t)e * 512 + (n0 >> 7) * 256 + kind * 128 + (n0 & 127), scr, F.lane); }
    else { const float* W = F.in[21] + (size_t)(l * NE + e) * DE * D; const int kb = it >> 5, nb = it & 31;
        transpose_item(W, D, 64 * kb, 32 * nb, WD, DE, (size_t)e * D + 32 * nb, scr, F.lane); }
}

__device__ __forceinline__ void conv_moe_queue(Frame& F, int l, bf16* WGU, bf16* WD) {
    LAS float* scr = (LAS float*)(F.lds + F.wave * 16384);
    unsigned* q = (unsigned*)(F.ctl + CW_Q + 64 * l);
    for (;;) {
        unsigned base = 0;
        if (F.lane == 0) base = atomicAdd(q, 8u);
        base = (unsigned)__builtin_amdgcn_readfirstlane((int)base);
        if (base >= 6144u) break;
        for (int r = (int)base; r < (int)base + 8; ++r) conv_moe_item(F, l, r, WGU, WD, scr);
    }
}
__device__ __forceinline__ void p0_prep(Frame& F) {
    if (F.bid < 192) {
        LAS float* sil = (LAS float*)(F.lds);
        LAS float* red = (LAS float*)(F.lds + 32768);
        for (int i = F.tid; i < 5 * D; i += NTHR) { const float cv = (i < 4 * D) ? F.in[1][i] : F.in[3][i - 4 * D]; sil[i] = siluf_(cv); }
        __syncthreads();
        const int l = F.bid / 96, col0 = (F.bid % 96) * 64;
        const float* W = F.in[4] + (size_t)l * D * 6144 + col0 + F.lane;
        float a0 = 0.f, a1 = 0.f, a2 = 0.f, a3 = 0.f, a4 = 0.f;
        const int kbeg = F.wave * 128;
#pragma unroll 8
        for (int k = kbeg; k < kbeg + 128; ++k) { const float w = W[(size_t)k * 6144];
            a0 += sil[k] * w; a1 += sil[D + k] * w; a2 += sil[2 * D + k] * w; a3 += sil[3 * D + k] * w; a4 += sil[4 * D + k] * w; }
        red[(F.wave * 5 + 0) * 64 + F.lane] = a0; red[(F.wave * 5 + 1) * 64 + F.lane] = a1; red[(F.wave * 5 + 2) * 64 + F.lane] = a2;
        red[(F.wave * 5 + 3) * 64 + F.lane] = a3; red[(F.wave * 5 + 4) * 64 + F.lane] = a4;
        __syncthreads();
        if (F.tid < 320) { const int b = F.tid >> 6, cc = F.tid & 63; float s = 0.f;
#pragma unroll
            for (int w = 0; w < 8; ++w) s += red[(w * 5 + b) * 64 + cc];
            ((float*)(F.ws + WS_MODV))[((size_t)l * 5 + b) * 6144 + col0 + cc] = s + F.in[5][l * 6144 + col0 + cc]; }
        __syncthreads();
    }
    if (F.bid == 192) for (int i = F.tid; i < 2 * D; i += NTHR) { const float* lb = (i < D) ? F.in[9] : F.in[10]; const int c = i & (D - 1);
        ((float*)(F.ws + WS_LBV))[i] = sigmoidf_(lb[c] - lb[D + c]); }
    LAS float* scr = (LAS float*)(F.lds + F.wave * 16384);
    const int gw = F.bid * NWAVES + F.wave, NGW = F.G * NWAVES;
    constexpr int I_IN = 16 * 160, I_OUT = 16 * 32;
    for (int it = gw; it < I_IN + I_OUT; it += NGW) {
        int r = it;
        if (r < I_IN) { const int kb = r / 160, nb = r % 160; transpose_item(F.in[8], NPROJ * D, 64 * kb, 32 * nb, (bf16*)(F.ws + WS_WHGIN), D, (size_t)32 * nb, scr, F.lane); continue; } r -= I_IN;
        { const int kb = r >> 5, nb = r & 31; transpose_item(F.in[12], D, 64 * kb, 32 * nb, (bf16*)(F.ws + WS_WHGOUT), D, (size_t)32 * nb, scr, F.lane); }
    }
}
__device__ __forceinline__ void conv_layer1(Frame& F) {
    LAS float* scr = (LAS float*)(F.lds + F.wave * 16384);
    const int gw = F.bid * NWAVES + F.wave, NGW = F.G * NWAVES;
    constexpr int I_SQ = 16 * 32, I_GRP = 4 * 4 * 8;
    for (int it = gw; it < 2 * I_SQ + I_GRP; it += NGW) {
        int r = it;
        if (r < I_SQ) { const int kb = r >> 5, nb = r & 31; transpose_item(F.in[13], D, 64 * kb, 32 * nb, (bf16*)(F.ws + WS_WPIN), D, (size_t)32 * nb, scr, F.lane); continue; } r -= I_SQ;
        if (r < I_SQ) { const int kb = r >> 5, nb = r & 31; transpose_item(F.in[16], D, 64 * kb, 32 * nb, (bf16*)(F.ws + WS_WPOUT), D, (size_t)32 * nb, scr, F.lane); continue; } r -= I_SQ;
        if (r < I_GRP) { const int g = r >> 5, q = r & 31, kb = q >> 3, nb = q & 7;
            transpose_item(F.in[14] + (size_t)g * 256 * 256, 256, 64 * kb, 32 * nb, (bf16*)(F.ws + WS_WGRP), 256, (size_t)g * 256 + 32 * nb, scr, F.lane); }
    }
    for (int it = gw; it < 6144; it += NGW) conv_moe_item(F, 1, it, (bf16*)(F.ws + WS_WGU1), (bf16*)(F.ws + WS_WD1), scr);
}

__device__ __forceinline__ void load_row_bf16(const bf16* xr, int lane, f32x4 (&v)[4]) {
#pragma unroll
    for (int j = 0; j < 4; ++j) { const v2u a = ((const v2u*)xr)[lane + 64 * j]; v[j] = (f32x4){bflo(a.x), bfhi(a.x), bflo(a.y), bfhi(a.y)}; }
}
__device__ __forceinline__ void store_row_bf16(bf16* xr, int lane, const f32x4 (&v)[4]) {
#pragma unroll
    for (int j = 0; j < 4; ++j) ((v2u*)xr)[lane + 64 * j] = (v2u){pk2(v[j].x, v[j].y), pk2(v[j].z, v[j].w)};
}
__device__ __forceinline__ void modulate_row(const f32x4 (&v)[4], const float* g, const float* sh, const float* sc, bf16* orow, int lane) {
    float s2 = 0.f;
#pragma unroll
    for (int j = 0; j < 4; ++j) s2 += (v[j].x * v[j].x + v[j].y * v[j].y) + (v[j].z * v[j].z + v[j].w * v[j].w);
    const float rstd = 1.f / sqrtf(wave_sum(s2) * (1.f / D) + EPS);
    unsigned long long* o8 = (unsigned long long*)orow + lane;
#pragma unroll
    for (int j = 0; j < 4; ++j) { const int c = 4 * lane + 256 * j;
        const f32x4 gv = *(const f32x4*)(g + c), shv = *(const f32x4*)(sh + c), scv = *(const f32x4*)(sc + c);
        const f32x4 h = v[j] * rstd * gv * (scv + 1.f) + shv;
        o8[64 * j] = (unsigned long long)pk2(h.x, h.y) | ((unsigned long long)pk2(h.z, h.w) << 32); }
}
__device__ __forceinline__ void p1_modulate0(Frame& F) {
    const int gw = F.bid * NWAVES + F.wave, NGW = F.G * NWAVES;
    bf16* H = (bf16*)(F.ws + WS_H);
    for (int row = gw; row < M_ALL; row += NGW) {
        const bool isctx = row >= M_LAT; const int b = isctx ? 4 : row / SEQ;
        const float* xr = isctx ? F.in[2] + (size_t)(row - M_LAT) * D : F.in[0] + (size_t)row * D;
        f32x4 v[4];
#pragma unroll
        for (int j = 0; j < 4; ++j) v[j] = ((const f32x4*)xr)[F.lane + 64 * j];
        modulate_row(v, F.in[6], modv(F, 0, b, 0), modv(F, 0, b, 1), H + (size_t)row * D, F.lane);
    }
}

__device__ __forceinline__ void p3_scan_naive(Frame& F) {
    if (F.bid >= 64) return;
    const int b = F.bid >> 4, h = (F.bid >> 1) & 7, dir = F.bid & 1;
    const bf16* PQ = (const bf16*)(F.ws + WS_PL), *PV = PQ + (size_t)M_ALL * D, *PZ = PQ + (size_t)(2 + dir) * M_ALL * D;
    bf16* OL = (bf16*)F.out + (size_t)dir * M_LAT * D; bf16* OC = (bf16*)(F.ws + (dir ? WS_OBC : WS_OFC));
    LAS float* fl = (LAS float*)F.lds, *kl = fl + 128, *ql = fl + 256, *ored = fl + 384;
    const int v = F.tid & 127, kq = F.tid >> 7;
    float lbv = 0.f;
    if (F.tid < 128) { const float* lb = dir ? F.in[10] : F.in[9]; lbv = sigmoidf_(lb[h * DH + F.tid] - lb[D + h * DH + F.tid]); }
    float S[32];
#pragma unroll
    for (int j = 0; j < 32; ++j) S[j] = 0.f;
    for (int s = 0; s < CTXL + SEQ; ++s) {
        int row;
        if (s < CTXL) row = M_LAT + b * CTXL + (dir ? CTXL - 1 - s : s);
        else row = b * SEQ + (dir ? SEQ - 1 - (s - CTXL) : s - CTXL);
        const size_t off = (size_t)row * D + h * DH;
        if (F.tid < 128) { const float kk = bf2f(PZ[off + F.tid]);
            fl[F.tid] = 1.f - kk; kl[F.tid] = kk; ql[F.tid] = bf2f(PQ[off + F.tid]); }
        const float vv = bf2f(PV[off + v]);
        __syncthreads();
        float po = 0.f;
#pragma unroll
        for (int j = 0; j < 32; ++j) { const int k = 32 * kq + j; S[j] = fl[k] * S[j] + kl[k] * vv; po += S[j] * ql[k]; }
        ored[kq * 128 + v] = po;
        __syncthreads();
        if (kq == 0) { const float o = (ored[v] + ored[128 + v]) + (ored[256 + v] + ored[384 + v]);
            if (s >= CTXL) OL[(size_t)row * D + h * DH + v] = (bf16)f2bf(o);
            else if (CTX_FULL) OC[(size_t)(row - M_LAT) * D + h * DH + v] = (bf16)f2bf(o); }
    }
}

typedef float f32x16 __attribute__((ext_vector_type(16)));
__device__ __forceinline__ void lds_fadd(LAS float* p, float v) { (void)__hip_atomic_fetch_add(p, v, __ATOMIC_RELAXED, __HIP_MEMORY_SCOPE_WORKGROUP); }
typedef float f32x2 __attribute__((ext_vector_type(2)));
#define MFMA32(a, b, c) __builtin_amdgcn_mfma_f32_32x32x16_bf16((a), (b), (c), 0, 0, 0)
__device__ __forceinline__ int crow(int reg, int h) { return (reg & 3) + 8 * (reg >> 2) + 4 * h; }
__device__ __forceinline__ int t256_off(int row, int cb) { return row * 256 + ((((cb >> 4) ^ (row & 15)) << 4) | (cb & 15)); }
__device__ __forceinline__ int t128_off(int row, int cb) { return row * 128 + ((((cb >> 4) ^ ((row >> 1) & 7)) << 4) | (cb & 15)); }
__device__ __forceinline__ bf16x8 pack8(const f32x16& x, int s) {
    v4u p; p.x = pk2(x[8 * s], x[8 * s + 1]); p.y = pk2(x[8 * s + 2], x[8 * s + 3]); p.z = pk2(x[8 * s + 4], x[8 * s + 5]); p.w = pk2(x[8 * s + 6], x[8 * s + 7]);
    return __builtin_bit_cast(bf16x8, p);
}
template <bool STATE  >
__device__ __forceinline__ void scan_items(Frame& F) {
    constexpr int SC_QE = 0, SC_QC = 16384, SC_KR = 32768, SC_KRT = 49152, SC_VT = 65536, SC_ST = 69632, SC_TOT = 77824, SC_VEC = 81920, SC_SLOT = 83968, SC_ST2 = 124928;
    static_assert(SC_ST2 + 8192 <= RING_BYTES, "scan LDS map");
    constexpr int NCH = (CTXL + SEQ) / 64;
    LAS unsigned char* L = F.lds;
    const int tid = F.tid, lane = F.lane, w = F.wave, r = lane & 31, hh = lane >> 5;
    const bf16* PQ = (const bf16*)(F.ws + WS_PL); const bf16* PV = PQ + (size_t)M_ALL * D;
    f32x16 zero16;
#pragma unroll
    for (int i = 0; i < 16; ++i) zero16[i] = 0.f;
    for (int item = F.bid; item < 256; item += F.G) {
        const int dvs = (item >> 3) & 3, bhd = (item >> 5) * 8 + (item & 7), b = bhd >> 4, h = (bhd >> 1) & 7, dir = bhd & 1;
        const bf16* PZ = PQ + (size_t)(2 + dir) * M_ALL * D;
        const int c0 = 2 * lane, colq = h * DH + c0, colv = h * DH + dvs * 32;
        bf16* OL = (bf16*)F.out + (size_t)dir * M_LAT * D; bf16* OC = (bf16*)(F.ws + (dir ? WS_OBC : WS_OFC));
        const int sgn = dir ? -1 : 1;
        __syncthreads();
        for (int i = tid; i < 8192 / 16; i += NTHR) ((LAS v4u*)(L + SC_ST))[i] = (v4u){0u, 0u, 0u, 0u};
        f32x16 S0 = zero16, S1 = zero16;
        unsigned zr[8], qr[8]; v4u vr = {0u, 0u, 0u, 0u};
#define SCAN_BASE(n) (((n) < 4) ? (M_LAT + b * CTXL + (dir ? CTXL - 1 - 64 * (n) : 64 * (n))) : (b * SEQ + (dir ? SEQ - 1 - 64 * ((n) - 4) : 64 * ((n) - 4))))
#define SCAN_LOAD(n) do { const int _base = SCAN_BASE(n); \
            _Pragma("unroll") for (int _i = 0; _i < 8; ++_i) { const size_t _o = (size_t)(_base + sgn * (8 * w + _i)) * D + colq; zr[_i] = *(const unsigned*)(PZ + _o); qr[_i] = *(const unsigned*)(PQ + _o); } \
            if (tid < 256) vr = *(const v4u*)(PV + (size_t)(_base + sgn * (tid >> 2)) * D + colv + 8 * (tid & 3)); } while (0)
#define SCAN_C(m) do { const LAS unsigned char* sl_ = L + SC_SLOT + ((m) & 1) * 20480; const int base_ = SCAN_BASE(m); \
            _Pragma("unroll") for (int q_ = 0; q_ < 8; ++q_) { const int t_ = lane + 64 * q_, c_ = t_ >> 3, v0_ = (t_ & 7) * 4, so_ = ((c_ & 31) * 32 + v0_) * 4; f32x4 o_; \
                if (c_ < 32) o_ = *(const LAS f32x4*)(sl_ + so_) + *(const LAS f32x4*)(sl_ + 3 * 4096 + so_); \
                else o_ = *(const LAS f32x4*)(sl_ + 4096 + so_) + *(const LAS f32x4*)(sl_ + 2 * 4096 + so_) + *(const LAS f32x4*)(sl_ + 4 * 4096 + so_); \
                const int row_ = base_ + sgn * c_; const v2u ov_ = {pk2(o_.x, o_.y), pk2(o_.z, o_.w)}; \
                if ((m) >= 4) *(v2u*)(OL + (size_t)row_ * D + colv + v0_) = ov_; \
                else if (CTX_FULL) *(v2u*)(OC + (size_t)(row_ - M_LAT) * D + colv + v0_) = ov_; } } while (0)
        SCAN_LOAD(0);
        for (int n = 0; n < NCH; ++n) {
            float f0[8], f1[8];
            float pr0 = 1.f, pr1 = 1.f;
#pragma unroll
            for (int i = 0; i < 8; ++i) { f0[i] = 1.f - bflo(zr[i]); f1[i] = 1.f - bfhi(zr[i]); pr0 *= f0[i]; pr1 *= f1[i]; }
            *(LAS f32x2*)(L + SC_TOT + (w * 128 + c0) * 4) = (f32x2){__logf(pr0), __logf(pr1)};
            __syncthreads();
            if (tid < 256) { const int p = tid >> 2, c8 = tid & 3;
#pragma unroll
                for (int j = 0; j < 8; ++j) { const unsigned hv = (vr[j >> 1] >> (16 * (j & 1))) & 0xffffu; *(LAS unsigned short*)(L + SC_VT + t128_off(8 * c8 + j, 2 * p)) = (unsigned short)hv; } }
            float off0 = 0.f, off1 = 0.f, ref0 = 0.f, ref1 = 0.f, last0 = 0.f, last1 = 0.f;
#pragma unroll
            for (int ww = 0; ww < 8; ++ww) { const f32x2 t2 = *(const LAS f32x2*)(L + SC_TOT + (ww * 128 + c0) * 4); const float t0 = t2.x, t1 = t2.y;
                off0 += (ww < w) ? t0 : 0.f; off1 += (ww < w) ? t1 : 0.f; if (ww < 4) { ref0 += t0; ref1 += t1; } last0 += t0; last1 += t1; }
            float E0 = __expf(off0 - ref0), E1 = __expf(off1 - ref1);
            const float er0 = __expf(ref0), er1 = __expf(ref1);
            unsigned krp0[4], krp1[4];
#pragma unroll
            for (int i = 0; i < 8; i += 2) {
                float kra[2], krb[2];
#pragma unroll
                for (int u = 0; u < 2; ++u) { const int ii = i + u, srow = 8 * w + ii;
                    E0 *= f0[ii]; E1 *= f1[ii];
                    const float R0 = __builtin_amdgcn_rcpf(E0), R1 = __builtin_amdgcn_rcpf(E1);
                    const float q0 = bflo(qr[ii]), q1 = bfhi(qr[ii]);
                    kra[u] = (1.f - f0[ii]) * R0; krb[u] = (1.f - f1[ii]) * R1;
                    *(LAS unsigned*)(L + SC_QE + t256_off(srow, 2 * c0)) = pk2(q0 * E0, q1 * E1);
                    *(LAS unsigned*)(L + SC_QC + t256_off(srow, 2 * c0)) = pk2(q0 * E0 * er0, q1 * E1 * er1);
                    *(LAS unsigned*)(L + SC_KR + t256_off(srow, 2 * c0)) = pk2(kra[u], krb[u]); }
                krp0[i >> 1] = pk2(kra[0], kra[1]); krp1[i >> 1] = pk2(krb[0], krb[1]);
            }
            *(LAS v4u*)(L + SC_KRT + t128_off(c0, 16 * w)) = (v4u){krp0[0], krp0[1], krp0[2], krp0[3]};
            *(LAS v4u*)(L + SC_KRT + t128_off(c0 + 1, 16 * w)) = (v4u){krp1[0], krp1[1], krp1[2], krp1[3]};
            if (w == 0) { *(LAS f32x2*)(L + SC_VEC + c0 * 4) = (f32x2){__expf(last0), __expf(last1)};
                *(LAS f32x2*)(L + SC_VEC + 512 + c0 * 4) = (f32x2){__expf(last0 - ref0), __expf(last1 - ref1)}; }
            if (n + 1 < NCH) SCAN_LOAD(n + 1);
            __syncthreads();
            LAS unsigned char* SLW = L + SC_SLOT + (n & 1) * 20480; const LAS unsigned char* STR = L + ((n & 1) ? SC_ST2 : SC_ST); LAS unsigned char* STW = L + ((n & 1) ? SC_ST : SC_ST2);
            if (!STATE && w < 3) {
                const int sb = (w == 2) ? 1 : 0, cb = (w == 0) ? 0 : 1;
                f32x16 x = zero16;
#pragma unroll
                for (int ks = 0; ks < 8; ++ks) { const int cbyte = (16 * ks + 8 * hh) * 2;
                    const bf16x8 a = *(const LAS bf16x8*)(L + SC_KR + t256_off(32 * sb + r, cbyte)), bq = *(const LAS bf16x8*)(L + SC_QE + t256_off(32 * cb + r, cbyte));
                    x = MFMA32(a, bq, x); }
                if (sb == cb) {
#pragma unroll
                    for (int g = 0; g < 16; ++g) x[g] = (crow(g, hh) > r) ? 0.f : x[g]; }
                f32x16 o = zero16;
#pragma unroll
                for (int sp = 0; sp < 2; ++sp) { const bf16x8 pa = pack8(x, sp); const int s0 = 32 * sb + 16 * sp + 4 * hh;
                    const v2u lo = *(const LAS v2u*)(L + SC_VT + t128_off(r, 2 * s0)), hi = *(const LAS v2u*)(L + SC_VT + t128_off(r, 2 * (s0 + 8)));
                    const bf16x8 vb = __builtin_bit_cast(bf16x8, ((v4u){lo.x, lo.y, hi.x, hi.y}));
                    o = MFMA32(pa, vb, o); }
#pragma unroll
                for (int g = 0; g < 16; ++g) *(LAS float*)(SLW + w * 4096 + (crow(g, hh) * 32 + r) * 4) = o[g];
            } else if (!STATE && w < 5) {
                const int cb = w - 3; f32x16 o = zero16;
#pragma unroll
                for (int ks = 0; ks < 8; ++ks) { const int cbyte = (16 * ks + 8 * hh) * 2;
                    const bf16x8 a = *(const LAS bf16x8*)(L + SC_QC + t256_off(32 * cb + r, cbyte)), bs = *(const LAS bf16x8*)(STR + t256_off(r, cbyte));
                    o = MFMA32(a, bs, o); }
#pragma unroll
                for (int g = 0; g < 16; ++g) *(LAS float*)(SLW + w * 4096 + (crow(g, hh) * 32 + r) * 4) = o[g];
            } else if (STATE) {
#define SCAN_KV(ST_, kb_) do { f32x16 kv = zero16; \
                    _Pragma("unroll") for (int ks = 0; ks < 4; ++ks) { const int sbyte = (16 * ks + 8 * hh) * 2; \
                        const bf16x8 a = *(const LAS bf16x8*)(L + SC_KRT + t128_off(32 * (kb_) + r, sbyte)), bv = *(const LAS bf16x8*)(L + SC_VT + t128_off(r, sbyte)); \
                        kv = MFMA32(a, bv, kv); } \
                    _Pragma("unroll") for (int g4 = 0; g4 < 4; ++g4) { const int kk = (32 * (kb_) + 8 * g4 + 4 * hh) * 4; \
                        const f32x4 el = *(const LAS f32x4*)(L + SC_VEC + kk), elr = *(const LAS f32x4*)(L + SC_VEC + 512 + kk); \
                        _Pragma("unroll") for (int j = 0; j < 4; ++j) ST_[4 * g4 + j] = el[j] * ST_[4 * g4 + j] + elr[j] * kv[4 * g4 + j]; } } while (0)
                const int kb0 = 2 * (w - 5);
                SCAN_KV(S0, kb0); SCAN_KV(S1, kb0 + 1);
#pragma unroll
                for (int g = 0; g < 4; ++g) {
                    *(LAS v2u*)(STW + t256_off(r, 2 * (32 * kb0 + 8 * g + 4 * hh))) = (v2u){pk2(S0[4 * g], S0[4 * g + 1]), pk2(S0[4 * g + 2], S0[4 * g + 3])};
                    *(LAS v2u*)(STW + t256_off(r, 2 * (32 * (kb0 + 1) + 8 * g + 4 * hh))) = (v2u){pk2(S1[4 * g], S1[4 * g + 1]), pk2(S1[4 * g + 2], S1[4 * g + 3])}; }
            } else if (!STATE && n > 0) { SCAN_C(n - 1); }
        }
#undef SCAN_KV
        __syncthreads();
        if (!STATE && w == 7) SCAN_C(NCH - 1);
#undef SCAN_C
#undef SCAN_LOAD
#undef SCAN_BASE
    }
}

__device__ __forceinline__ void p3_scan(Frame& F) {
    if (F.wave == 5 || F.wave == 6) scan_items<true>(F); else scan_items<false>(F);
}
__device__ __forceinline__ void p4_readout_prep(Frame& F) {
    const int gw = F.bid * NWAVES + F.wave, NGW = F.G * NWAVES;
    const bf16* SG = (const bf16*)(F.ws + WS_PL) + (size_t)4 * M_ALL * D; bf16* YP = (bf16*)(F.ws + WS_H);
    const int nrows = CTX_FULL ? M_ALL : M_LAT;
    for (int row = gw; row < nrows; row += NGW) {
        const bf16 *ofp, *obp;
        if (row < M_LAT) { ofp = (const bf16*)F.out + (size_t)row * D; obp = ofp + (size_t)M_LAT * D; }
        else { ofp = (const bf16*)(F.ws + WS_OFC) + (size_t)(row - M_LAT) * D; obp = (const bf16*)(F.ws + WS_OBC) + (size_t)(row - M_LAT) * D; }
        const int c0 = 16 * F.lane;
        const v4u f0 = *(const v4u*)(ofp + c0), f1 = *(const v4u*)(ofp + c0 + 8), b0 = *(const v4u*)(obp + c0), b1 = *(const v4u*)(obp + c0 + 8);
        const v4u g0 = *(const v4u*)(SG + (size_t)row * D + c0), g1 = *(const v4u*)(SG + (size_t)row * D + c0 + 8);
        float o[16]; float ss = 0.f;
#pragma unroll
        for (int q = 0; q < 4; ++q) { o[2 * q] = bflo(f0[q]) + bflo(b0[q]); o[2 * q + 1] = bfhi(f0[q]) + bfhi(b0[q]); o[8 + 2 * q] = bflo(f1[q]) + bflo(b1[q]); o[8 + 2 * q + 1] = bfhi(f1[q]) + bfhi(b1[q]); }
#pragma unroll
        for (int j = 0; j < 16; ++j) ss += o[j] * o[j];
        ss += __shfl_xor(ss, 1); ss += __shfl_xor(ss, 2); ss += __shfl_xor(ss, 4);
        const float rstd = 1.f / sqrtf(ss * (1.f / DH) + EPS);
        const float* gn = F.in[11] + (c0 & 127);
        float y[16];
#pragma unroll
        for (int q = 0; q < 4; ++q) { y[2 * q] = o[2 * q] * rstd * gn[2 * q] * bflo(g0[q]); y[2 * q + 1] = o[2 * q + 1] * rstd * gn[2 * q + 1] * bfhi(g0[q]);
            y[8 + 2 * q] = o[8 + 2 * q] * rstd * gn[8 + 2 * q] * bflo(g1[q]); y[8 + 2 * q + 1] = o[8 + 2 * q + 1] * rstd * gn[8 + 2 * q + 1] * bfhi(g1[q]); }
        v4u w0, w1;
#pragma unroll
        for (int q = 0; q < 4; ++q) { w0[q] = pk2(y[2 * q], y[2 * q + 1]); w1[q] = pk2(y[8 + 2 * q], y[8 + 2 * q + 1]); }
        *(v4u*)(YP + (size_t)row * D + c0) = w0; *(v4u*)(YP + (size_t)row * D + c0 + 8) = w1;
    }
    conv_layer1(F);
}

__device__ __forceinline__ void top2_of4(float a0, float a1, float a2, float a3, int& i1, int& i2, float& sum) {
    i1 = 0; float v1 = a0;
    if (a1 > v1) { v1 = a1; i1 = 1; }
    if (a2 > v1) { v1 = a2; i1 = 2; }
    if (a3 > v1) { v1 = a3; i1 = 3; }
    const float c0 = (i1 == 0) ? -1e30f : a0, c1 = (i1 == 1) ? -1e30f : a1, c2 = (i1 == 2) ? -1e30f : a2, c3 = (i1 == 3) ? -1e30f : a3;
    i2 = 0; float v2 = c0;
    if (c1 > v2) { v2 = c1; i2 = 1; }
    if (c2 > v2) { v2 = c2; i2 = 2; }
    if (c3 > v2) { v2 = c3; i2 = 3; }
    sum = v1 + v2;
}
__device__ __forceinline__ int rt_swz(int row, int k) { return row * D + ((((k >> 2) ^ row) << 2) | (k & 3)); }
__device__ __forceinline__ void p_route(Frame& F, int l, int bank) {
    LAS float* RWT = (LAS float*)F.lds;
    LAS float* HL = RWT + NE * D;
    LAS float* PART = (LAS float*)(F.lds + LDSCTL_OFF + 1024);
    LAS float* SG = PART + 8 * 256;
    LAS unsigned* lcnt = (LAS unsigned*)(SG + 256);
    const int tid = F.tid, lane = F.lane, w = F.wave;
    for (int i = tid; i < D * NE; i += NTHR) { const int k = i >> 4, e = i & 15; RWT[rt_swz(e, k)] = F.in[17][i]; }
    if (tid < 32) lcnt[tid] = 0u;
    const int nrows = (l == 0 && CTX_FULL) ? M_ALL : M_LAT, ngroups = nrows / 16;
    const float* g = F.in[7] + l * D;
    f32x4 xv[2][4];
#define RT_LOAD(grp) do { _Pragma("unroll") for (int rr = 0; rr < 2; ++rr) { const int row = (grp) * 16 + 2 * w + rr; \
        load_row_bf16((const bf16*)(F.ws + WS_XL) + (size_t)row * D, lane, xv[rr]); } } while (0)
    if (F.bid < ngroups) RT_LOAD(F.bid);
    int it = 0;
    for (int grp = F.bid; grp < ngroups; grp += F.G, ++it) {
        __syncthreads();
#pragma unroll
        for (int rr = 0; rr < 2; ++rr) { const int rl = 2 * w + rr, row = grp * 16 + rl; const int b = (row >= M_LAT) ? 4 : row / SEQ;
            float s2 = 0.f;
#pragma unroll
            for (int j = 0; j < 4; ++j) s2 += (xv[rr][j].x * xv[rr][j].x + xv[rr][j].y * xv[rr][j].y) + (xv[rr][j].z * xv[rr][j].z + xv[rr][j].w * xv[rr][j].w);
            const float rstd = 1.f / sqrtf(wave_sum(s2) * (1.f / D) + EPS);
            const float* sh = modv(F, l, b, 3); const float* sc = modv(F, l, b, 4);
            unsigned long long* o8 = (unsigned long long*)((bf16*)(F.ws + WS_H) + (size_t)row * D) + lane;
#pragma unroll
            for (int j = 0; j < 4; ++j) { const int c = 4 * lane + 256 * j;
                const f32x4 gv = *(const f32x4*)(g + c), shv = *(const f32x4*)(sh + c), scv = *(const f32x4*)(sc + c);
                const f32x4 h = xv[rr][j] * rstd * gv * (scv + 1.f) + shv;
                o8[64 * j] = (unsigned long long)pk2(h.x, h.y) | ((unsigned long long)pk2(h.z, h.w) << 32);
                *(LAS f32x4*)(HL + rt_swz(rl, c)) = h; } }
        if (grp + F.G < ngroups) RT_LOAD(grp + F.G);
        __syncthreads();
        { f32x4 acc = {0.f, 0.f, 0.f, 0.f}; const int r16 = lane & 15, q = lane >> 4;
#pragma unroll
          for (int j = 0; j < 8; ++j) { const int k = 128 * w + 16 * j + 4 * q;
              const f32x4 a4 = *(const LAS f32x4*)(HL + rt_swz(r16, k)), b4 = *(const LAS f32x4*)(RWT + rt_swz(r16, k));
              acc = __builtin_amdgcn_mfma_f32_16x16x4f32(a4.x, b4.x, acc, 0, 0, 0); acc = __builtin_amdgcn_mfma_f32_16x16x4f32(a4.y, b4.y, acc, 0, 0, 0);
              acc = __builtin_amdgcn_mfma_f32_16x16x4f32(a4.z, b4.z, acc, 0, 0, 0); acc = __builtin_amdgcn_mfma_f32_16x16x4f32(a4.w, b4.w, acc, 0, 0, 0); }
#pragma unroll
          for (int j = 0; j < 4; ++j) PART[w * 256 + (q * 4 + j) * 16 + r16] = acc[j]; }
        __syncthreads();
        if (tid < 256) { float lg = 0.f;
#pragma unroll
            for (int ww = 0; ww < 8; ++ww) lg += PART[ww * 256 + tid];
            SG[tid] = sigmoidf_(lg); }
        __syncthreads();
        if (tid < 16) { const int row = grp * 16 + tid;
            float s[16], sel[16];
#pragma unroll
            for (int e4 = 0; e4 < 4; ++e4) { const f32x4 sv = *(const LAS f32x4*)(SG + tid * 16 + 4 * e4), bv = *(const f32x4*)(F.in[18] + 4 * e4);
                s[4 * e4] = sv.x; s[4 * e4 + 1] = sv.y; s[4 * e4 + 2] = sv.z; s[4 * e4 + 3] = sv.w;
                sel[4 * e4] = sv.x + bv.x; sel[4 * e4 + 1] = sv.y + bv.y; sel[4 * e4 + 2] = sv.z + bv.z; sel[4 * e4 + 3] = sv.w + bv.w; }
            int i1a, i2a, i1b, i2b, i1c, i2c, i1d, i2d; float gsa, gsb, gsc, gsd;
            top2_of4(sel[0], sel[1], sel[2], sel[3], i1a, i2a, gsa); top2_of4(sel[4], sel[5], sel[6], sel[7], i1b, i2b, gsb);
            top2_of4(sel[8], sel[9], sel[10], sel[11], i1c, i2c, gsc); top2_of4(sel[12], sel[13], sel[14], sel[15], i1d, i2d, gsd);
            int bpk = i1a | (i2a << 2); float bestv = gsa;
            { const bool c = gsb > bestv; bestv = c ? gsb : bestv; bpk = c ? (i1b | (i2b << 2) | 16) : bpk; }
            { const bool c = gsc > bestv; bestv = c ? gsc : bestv; bpk = c ? (i1c | (i2c << 2) | 32) : bpk; }
            { const bool c = gsd > bestv; bestv = c ? gsd : bestv; bpk = c ? (i1d | (i2d << 2) | 48) : bpk; }
            const int e1 = (bpk >> 4) * 4 + (bpk & 3), e2 = (bpk >> 4) * 4 + ((bpk >> 2) & 3);
            float s1 = 0.f, s2v = 0.f;
#pragma unroll
            for (int e = 0; e < 16; ++e) { s1 = (e == e1) ? s[e] : s1; s2v = (e == e2) ? s[e] : s2v; }
            const float inv = 1.f / (s1 + s2v);
            const unsigned p1 = __hip_atomic_fetch_add(lcnt + e1, 1u, __ATOMIC_RELAXED, __HIP_MEMORY_SCOPE_WORKGROUP);
            const unsigned p2 = __hip_atomic_fetch_add(lcnt + e2, 1u, __ATOMIC_RELAXED, __HIP_MEMORY_SCOPE_WORKGROUP);
            lcnt[32 + it * 16 + tid] = (unsigned)e1 | (p1 << 4) | ((unsigned)e2 << 16) | (p2 << 20);
            float* slotw = (float*)(F.ws + WS_SLOTW);
            slotw[row * 2] = s1 * inv; slotw[row * 2 + 1] = s2v * inv; }
    }
#undef RT_LOAD
    __syncthreads();
    if (tid < 16) lcnt[16 + tid] = atomicAdd((unsigned*)(F.ctl + CW_CNT + 1024 * bank + 64 * tid), lcnt[tid]);
    __syncthreads();
    if (tid < 16 * it) { const int row = (F.bid + F.G * (tid >> 4)) * 16 + (tid & 15); const unsigned en = lcnt[32 + tid];
        const unsigned e1 = en & 15u, p1 = ((en >> 4) & 0xfffu) + lcnt[16 + e1], e2 = (en >> 16) & 15u, p2 = (en >> 20) + lcnt[16 + e2];
        unsigned* list = (unsigned*)(F.ws + WS_LIST); unsigned* slote = (unsigned*)(F.ws + WS_SLOTE);
        list[(size_t)e1 * LIST_CAP + p1] = (unsigned)row * 2u; list[(size_t)e2 * LIST_CAP + p2] = (unsigned)row * 2u + 1u;
        slote[row * 2] = e1 | (p1 << 8); slote[row * 2 + 1] = e2 | (p2 << 8); }
    __syncthreads();
}
__device__ __forceinline__ void moe_prefix(Frame& F, int l) {
    if (F.tid == 0) { unsigned acc = 0;
        for (int e = 0; e < 16; ++e) { const unsigned c = __hip_atomic_load((unsigned*)(F.ctl + CW_CNT + 1024 * l + 64 * e), RLX_AGENT); F.MISC[32 + e] = acc; F.MISC[32 + 17 + e] = c; acc += (c + 255u) >> 8; }
        F.MISC[32 + 16] = acc; }
    __syncthreads();
}
__device__ __forceinline__ void combine_row(Frame& F, int l, int row, int b, const volatile LAS unsigned* tb, f32x4 (&v)[4]) {
    const unsigned se0 = ((const unsigned*)(F.ws + WS_SLOTE))[row * 2], se1 = ((const unsigned*)(F.ws + WS_SLOTE))[row * 2 + 1];
    const float w0 = ((const float*)(F.ws + WS_SLOTW))[row * 2], w1 = ((const float*)(F.ws + WS_SLOTW))[row * 2 + 1];
    const size_t p0 = (size_t)tb[se0 & 255u] * 256 + (se0 >> 8), p1 = (size_t)tb[se1 & 255u] * 256 + (se1 >> 8);
    const bf16* Y2 = (const bf16*)(F.ws + WS_Y2);
    const v2u* y0 = (const v2u*)(Y2 + p0 * D) + F.lane; const v2u* y1 = (const v2u*)(Y2 + p1 * D) + F.lane;
    const float* g2 = modv(F, l, b, 5);
#pragma unroll
    for (int j = 0; j < 4; ++j) { const v2u a = y0[64 * j], c = y1[64 * j]; const f32x4 gv = *(const f32x4*)(g2 + 4 * F.lane + 256 * j);
        f32x4 ff; ff.x = w0 * bflo(a.x) + w1 * bflo(c.x); ff.y = w0 * bfhi(a.x) + w1 * bfhi(c.x); ff.z = w0 * bflo(a.y) + w1 * bflo(c.y); ff.w = w0 * bfhi(a.y) + w1 * bfhi(c.y);
        v[j] = v[j] + gv * ff; }
}
__device__ __forceinline__ void p9_combine_mod(Frame& F) {
    moe_prefix(F, 0);
    const volatile LAS unsigned* tb = F.MISC + 32;
    const int gw = F.bid * NWAVES + F.wave, NGW = F.G * NWAVES;
    const int nrows = CTX_FULL ? M_ALL : M_LAT;
    for (int row = gw; row < nrows; row += NGW) {
        const bool isctx = row >= M_LAT; const int b = isctx ? 4 : row / SEQ;
        bf16* xr = (bf16*)(F.ws + WS_XL) + (size_t)row * D;
        f32x4 v[4];
        load_row_bf16(xr, F.lane, v);
        combine_row(F, 0, row, b, tb, v);
        store_row_bf16(xr, F.lane, v);
        if (!isctx) modulate_row(v, F.in[6] + D, modv(F, 1, b, 0), modv(F, 1, b, 1), (bf16*)(F.ws + WS_H) + (size_t)row * D, F.lane);
    }
}
__device__ __forceinline__ void p11_pool(Frame& F) {
    LAS float* I = (LAS float*)F.lds;
    const bf16* U = (const bf16*)F.out; bf16* DP = (bf16*)(F.ws + WS_DP);
    const int t = F.tid;
    for (int item = F.bid; item < 512; item += F.G) {
        const int b = item >> 7, slab = item & 127, g = slab >> 5, win = 2 << g, half = win >> 1;
        const bf16* Ub = U + ((size_t)b * 128 + slab) * SEQ * 8;
        __syncthreads();
#pragma unroll
        for (int j = 0; j < 8; ++j) { const int tok = t + 512 * j, r = tok >> 6, c = tok & 63; const v4u w = *(const v4u*)(Ub + (size_t)tok * 8);
            LAS f32x4* dst = (LAS f32x4*)(I + r * 512 + ((c ^ (r & 3)) * 8));
            dst[0] = (f32x4){bflo(w.x), bfhi(w.x), bflo(w.y), bfhi(w.y)}; dst[1] = (f32x4){bflo(w.z), bfhi(w.z), bflo(w.w), bfhi(w.w)}; }
        __syncthreads();
        { const int r = t >> 3, ch = t & 7; float run = 0.f;
#pragma unroll 16
          for (int c = 0; c < 64; ++c) { LAS float* p = I + r * 512 + ((c ^ (r & 3)) * 8) + ch; run += *p; *p = run; } }
        __syncthreads();
        { const int c = t >> 3, ch = t & 7; float run = 0.f;
#pragma unroll 16
          for (int r = 0; r < 64; ++r) { LAS float* p = I + r * 512 + ((c ^ (r & 3)) * 8) + ch; run += *p; *p = run; } }
        __syncthreads();
#pragma unroll 2
        for (int j = 0; j < 8; ++j) { const int tok = t + 512 * j, r = tok >> 6, c = tok & 63;
            const int rlo = max(r - half, 0), rhi = min(r - half + win, GRIDW), clo = max(c - half, 0), chi = min(c - half + win, GRIDW);
            const int r1 = rhi - 1, c1 = chi - 1, r0 = rlo - 1, c0 = clo - 1;
            const LAS f32x4* p11 = (const LAS f32x4*)(I + r1 * 512 + ((c1 ^ (r1 & 3)) * 8));
            f32x4 s0 = p11[0], s1 = p11[1];
            if (r0 >= 0) { const LAS f32x4* q = (const LAS f32x4*)(I + r0 * 512 + ((c1 ^ (r0 & 3)) * 8)); s0 -= q[0]; s1 -= q[1]; }
            if (c0 >= 0) { const LAS f32x4* q = (const LAS f32x4*)(I + r1 * 512 + ((c0 ^ (r1 & 3)) * 8)); s0 -= q[0]; s1 -= q[1]; }
            if (r0 >= 0 && c0 >= 0) { const LAS f32x4* q = (const LAS f32x4*)(I + r0 * 512 + ((c0 ^ (r0 & 3)) * 8)); s0 += q[0]; s1 += q[1]; }
            const float inv = 1.f / (float)((rhi - rlo) * (chi - clo));
            const v4u w = *(const v4u*)(Ub + (size_t)tok * 8);
            v4u o; o.x = pk2(s0.x * inv - bflo(w.x), s0.y * inv - bfhi(w.x)); o.y = pk2(s0.z * inv - bflo(w.y), s0.w * inv - bfhi(w.y));
            o.z = pk2(s1.x * inv - bflo(w.z), s1.y * inv - bfhi(w.z)); o.w = pk2(s1.z * inv - bflo(w.w), s1.w * inv - bfhi(w.w));
            *(v4u*)(DP + ((size_t)slab * M_LAT + (size_t)b * SEQ + tok) * 8) = o; }
    }
}
__device__ __forceinline__ void p17_final(Frame& F) {
    moe_prefix(F, 1);
    const volatile LAS unsigned* tb = F.MISC + 32;
    const int gw = F.bid * NWAVES + F.wave, NGW = F.G * NWAVES;
    for (int row = gw; row < M_LAT; row += NGW) {
        float* xr = F.out + (size_t)row * D;
        f32x4 v[4];
        load_row_bf16((const bf16*)(F.ws + WS_XL) + (size_t)row * D, F.lane, v);
        combine_row(F, 1, row, row / SEQ, tb, v);
        float s2 = 0.f;
#pragma unroll
        for (int j = 0; j < 4; ++j) s2 += (v[j].x * v[j].x + v[j].y * v[j].y) + (v[j].z * v[j].z + v[j].w * v[j].w);
        const float rstd = 1.f / sqrtf(wave_sum(s2) * (1.f / D) + EPS);
#pragma unroll
        for (int j = 0; j < 4; ++j) { const f32x4 gv = *(const f32x4*)(F.in[22] + 4 * F.lane + 256 * j); ((f32x4*)xr)[F.lane + 64 * j] = v[j] * rstd * gv; }
    }
}

struct Args { const float* in[23]; float* out; unsigned char* ws; int ph_lo, ph_hi; };
#ifndef NAIVE_GEMM
#define RUN_GEMM(EpiT, SchedT, g, S, E) gemm_phase<EpiT, SchedT, true, true>(F.lds, g, S, E)
#else
#define RUN_GEMM(EpiT, SchedT, g, S, E) gemm_naive<EpiT, SchedT>(g, S, E)
#endif

__global__ void __launch_bounds__(NTHR, 2) fwd_kernel(Args args) {
    extern __shared__ __attribute__((aligned(16))) unsigned char lds[];
    Frame F;
    F.lds = (LAS unsigned char*)lds; F.MISC = (volatile LAS unsigned*)(F.lds + MISC_OFF);
    F.tid = threadIdx.x; F.lane = F.tid & 63; F.wave = __builtin_amdgcn_readfirstlane(F.tid >> 6);
    F.G = gridDim.x; F.bid = blockIdx.x;
#pragma unroll
    for (int i = 0; i < 23; ++i) F.in[i] = args.in[i];
    F.out = args.out; F.ws = args.ws; F.ctl = (gu32*)(args.ws + WS_CTL);
    for (int u = F.tid; u < (LDS_BYTES - LDSCTL_OFF) / 4; u += NTHR) ((LAS unsigned*)(F.lds + LDSCTL_OFF))[u] = 0u;
    __syncthreads();
    XcdBarrier bar; bar.bar = (unsigned*)(F.ctl + CW_BAR); bar.x = 0; bar.st = nullptr;
    if (MK_ONE_LAUNCH) bar = xcd_barrier_post((unsigned*)(F.ctl + CW_BAR), F.MISC + 8);
    const int lo = args.ph_lo, hi = args.ph_hi;
#ifndef PHMASK
#define PHMASK 0x3ffff
#endif
#define IN(k) (((PHMASK >> (k)) & 1) && lo <= (k) && (k) < hi)
#ifndef REPMASK
#define REPMASK 0
#endif
#define REPLOOP(k) for (int _r = 0; _r <= ((REPMASK >> (k)) & 1); (++_r <= ((REPMASK >> (k)) & 1)) ? xcd_barrier(bar) : (void)0)
#define SEAM(k) do { if (IN(k) && IN((k) + 1)) xcd_barrier(bar); } while (0)
    bf16* const PL = (bf16*)(F.ws + WS_PL);

    if (IN(0)) REPLOOP(0) { p0_prep(F); } SEAM(0);
    if (IN(1)) REPLOOP(1) { p1_modulate0(F); } SEAM(1);
    if (IN(2)) REPLOOP(2) {
        Gemm g{(const bf16*)(F.ws + WS_H), (const bf16*)(F.ws + WS_WHGIN), D, 128}; StaticOrder S; S.init(M_ALL, NPROJ * D, F.G, F.bid);
        EpiInProj E{PL, (const float*)(F.ws + WS_LBV)}; RUN_GEMM(EpiInProj, StaticOrder, g, S, E);
        conv_moe_queue(F, 0, (bf16*)(F.ws + WS_WGU0), (bf16*)(F.ws + WS_WD0)); } SEAM(2);
    #ifdef SCAN_NAIVE
    if (IN(3)) REPLOOP(3) { p3_scan_naive(F); } SEAM(3);
#else
    if (IN(3)) REPLOOP(3) { p3_scan(F); } SEAM(3);
#endif
    if (IN(4)) REPLOOP(4) { p4_readout_prep(F); } SEAM(4);
    if (IN(5)) REPLOOP(5) {
        Gemm g{(const bf16*)(F.ws + WS_H), (const bf16*)(F.ws + WS_WHGOUT), D, 128}; StaticOrder S; S.init(CTX_FULL ? M_ALL : M_LAT, D, F.G, F.bid);
        EpiResid<true> E{F.in[0], (bf16*)(F.ws + WS_XL), modv(F, 0, 0, 2)}; RUN_GEMM(EpiResid<true>, StaticOrder, g, S, E); } SEAM(5);
    if (IN(6)) REPLOOP(6) { p_route(F, 0, (_r < ((REPMASK >> 6) & 1)) ? 2 : 0); } SEAM(6);
    if (IN(7)) REPLOOP(7) { moe_prefix(F, 0);
        Gemm g{(const bf16*)(F.ws + WS_H), (const bf16*)(F.ws + WS_WGU0), D, 128}; MoeOrder S{F.G, F.bid, 2, 1, F.MISC + 32, (const unsigned*)(F.ws + WS_LIST)};
        EpiGateUp E{(bf16*)(F.ws + WS_ACT)}; RUN_GEMM(EpiGateUp, MoeOrder, g, S, E);
 } SEAM(7);
    if (IN(8)) REPLOOP(8) { moe_prefix(F, 0);
        Gemm g{(const bf16*)(F.ws + WS_ACT), (const bf16*)(F.ws + WS_WD0), DE, 128}; MoeOrder S{F.G, F.bid, 4, 0, F.MISC + 32, (const unsigned*)(F.ws + WS_LIST)};
        EpiDown E{(bf16*)(F.ws + WS_Y2)}; RUN_GEMM(EpiDown, MoeOrder, g, S, E); } SEAM(8);
    if (IN(9)) REPLOOP(9) { p9_combine_mod(F); } SEAM(9);
    if (IN(10)) REPLOOP(10) {
        Gemm g{(const bf16*)(F.ws + WS_H), (const bf16*)(F.ws + WS_WPIN), D, 128}; StaticOrder S; S.init(M_LAT, D, F.G, F.bid);
        EpiPoolIn E{(bf16*)F.out}; RUN_GEMM(EpiPoolIn, StaticOrder, g, S, E); } SEAM(10);
        if (IN(11)) REPLOOP(11) { p11_pool(F); } SEAM(11);
    if (IN(12)) REPLOOP(12) {
        Gemm g{(const bf16*)(F.ws + WS_DP), (const bf16*)(F.ws + WS_WGRP), 256, (size_t)8 * M_LAT * 16}; GroupOrder S{F.G, F.bid};
        EpiGrp E{(bf16*)(F.ws + WS_E), F.in[15]}; RUN_GEMM(EpiGrp, GroupOrder, g, S, E); } SEAM(12);
    if (IN(13)) REPLOOP(13) {
        Gemm g{(const bf16*)(F.ws + WS_E), (const bf16*)(F.ws + WS_WPOUT), D, 128}; StaticOrder S; S.init(M_LAT, D, F.G, F.bid);
        EpiResid<false> E{F.ws + WS_XL, (bf16*)(F.ws + WS_XL), modv(F, 1, 0, 2)}; RUN_GEMM(EpiResid<false>, StaticOrder, g, S, E); } SEAM(13);
    if (IN(14)) REPLOOP(14) { p_route(F, 1, (_r < ((REPMASK >> 14) & 1)) ? 3 : 1); } SEAM(14);
    if (IN(15)) REPLOOP(15) { moe_prefix(F, 1);
        Gemm g{(const bf16*)(F.ws + WS_H), (const bf16*)(F.ws + WS_WGU1), D, 128}; MoeOrder S{F.G, F.bid, 2, 1, F.MISC + 32, (const unsigned*)(F.ws + WS_LIST)};
        EpiGateUp E{(bf16*)(F.ws + WS_ACT)}; RUN_GEMM(EpiGateUp, MoeOrder, g, S, E); } SEAM(15);
    if (IN(16)) REPLOOP(16) { moe_prefix(F, 1);
        Gemm g{(const bf16*)(F.ws + WS_ACT), (const bf16*)(F.ws + WS_WD1), DE, 128}; MoeOrder S{F.G, F.bid, 4, 0, F.MISC + 32, (const unsigned*)(F.ws + WS_LIST)};
        EpiDown E{(bf16*)(F.ws + WS_Y2)}; RUN_GEMM(EpiDown, MoeOrder, g, S, E); } SEAM(16);
    if (IN(17)) REPLOOP(17) { p17_final(F); }
#undef IN
#undef SEAM
}

extern "C" void kernel_launch(void* const* d_in, const int* in_sizes, int n_in, void* d_out, int out_size, void* d_ws, size_t ws_size, hipStream_t stream) {
    static int grid = 0;
    if (grid == 0) {
        if (n_in != 23 || in_sizes[0] != M_LAT * D || out_size != M_LAT * D || ws_size < WS_END) { fprintf(stderr, "kernel_launch: unexpected shapes (n_in %d, in0 %d, out %d, ws %zu); nothing launched\n", n_in, n_in > 0 ? in_sizes[0] : -1, out_size, ws_size); grid = -1; return; }
        int dev = 0, cus = 0, per_cu = 0;
        if (hipGetDevice(&dev) != hipSuccess || hipDeviceGetAttribute(&cus, hipDeviceAttributeMultiprocessorCount, dev) != hipSuccess) { grid = -1; return; }
        if (hipFuncSetAttribute((const void*)fwd_kernel, hipFuncAttributeMaxDynamicSharedMemorySize, LDS_BYTES) != hipSuccess) { fprintf(stderr, "kernel_launch: hipFuncSetAttribute failed\n"); grid = -1; return; }
        if (hipOccupancyMaxActiveBlocksPerMultiprocessor(&per_cu, (const void*)fwd_kernel, NTHR, LDS_BYTES) != hipSuccess || per_cu < 1) { fprintf(stderr, "kernel_launch: occupancy query says %d blocks per CU\n", per_cu); per_cu = 1; }
        (void)hipGetLastError();
        grid = cus;
    }
    if (grid < 0) return;
    if (hipMemsetAsync((char*)d_ws + WS_CTL, 0, CTL_ZERO_BYTES, stream) != hipSuccess) return;
    Args a{};
    for (int i = 0; i < 23; ++i) a.in[i] = (const float*)d_in[i];
    a.out = (float*)d_out; a.ws = (unsigned char*)d_ws;
    if (MK_ONE_LAUNCH) { a.ph_lo = 0; a.ph_hi = NPHASE; hipLaunchKernelGGL(fwd_kernel, dim3(grid), dim3(NTHR), LDS_BYTES, stream, a); }
    else for (int p = 0; p < NPHASE; ++p) { a.ph_lo = p; a.ph_hi = p + 1; hipLaunchKernelGGL(fwd_kernel, dim3(grid), dim3(NTHR), LDS_BYTES, stream, a); }
}
```

```cpp
#include <hip/hip_runtime.h>
#include <cstdio>
#include <cstdint>

#ifndef MK_ONE_LAUNCH
#define MK_ONE_LAUNCH 1
#endif
#ifndef CTX_FULL
#define CTX_FULL 0
#endif

constexpr int D = 1024, NB = 4, SEQ = 4096, CTXL = 256;
constexpr int M_LAT = NB * SEQ, M_CTX = NB * CTXL, M_ALL = M_LAT + M_CTX;
constexpr int NH = 8, DH = 128, NPROJ = 5;
constexpr int NE = 16, DE = 256, NGRP = 4, EPG = 4;
constexpr int GRIDW = 64;
constexpr float EPS = 1e-6f;
constexpr int NWAVES = 8, NTHR = 512;
constexpr int NPHASE = 18;

constexpr size_t MiB = 1u << 20;
constexpr size_t WS_CTL = 0, CTL_ZERO_BYTES = 1 * MiB;
constexpr size_t WS_MODV = 1 * MiB;
constexpr size_t WS_LBV = 1 * MiB + 256 * 1024;
constexpr size_t WS_LIST = 2 * MiB;
constexpr size_t WS_SLOTE = 2 * MiB + 1280 * 1024;
constexpr size_t WS_SLOTW = 2 * MiB + 1536 * 1024;
constexpr size_t WS_WHGIN = 4 * MiB;
constexpr size_t WS_WHGOUT = 14 * MiB;
constexpr size_t WS_WGU0 = 16 * MiB;
constexpr size_t WS_WD0 = 32 * MiB;
constexpr size_t WS_XC = 40 * MiB;
constexpr size_t WS_H = 44 * MiB;
constexpr size_t WS_PL = 78 * MiB;
constexpr size_t PLANE = (size_t)M_ALL * D * 2;
constexpr size_t WS_OFC = 248 * MiB, WS_OBC = 250 * MiB;
constexpr size_t WS_WPIN = 78 * MiB, WS_WGRP = 80 * MiB, WS_WPOUT = 81 * MiB;
constexpr size_t WS_WGU1 = 83 * MiB, WS_WD1 = 99 * MiB;
constexpr size_t WS_ACT = 108 * MiB;
constexpr size_t WS_Y2 = 128 * MiB;
constexpr size_t WS_XL = 204 * MiB;
constexpr size_t WS_DP = 108 * MiB;
constexpr size_t WS_E = 140 * MiB;
constexpr size_t WS_END = 256 * MiB;
static_assert(WS_PL + 5 * PLANE <= WS_OFC && WS_H + PLANE <= WS_PL && WS_Y2 + (size_t)38912 * 2048 <= WS_XL && WS_XL + (size_t)M_LAT * 2048 <= WS_OFC, "ws map");
static_assert(WS_ACT + (size_t)38912 * 512 <= WS_Y2 && WS_DP + (size_t)M_LAT * 2048 <= WS_E && WS_E + (size_t)M_LAT * 2048 <= WS_XL && WS_WD1 + 8 * MiB <= WS_ACT, "ws map 2");
constexpr int CW_BAR = 4096;
constexpr int CW_Q = 16384;
constexpr int CW_CNT = 8192;
constexpr int LIST_CAP = M_ALL;

constexpr int RING_BYTES = 147456;
constexpr int LDSCTL_OFF = RING_BYTES, MISC_OFF = LDSCTL_OFF + 320;
constexpr int LDS_BYTES = 163840;

#define GAS __attribute__((address_space(1)))
#define LAS __attribute__((address_space(3)))
typedef unsigned short bf16;
typedef unsigned v4u __attribute__((ext_vector_type(4)));
typedef unsigned v2u __attribute__((ext_vector_type(2)));
typedef float f32x4 __attribute__((ext_vector_type(4)));
typedef short bf16x8 __attribute__((ext_vector_type(8)));
typedef GAS unsigned gu32;
#define RLX_AGENT __ATOMIC_RELAXED, __HIP_MEMORY_SCOPE_AGENT
#define LDS_WAIT() asm volatile("s_waitcnt lgkmcnt(0)" ::: "memory")
#define VM_WAIT() asm volatile("s_waitcnt vmcnt(0)" ::: "memory")

__device__ __forceinline__ unsigned f2bf(float f) { unsigned u = __builtin_bit_cast(unsigned, f); return (u + 0x7fffu + ((u >> 16) & 1u)) >> 16; }
typedef float f32x2_t __attribute__((ext_vector_type(2)));
typedef __bf16 bf16x2_t __attribute__((ext_vector_type(2)));
__device__ __forceinline__ unsigned pk2(float lo, float hi) { const f32x2_t v = {lo, hi}; const bf16x2_t b = __builtin_convertvector(v, bf16x2_t); return __builtin_bit_cast(unsigned, b); }
__device__ __forceinline__ float bf2f(unsigned b) { return __builtin_bit_cast(float, b << 16); }
__device__ __forceinline__ float bflo(unsigned w) { return __builtin_bit_cast(float, w << 16); }
__device__ __forceinline__ float bfhi(unsigned w) { return __builtin_bit_cast(float, w & 0xffff0000u); }
__device__ __forceinline__ float sigmoidf_(float x) { return __builtin_amdgcn_rcpf(1.f + __expf(-x)); }
__device__ __forceinline__ float siluf_(float x) { return x * __builtin_amdgcn_rcpf(1.f + __expf(-x)); }
__device__ __forceinline__ float wave_sum(float v) {
#pragma unroll
    for (int o = 1; o < 64; o <<= 1) v += __shfl_xor(v, o);
    return v;
}

#define XB_TMO      128
#define XB_XCNT(j)  (256  + 64 * (j))
#define XB_XSUB(j)  (1280 + 64 * (j))
#define XB_XGEN(j)  (2304 + 64 * (j))
#define XB_TOP      3328
#define XB_TOPGEN   3392
#define XCD_BAR_WORDS 3456
#define XB_SPIN_CAP (1u << 18)
__device__ __forceinline__ unsigned xb_ld(unsigned* p)              { return __hip_atomic_load(p, __ATOMIC_RELAXED, __HIP_MEMORY_SCOPE_AGENT); }
__device__ __forceinline__ unsigned xb_add(unsigned* p, unsigned v) { return __hip_atomic_fetch_add(p, v, __ATOMIC_RELAXED, __HIP_MEMORY_SCOPE_AGENT); }
__device__ __forceinline__ unsigned xb_xcc_id() { return (unsigned)__builtin_amdgcn_s_getreg((3 << 11) | 20) & 0xFu; }
#define XB_SPIN(cond, bar) do { unsigned _sp = 0; while (cond) { __builtin_amdgcn_s_sleep(1); \
    if ((++_sp & 255u) == 0u) { if (xb_ld(&(bar)[XB_TMO])) break; if (_sp > XB_SPIN_CAP) { atomicAdd(&(bar)[XB_TMO], 1u); break; } } } } while (0)
struct XcdBarrier { unsigned* bar; unsigned x; volatile LAS unsigned* st; };
__device__ __forceinline__ XcdBarrier xcd_barrier_post(unsigned* bar, volatile LAS unsigned* st) {
    XcdBarrier b; b.bar = bar; b.x = xb_xcc_id(); b.st = st;
    if (threadIdx.x == 0) (void)xb_add(&bar[XB_XCNT(b.x)], 1u);
    return b;
}
__device__ __forceinline__ void xcd_barrier_complete(unsigned* bar, unsigned x, unsigned& nloc, unsigned& nx) {
    const unsigned G = gridDim.x * gridDim.y * gridDim.z;
    unsigned sum, cnt, mine, sp = 0u;
    for (;;) {
        sum = 0u; cnt = 0u; mine = 0u;
#pragma unroll
        for (unsigned j = 0; j < 16; ++j) { const unsigned c = xb_ld(&bar[XB_XCNT(j)]); sum += c; cnt += (c > 0u) ? 1u : 0u; mine = (j == x) ? c : mine; }
        if (sum == G) break;
        __builtin_amdgcn_s_sleep(1);
        if ((++sp & 255u) == 0u) { if (xb_ld(&bar[XB_TMO])) break; if (sp > XB_SPIN_CAP) { atomicAdd(&bar[XB_TMO], 1u); break; } }
    }
    nloc = mine > 0u ? mine : 1u; nx = cnt > 0u ? cnt : 1u;
}
__device__ __forceinline__ void xcd_barrier(const XcdBarrier& b) {
    asm volatile("s_waitcnt vmcnt(0)" ::: "memory");
    __syncthreads();
    if (threadIdx.x == 0) {
        unsigned* bar = b.bar;
        __builtin_amdgcn_s_waitcnt(0);
        unsigned nloc = b.st[0], nx = b.st[1];
        if (nloc == 0u) { xcd_barrier_complete(bar, b.x, nloc, nx); b.st[0] = nloc; b.st[1] = nx; }
        const unsigned old = xb_add(&bar[XB_XSUB(b.x)], 1u);
        const unsigned gen = old / nloc;
        if (old + 1u == (gen + 1u) * nloc) {
            __builtin_amdgcn_fence(__ATOMIC_RELEASE, "agent");
            asm volatile("s_waitcnt vmcnt(0)" ::: "memory");
            const unsigned og = xb_add(&bar[XB_TOP], 1u);
            const unsigned tg = og / nx;
            if (og + 1u == (tg + 1u) * nx) xb_add(&bar[XB_TOPGEN], 1u);
            else XB_SPIN(xb_ld(&bar[XB_TOPGEN]) == tg, bar);
            __builtin_amdgcn_fence(__ATOMIC_ACQUIRE, "agent");
            xb_add(&bar[XB_XGEN(b.x)], 1u);
            asm volatile("s_waitcnt vmcnt(0)" ::: "memory");
        } else {
            XB_SPIN(xb_ld(&bar[XB_XGEN(b.x)]) == gen, bar);
            __builtin_amdgcn_fence(__ATOMIC_ACQUIRE, "agent");
            asm volatile("s_waitcnt vmcnt(0)" ::: "memory");
        }
    }
    __syncthreads();
}

struct Unit { int pm, pn; };
struct Gemm { const bf16* A; const bf16* Bt; int K; size_t kstepA; };
constexpr int NXCD = 8, WGM = 8, BM = 256;

struct StaticOrder {
    int nM, nN, nwg, G, c;
    __device__ __forceinline__ void init(int M, int N, int G_, int c_) { nM = M / BM; nN = N / BM; nwg = nM * nN; G = G_; c = c_; }
    __device__ __forceinline__ bool next(int i, Unit& u) const {
        const long L = (long)i * G + c; if (L >= nwg) return false;
        int wgid = (int)L; { const int q = nwg / NXCD, r = nwg % NXCD, xcd = wgid % NXCD, off = wgid / NXCD; wgid = (xcd < r ? xcd * (q + 1) : r * (q + 1) + (xcd - r) * q) + off; }
        const int nig = WGM * nN, gid = wgid / nig, fm = gid * WGM, gsz = (nM - fm) < WGM ? (nM - fm) : WGM;
        u.pm = fm + ((wgid % nig) % gsz); u.pn = (wgid % nig) / gsz; return true;
    }
    __device__ __forceinline__ int a_row(const Unit& u, int r) const { return u.pm * BM + r; }
    __device__ __forceinline__ unsigned a_off(const Unit& u, int r, int c, int K) const { return (unsigned)((u.pm * BM + r) * K + c) * 2u; }
};
struct GroupOrder {
    int G, c;
    __device__ __forceinline__ bool next(int i, Unit& u) const { const int L = i * G + c; if (L >= 256) return false; u.pm = L; u.pn = L >> 6; return true; }
    __device__ __forceinline__ int a_row(const Unit& u, int r) const { return u.pm * BM + r; }
    __device__ __forceinline__ unsigned a_off(const Unit& u, int r, int c, int K) const { return (unsigned)(((u.pn * 32 + (c >> 3)) * M_LAT + (u.pm & 63) * BM + r) * 8 + (c & 7)) * 2u; }
};
struct SlabOrder : StaticOrder {
    __device__ __forceinline__ unsigned a_off(const Unit& u, int r, int c, int K) const { return (unsigned)(((c >> 3) * M_LAT + u.pm * BM + r) * 8 + (c & 7)) * 2u; }
};
struct MoeOrder {
    int G, c, npn, gather; const volatile LAS unsigned* tb; const unsigned* list;
    __device__ __forceinline__ bool next(int i, Unit& u) const {
        const int L = i * G + c; const int nt = (int)tb[16];
        if (L >= nt * npn) return false;
        const int t = L / npn, nl = L % npn; int e = 0;
#pragma unroll
        for (int j = 1; j < 16; ++j) e += (t >= (int)tb[j]) ? 1 : 0;
        u.pm = t; u.pn = e * npn + nl; return true;
    }
    __device__ __forceinline__ int a_row(const Unit& u, int r) const {
        if (!gather) return u.pm * BM + r;
        const int e = u.pn / npn; const int idx = (u.pm - (int)tb[e]) * BM + r;
        const unsigned ent = (idx < (int)tb[17 + e]) ? list[(size_t)e * LIST_CAP + idx] : 0u;
        return (int)(ent >> 1);
    }
    __device__ __forceinline__ unsigned a_off(const Unit& u, int r, int c, int K) const { return (unsigned)(a_row(u, r) * K + c) * 2u; }
};

template <class Epi, class Sched>
__device__ __forceinline__ void gemm_naive(const Gemm g, const Sched& S, const Epi& E) {
    const int tid = threadIdx.x, wid = tid >> 6, lane = tid & 63, wr = wid >> 2, wc = wid & 3, fr = lane & 15, fq = lane >> 4;
    const int K = g.K;
    Unit u;
    for (int i = 0; S.next(i, u); ++i) {
        f32x4 acc[2][2][4][2];
#pragma unroll
        for (int ai = 0; ai < 2; ++ai)
#pragma unroll
            for (int m = 0; m < 4; ++m) {
                const bf16* ar = g.A + (size_t)S.a_row(u, 128 * ai + 64 * wr + 16 * m + fr) * K;
#pragma unroll
                for (int bj = 0; bj < 2; ++bj)
#pragma unroll
                    for (int n = 0; n < 2; ++n) {
                        const int c0 = 128 * bj + 32 * wc + (Epi::PERM ? 8 * fq + 4 * n : 16 * n + 4 * fq);
                        const bf16* br = g.Bt + (size_t)(u.pn * BM + c0) * K;
                        f32x4 a0 = {0.f, 0.f, 0.f, 0.f};
#pragma unroll 1
                        for (int k = 0; k < K; k += 8) {
                            const v4u b0 = *(const v4u*)(br + k), b1 = *(const v4u*)(br + (size_t)K + k), b2 = *(const v4u*)(br + (size_t)2 * K + k), b3 = *(const v4u*)(br + (size_t)3 * K + k);
                            const v4u x0 = *(const v4u*)(ar + k);
#pragma unroll
                            for (int q = 0; q < 4; ++q) {
                                const f32x4 blo = {bflo(b0[q]), bflo(b1[q]), bflo(b2[q]), bflo(b3[q])}, bhi = {bfhi(b0[q]), bfhi(b1[q]), bfhi(b2[q]), bfhi(b3[q])};
                                a0 += blo * bflo(x0[q]) + bhi * bfhi(x0[q]);
                            }
                        }
                        asm volatile("" : "+v"(a0));
                        acc[ai][bj][m][n] = a0;
                    }
            }
        E(acc, u, wr, wc, fr, fq);
    }
}

constexpr int BK = 64, HALF = 128, HTB = HALF * BK * 2;
__device__ __forceinline__ int lds_byte(int r, int c) { const int st = (r >> 4) * 2 + (c >> 5), rr = r & 15, cc = c & 31, ob = rr * 64 + cc * 2; return st * 1024 + (ob ^ (((ob >> 9) & 1) << 5)); }
__device__ __forceinline__ void stage_rc(int b, int& R, int& C) { const int st = b / 1024, sb = b % 1024, swz = sb ^ (((sb >> 9) & 1) << 5); R = (st >> 1) * 16 + swz / 64; C = (st & 1) * 32 + (swz % 64) / 2; }
__device__ __forceinline__ int perm32(int rho) { const int n = rho >> 4, i = rho & 15; return 8 * (i >> 2) + 4 * n + (i & 3); }
template <class Epi, class Sched, bool ALIGN_EPI = false, bool SP2 = false>
__device__ __forceinline__ void gemm_phase(LAS unsigned char* lds, const Gemm g, const Sched& S, const Epi& E) {
    const int tid = threadIdx.x, wid = __builtin_amdgcn_readfirstlane(tid >> 6), lane = tid & 63, wr = wid >> 2, wc = wid & 3, fr = lane & 15, fq = lane >> 4;
    const int K = g.K, nt = K / BK;
    unsigned vAc0[2], vAc1[2], vAn0[2], vAn1[2], voffB[2]; int stR[2], stC[2];
#pragma unroll
    for (int i = 0; i < 2; ++i) { int R, C; stage_rc(tid * 16 + i * 8192, R, C); const int Rb = Epi::PERM ? ((R & ~31) + perm32(R & 31)) : R;
        stR[i] = R; stC[i] = C; voffB[i] = (unsigned)(Rb * K + C) * 2u; }
#define PG8_SETA(v0, v1, U) do { _Pragma("unroll") for (int _i = 0; _i < 2; ++_i) { v0[_i] = S.a_off(U, stR[_i], stC[_i], K); v1[_i] = S.a_off(U, HALF + stR[_i], stC[_i], K); } } while (0)
    const size_t kstep = (size_t)(BK * 2);
    const size_t kstepA = g.kstepA;
    const size_t hstep = (size_t)HALF * K * 2;
    const size_t tstep = 2 * hstep;
    const unsigned ldsw = (unsigned)wid * 1024u;
    const int aoff = lds_byte(wr * 64 + fr, fq * 8), boff = lds_byte(wc * 32 + fr, fq * 8);
#define PG8_SA(b, h) (((b) * 2 + (h)) * HTB)
#define PG8_SB(b, h) ((4 + (b) * 2 + (h)) * HTB)
#define PG8_STAGE(bufoff, gbase, voff) do { _Pragma("unroll") for (int _i = 0; _i < 2; ++_i) \
        __builtin_amdgcn_global_load_lds((const unsigned*)((const char*)(gbase) + (voff)[_i]), (LAS unsigned*)(lds + (bufoff) + ldsw + _i * 8192), 16, 0, 0); } while (0)
#define PG8_LDA(dst, b, h) do { _Pragma("unroll") for (int m = 0; m < 4; ++m) _Pragma("unroll") for (int k = 0; k < 2; ++k) dst[m][k] = *(const LAS bf16x8*)(lds + PG8_SA(b, h) + aoff + m * 2048 + k * 1024); } while (0)
#define PG8_LDB(dst, b, h) do { _Pragma("unroll") for (int n = 0; n < 2; ++n) _Pragma("unroll") for (int k = 0; k < 2; ++k) dst[n][k] = *(const LAS bf16x8*)(lds + PG8_SB(b, h) + boff + n * 2048 + k * 1024); } while (0)
#define PG8_MMA(ai, bj, At, Bt) do { __builtin_amdgcn_s_setprio(1); _Pragma("unroll") for (int m = 0; m < 4; ++m) _Pragma("unroll") for (int n = 0; n < 2; ++n) _Pragma("unroll") for (int k = 0; k < 2; ++k) \
        acc[ai][bj][m][n] = __builtin_amdgcn_mfma_f32_16x16x32_bf16(Bt[n][k], At[m][k], acc[ai][bj][m][n], 0, 0, 0); __builtin_amdgcn_s_setprio(0); } while (0)
#define PG8_WAIT_V(n) asm volatile("s_waitcnt vmcnt(" #n ")" ::: "memory")
#define PG8_WAIT_L(n) asm volatile("s_waitcnt lgkmcnt(" #n ")" ::: "memory")
#define PG8_BAR __builtin_amdgcn_s_barrier()
#define PG8_SCHED __builtin_amdgcn_sched_barrier(0)
    Unit cur, nxt; int ui = 0;
    if (!S.next(0, cur)) return;
    f32x4 acc[2][2][4][2];
#pragma unroll
    for (int a = 0; a < 2; ++a)
#pragma unroll
        for (int b = 0; b < 2; ++b)
#pragma unroll
            for (int m = 0; m < 4; ++m)
#pragma unroll
                for (int n = 0; n < 2; ++n) acc[a][b][m][n] = (f32x4){0.f, 0.f, 0.f, 0.f};
    bf16x8 At[4][2], B0[2][2], B1[2][2];
    const char* const cA = (const char*)g.A; PG8_SETA(vAc0, vAc1, cur); const char* cB = (const char*)g.Bt + (size_t)cur.pn * tstep;
    if constexpr (SP2) {
        PG8_STAGE(PG8_SB(0, 0), cB, voffB); PG8_STAGE(PG8_SB(0, 1), cB + hstep, voffB); PG8_STAGE(PG8_SA(0, 0), cA, vAc0); PG8_STAGE(PG8_SA(0, 1), cA, vAc1);
        if (wr == 1) PG8_BAR;
        PG8_WAIT_V(2); PG8_BAR;
        PG8_STAGE(PG8_SB(1, 0), cB + kstep, voffB); PG8_STAGE(PG8_SA(1, 0), cA + kstepA, vAc0); PG8_STAGE(PG8_SB(1, 1), cB + hstep + kstep, voffB);
        PG8_WAIT_V(6); PG8_BAR;
    } else {
        PG8_STAGE(PG8_SB(0, 0), cB, voffB); PG8_STAGE(PG8_SA(0, 0), cA, vAc0); PG8_STAGE(PG8_SB(0, 1), cB + hstep, voffB); PG8_STAGE(PG8_SA(0, 1), cA, vAc1);
        if (wr == 1) PG8_BAR;
        PG8_WAIT_V(4); PG8_BAR;
        PG8_STAGE(PG8_SB(1, 0), cB + kstep, voffB); PG8_STAGE(PG8_SA(1, 0), cA + kstepA, vAc0); PG8_STAGE(PG8_SB(1, 1), cB + hstep + kstep, voffB);
        PG8_WAIT_V(6); PG8_BAR;
    }
    for (;;) {
        const bool has_next = S.next(ui + 1, nxt);
        if (has_next) { PG8_SETA(vAn0, vAn1, nxt); } else { vAn0[0] = vAc0[0]; vAn0[1] = vAc0[1]; vAn1[0] = vAc1[0]; vAn1[1] = vAc1[1]; }
        const char* nB = has_next ? (const char*)g.Bt + (size_t)nxt.pn * tstep : cB;
#pragma unroll 1
        for (int t = 0; t < nt; t += 2) {
            const bool last = (t == nt - 2);
            const char* a1 = cA + (size_t)(t + 1) * kstepA;
            const char* a2 = last ? cA : cA + (size_t)(t + 2) * kstepA; unsigned w0[2], w1[2]; w0[0] = last ? vAn0[0] : vAc0[0]; w0[1] = last ? vAn0[1] : vAc0[1]; w1[0] = last ? vAn1[0] : vAc1[0]; w1[1] = last ? vAn1[1] : vAc1[1]; const char* b2 = last ? nB : cB + (size_t)(t + 2) * kstep;
            const char* a3 = a2 + kstepA; const char* b3 = b2 + kstep;
            if constexpr (SP2) {
            PG8_LDB(B0, 0, 0); PG8_LDB(B1, 0, 1); PG8_SCHED; PG8_LDA(At, 0, 0); PG8_STAGE(PG8_SA(1, 1), a1, vAc1);
            PG8_WAIT_V(8); PG8_WAIT_L(0); PG8_BAR; PG8_MMA(0, 0, At, B0); PG8_MMA(0, 1, At, B1); PG8_BAR; PG8_SCHED;
            PG8_LDA(At, 0, 1); PG8_STAGE(PG8_SB(0, 0), b2, voffB); PG8_STAGE(PG8_SB(0, 1), b2 + hstep, voffB); PG8_STAGE(PG8_SA(0, 0), a2, w0);
            PG8_WAIT_V(8); PG8_WAIT_L(0); PG8_BAR; PG8_MMA(1, 0, At, B0); PG8_MMA(1, 1, At, B1); PG8_BAR; PG8_SCHED;
            PG8_LDB(B0, 1, 0); PG8_LDB(B1, 1, 1); PG8_SCHED; PG8_LDA(At, 1, 0); PG8_STAGE(PG8_SA(0, 1), a2, w1);
            PG8_WAIT_V(8); PG8_WAIT_L(0); PG8_BAR; PG8_MMA(0, 0, At, B0); PG8_MMA(0, 1, At, B1); PG8_BAR; PG8_SCHED;
            PG8_LDA(At, 1, 1); PG8_STAGE(PG8_SB(1, 0), b3, voffB); PG8_STAGE(PG8_SB(1, 1), b3 + hstep, voffB); PG8_STAGE(PG8_SA(1, 0), a3, w0);
            PG8_WAIT_V(8); PG8_WAIT_L(0); PG8_BAR; PG8_MMA(1, 0, At, B0); PG8_MMA(1, 1, At, B1); PG8_BAR; PG8_SCHED;
            } else {
            PG8_LDB(B0, 0, 0); PG8_SCHED; PG8_LDA(At, 0, 0); PG8_STAGE(PG8_SA(1, 1), a1, vAc1);
            PG8_WAIT_L(8); PG8_BAR; PG8_WAIT_L(0); PG8_MMA(0, 0, At, B0); PG8_BAR; PG8_SCHED;
            PG8_LDB(B1, 0, 1); PG8_STAGE(PG8_SB(0, 0), b2, voffB);
            PG8_BAR; PG8_WAIT_L(0); PG8_MMA(0, 1, At, B1); PG8_BAR;
            PG8_LDA(At, 0, 1); PG8_STAGE(PG8_SA(0, 0), a2, w0);
            PG8_BAR; PG8_WAIT_L(0); PG8_MMA(1, 0, At, B0); PG8_BAR; PG8_SCHED;
            PG8_STAGE(PG8_SB(0, 1), b2 + hstep, voffB);
            PG8_WAIT_V(6); PG8_BAR; PG8_MMA(1, 1, At, B1); PG8_BAR;
            PG8_LDB(B0, 1, 0); PG8_SCHED; PG8_LDA(At, 1, 0); PG8_STAGE(PG8_SA(0, 1), a2, w1);
            PG8_WAIT_L(8); PG8_BAR; PG8_WAIT_L(0); PG8_MMA(0, 0, At, B0); PG8_BAR; PG8_SCHED;
            PG8_LDB(B1, 1, 1); PG8_STAGE(PG8_SB(1, 0), b3, voffB);
            PG8_BAR; PG8_WAIT_L(0); PG8_MMA(0, 1, At, B1); PG8_BAR;
            PG8_LDA(At, 1, 1); PG8_STAGE(PG8_SA(1, 0), a3, w0);
            PG8_BAR; PG8_WAIT_L(0); PG8_MMA(1, 0, At, B0); PG8_BAR; PG8_SCHED;
            PG8_STAGE(PG8_SB(1, 1), b3 + hstep, voffB);
            PG8_WAIT_V(6); PG8_BAR; PG8_MMA(1, 1, At, B1); PG8_BAR;
            }
        }
        if constexpr (ALIGN_EPI) { if (wr == 0) PG8_BAR; }
        { E(acc, cur, wr, wc, fr, fq); }
        if (!has_next) break;
#pragma unroll
        for (int a = 0; a < 2; ++a)
#pragma unroll
            for (int b = 0; b < 2; ++b)
#pragma unroll
                for (int m = 0; m < 4; ++m)
#pragma unroll
                    for (int n = 0; n < 2; ++n) acc[a][b][m][n] = (f32x4){0.f, 0.f, 0.f, 0.f};
        cur = nxt; cB = nB; ++ui; vAc0[0] = vAn0[0]; vAc0[1] = vAn0[1]; vAc1[0] = vAn1[0]; vAc1[1] = vAn1[1];
        if constexpr (ALIGN_EPI) { if (wr == 1) PG8_BAR; }
    }
    PG8_WAIT_V(0);
    if constexpr (!ALIGN_EPI) { if (wr == 0) PG8_BAR; }
    PG8_BAR;

#undef PG8_SETA
#undef PG8_SA
#undef PG8_SB
#undef PG8_STAGE
#undef PG8_LDA
#undef PG8_LDB
#undef PG8_MMA
#undef PG8_WAIT_V
#undef PG8_WAIT_L
#undef PG8_BAR
#undef PG8_SCHED
}

struct EpiInProj {
    static constexpr bool PERM = true, AFTER_DRAIN = false;
    bf16* PL; const float* lbv;
    __device__ __forceinline__ void operator()(const f32x4 (&acc)[2][2][4][2], const Unit& u, int wr, int wc, int fr, int fq) const {
        const int p = u.pn >> 2; const bool act = (p == 0) || (p == 4), gate = (p == 2) || (p == 3);
        bf16* base = PL + (size_t)p * ((size_t)M_ALL * D);
        const int col0 = (u.pn & 3) * BM + wc * 32 + 8 * fq, row0 = u.pm * BM + wr * 64 + fr;
        f32x4 om[2][2];
#pragma unroll
        for (int bj = 0; bj < 2; ++bj)
#pragma unroll
            for (int n = 0; n < 2; ++n) om[bj][n] = gate ? (1.f - *(const f32x4*)(lbv + (p - 2) * D + col0 + bj * 128 + 4 * n)) : (f32x4){0.f, 0.f, 0.f, 0.f};
#pragma unroll
        for (int ai = 0; ai < 2; ++ai)
#pragma unroll
            for (int m = 0; m < 4; ++m) { bf16* rowp = base + (size_t)(row0 + ai * 128 + m * 16) * D + col0;
#pragma unroll
                for (int bj = 0; bj < 2; ++bj) { f32x4 v0 = acc[ai][bj][m][0], v1 = acc[ai][bj][m][1];
                    if (act) {
#pragma unroll
                        for (int j = 0; j < 4; ++j) { v0[j] = siluf_(v0[j]); v1[j] = siluf_(v1[j]); } }
                    if (gate) {
#pragma unroll
                        for (int j = 0; j < 4; ++j) { v0[j] = om[bj][0][j] * __builtin_amdgcn_rcpf(1.f + __expf(v0[j])); v1[j] = om[bj][1][j] * __builtin_amdgcn_rcpf(1.f + __expf(v1[j])); } }
                    v4u w; w.x = pk2(v0[0], v0[1]); w.y = pk2(v0[2], v0[3]); w.z = pk2(v1[0], v1[1]); w.w = pk2(v1[2], v1[3]);
                    *(v4u*)(rowp + bj * 128) = w; } }
    }
};
struct EpiPoolIn {
    static constexpr bool PERM = true, AFTER_DRAIN = false;
    bf16* O;
    __device__ __forceinline__ void operator()(const f32x4 (&acc)[2][2][4][2], const Unit& u, int wr, int wc, int fr, int fq) const {
        const int slab0 = (u.pn * BM + wc * 32 + 8 * fq) >> 3, row0 = u.pm * BM + wr * 64 + fr;
#pragma unroll
        for (int ai = 0; ai < 2; ++ai)
#pragma unroll
            for (int m = 0; m < 4; ++m) { const int row = row0 + ai * 128 + m * 16, b = row / SEQ, t = row % SEQ;
#pragma unroll
                for (int bj = 0; bj < 2; ++bj) { const f32x4 v0 = acc[ai][bj][m][0], v1 = acc[ai][bj][m][1];
                    v4u w; w.x = pk2(v0[0], v0[1]); w.y = pk2(v0[2], v0[3]); w.z = pk2(v1[0], v1[1]); w.w = pk2(v1[2], v1[3]);
                    *(v4u*)(O + (((size_t)b * 128 + slab0 + bj * 16) * SEQ + t) * 8) = w; } }
    }
};
struct EpiDown {
    static constexpr bool PERM = true, AFTER_DRAIN = false;
    bf16* O;
    __device__ __forceinline__ void operator()(const f32x4 (&acc)[2][2][4][2], const Unit& u, int wr, int wc, int fr, int fq) const {
        const int col0 = (u.pn & 3) * BM + wc * 32 + 8 * fq, row0 = u.pm * BM + wr * 64 + fr;
#pragma unroll
        for (int ai = 0; ai < 2; ++ai)
#pragma unroll
            for (int m = 0; m < 4; ++m) { bf16* rowp = O + (size_t)(row0 + ai * 128 + m * 16) * D + col0;
#pragma unroll
                for (int bj = 0; bj < 2; ++bj) { const f32x4 v0 = acc[ai][bj][m][0], v1 = acc[ai][bj][m][1];
                    v4u w; w.x = pk2(v0[0], v0[1]); w.y = pk2(v0[2], v0[3]); w.z = pk2(v1[0], v1[1]); w.w = pk2(v1[2], v1[3]);
                    *(v4u*)(rowp + bj * 128) = w; } }
    }
};
struct EpiGateUp {
    static constexpr bool PERM = true, AFTER_DRAIN = false;
    bf16* ACT;
    __device__ __forceinline__ void operator()(const f32x4 (&acc)[2][2][4][2], const Unit& u, int wr, int wc, int fr, int fq) const {
        const int col0 = (u.pn & 1) * 128 + wc * 32 + 8 * fq, row0 = u.pm * BM + wr * 64 + fr;
#pragma unroll
        for (int ai = 0; ai < 2; ++ai)
#pragma unroll
            for (int m = 0; m < 4; ++m) { bf16* rowp = ACT + (size_t)(row0 + ai * 128 + m * 16) * DE + col0;
                f32x4 v0, v1;
#pragma unroll
                for (int j = 0; j < 4; ++j) { v0[j] = siluf_(acc[ai][0][m][0][j]) * acc[ai][1][m][0][j]; v1[j] = siluf_(acc[ai][0][m][1][j]) * acc[ai][1][m][1][j]; }
                v4u w; w.x = pk2(v0[0], v0[1]); w.y = pk2(v0[2], v0[3]); w.z = pk2(v1[0], v1[1]); w.w = pk2(v1[2], v1[3]);
                *(v4u*)rowp = w; }
    }
};
struct EpiGrp {
    static constexpr bool PERM = true, AFTER_DRAIN = false;
    bf16* O; const float* ps;
    __device__ __forceinline__ void operator()(const f32x4 (&acc)[2][2][4][2], const Unit& u, int wr, int wc, int fr, int fq) const {
        const int col0 = u.pn * BM + wc * 32 + 8 * fq, row0 = (u.pm & 63) * BM + wr * 64 + fr;
#pragma unroll
        for (int bj = 0; bj < 2; ++bj) {
            const f32x4 s0 = *(const f32x4*)(ps + col0 + bj * 128), s1 = *(const f32x4*)(ps + col0 + bj * 128 + 4);
#pragma unroll
            for (int ai = 0; ai < 2; ++ai)
#pragma unroll
                for (int m = 0; m < 4; ++m) { bf16* rowp = O + (size_t)(row0 + ai * 128 + m * 16) * D + col0 + bj * 128;
                    const f32x4 v0 = acc[ai][bj][m][0] * s0, v1 = acc[ai][bj][m][1] * s1;
                    v4u w; w.x = pk2(v0[0], v0[1]); w.y = pk2(v0[2], v0[3]); w.z = pk2(v1[0], v1[1]); w.w = pk2(v1[2], v1[3]);
                    *(v4u*)rowp = w; }
        }
    }
};
template <bool XF32> struct EpiResid {
    static constexpr bool PERM = true, AFTER_DRAIN = false;
    const void* xin; bf16* out; const float* gate;
    __device__ __forceinline__ void operator()(const f32x4 (&acc)[2][2][4][2], const Unit& u, int wr, int wc, int fr, int fq) const {
        const int col0 = u.pn * BM + wc * 32 + 8 * fq, row0 = u.pm * BM + wr * 64 + fr;
        const float* gp = gate + (size_t)(row0 / SEQ) * 6144 + col0;
        f32x4 gv[2][2];
#pragma unroll
        for (int bj = 0; bj < 2; ++bj) { gv[bj][0] = *(const f32x4*)(gp + bj * 128); gv[bj][1] = *(const f32x4*)(gp + bj * 128 + 4); }
#pragma unroll
        for (int ai = 0; ai < 2; ++ai)
#pragma unroll
            for (int m = 0; m < 4; ++m) { const size_t ro = (size_t)(row0 + ai * 128 + m * 16) * D + col0;
#pragma unroll
                for (int bj = 0; bj < 2; ++bj) { f32x4 x0, x1;
                    if (XF32) { x0 = *(const f32x4*)((const float*)xin + ro + bj * 128); x1 = *(const f32x4*)((const float*)xin + ro + bj * 128 + 4); }
                    else { const v4u w = *(const v4u*)((const bf16*)xin + ro + bj * 128); x0 = (f32x4){bflo(w.x), bfhi(w.x), bflo(w.y), bfhi(w.y)}; x1 = (f32x4){bflo(w.z), bfhi(w.z), bflo(w.w), bfhi(w.w)}; }
                    const f32x4 y0 = x0 + gv[bj][0] * acc[ai][bj][m][0], y1 = x1 + gv[bj][1] * acc[ai][bj][m][1];
                    v4u o; o.x = pk2(y0[0], y0[1]); o.y = pk2(y0[2], y0[3]); o.z = pk2(y1[0], y1[1]); o.w = pk2(y1[2], y1[3]);
                    *(v4u*)(out + ro + bj * 128) = o; } }
    }
};
static_assert(!CTX_FULL, "the bf16 residual path covers latent rows only");

struct Frame {
    LAS unsigned char* lds; volatile LAS unsigned* MISC; gu32* ctl;
    int tid, lane, wave, G, bid;
    const float* in[23]; float* out; unsigned char* ws;
};
__device__ __forceinline__ const float* modv(const Frame& F, int l, int b, int j) { return (const float*)(F.ws + WS_MODV) + ((size_t)l * 5 + b) * 6144 + j * 1024; }

__device__ __forceinline__ void transpose_item(const float* W, int N, int k0, int n0, bf16* WT, int KT, size_t dst_row0, LAS float* scr, int lane) {
    { const int kr = lane >> 3, ch = lane & 7; f32x4 v[8];
#pragma unroll
      for (int i = 0; i < 8; ++i) v[i] = *(const f32x4*)(W + (size_t)(k0 + 8 * i + kr) * N + n0 + 4 * ch);
#pragma unroll
      for (int i = 0; i < 8; ++i) { LAS float* d = scr + (8 * i + kr) * 33 + 4 * ch; d[0] = v[i].x; d[1] = v[i].y; d[2] = v[i].z; d[3] = v[i].w; } }
    LDS_WAIT(); asm volatile("" ::: "memory");
    const int c = lane & 7;
#pragma unroll
    for (int j = 0; j < 4; ++j) { const int n = (lane >> 3) + 8 * j; const LAS float* s = scr + (8 * c) * 33 + n;
        v4u o; o.x = pk2(s[0 * 33], s[1 * 33]); o.y = pk2(s[2 * 33], s[3 * 33]); o.z = pk2(s[4 * 33], s[5 * 33]); o.w = pk2(s[6 * 33], s[7 * 33]);
        *(v4u*)(WT + (dst_row0 + n) * KT + k0 + 8 * c) = o; }
    LDS_WAIT(); asm volatile("" ::: "memory");
}
__device__ __forceinline__ void conv_moe_item(const Frame& F, int l, int r, bf16* WGU, bf16* WD, LAS float* scr) {
    const int kind = r >> 11, rr = r & 2047, e = rr >> 7, it = rr & 127;
    if (kind < 2) { const float* W = (kind ? F.in[20] : F.in[19]) + (size_t)(l * NE + e) * D * DE; const int kb = it >> 3, nb = it & 7, n0 = 32 * nb;
        transpose_item(W, DE, 64 * kb, n0, WGU, D, (size_t)e * 512 + (n0 >> 7) * 256 + kind * 128 + (n0 & 127), scr, F.lane); }
    else { const float* W = F.in[21] + (size_t)(l * NE + e) * DE * D; const int kb = it >> 5, nb = it & 31;
        transpose_item(W, D, 64 * kb, 32 * nb, WD, DE, (size_t)e * D + 32 * nb, scr, F.lane); }
}

__device__ __forceinline__ void conv_moe_queue(Frame& F, int l, bf16* WGU, bf16* WD) {
    LAS float* scr = (LAS float*)(F.lds + F.wave * 16384);
    unsigned* q = (unsigned*)(F.ctl + CW_Q + 64 * l);
    for (;;) {
        unsigned base = 0;
        if (F.lane == 0) base = atomicAdd(q, 8u);
        base = (unsigned)__builtin_amdgcn_readfirstlane((int)base);
        if (base >= 6144u) break;
        for (int r = (int)base; r < (int)base + 8; ++r) conv_moe_item(F, l, r, WGU, WD, scr);
    }
}
__device__ __forceinline__ void p0_prep(Frame& F) {
    if (F.bid < 192) {
        LAS float* sil = (LAS float*)(F.lds);
        LAS float* red = (LAS float*)(F.lds + 32768);
        for (int i = F.tid; i < 5 * D; i += NTHR) { const float cv = (i < 4 * D) ? F.in[1][i] : F.in[3][i - 4 * D]; sil[i] = siluf_(cv); }
        __syncthreads();
        const int l = F.bid / 96, col0 = (F.bid % 96) * 64;
        const float* W = F.in[4] + (size_t)l * D * 6144 + col0 + F.lane;
        float a0 = 0.f, a1 = 0.f, a2 = 0.f, a3 = 0.f, a4 = 0.f;
        const int kbeg = F.wave * 128;
#pragma unroll 8
        for (int k = kbeg; k < kbeg + 128; ++k) { const float w = W[(size_t)k * 6144];
            a0 += sil[k] * w; a1 += sil[D + k] * w; a2 += sil[2 * D + k] * w; a3 += sil[3 * D + k] * w; a4 += sil[4 * D + k] * w; }
        red[(F.wave * 5 + 0) * 64 + F.lane] = a0; red[(F.wave * 5 + 1) * 64 + F.lane] = a1; red[(F.wave * 5 + 2) * 64 + F.lane] = a2;
        red[(F.wave * 5 + 3) * 64 + F.lane] = a3; red[(F.wave * 5 + 4) * 64 + F.lane] = a4;
        __syncthreads();
        if (F.tid < 320) { const int b = F.tid >> 6, cc = F.tid & 63; float s = 0.f;
#pragma unroll
            for (int w = 0; w < 8; ++w) s += red[(w * 5 + b) * 64 + cc];
            ((float*)(F.ws + WS_MODV))[((size_t)l * 5 + b) * 6144 + col0 + cc] = s + F.in[5][l * 6144 + col0 + cc]; }
        __syncthreads();
    }
    if (F.bid == 192) for (int i = F.tid; i < 2 * D; i += NTHR) { const float* lb = (i < D) ? F.in[9] : F.in[10]; const int c = i & (D - 1);
        ((float*)(F.ws + WS_LBV))[i] = sigmoidf_(lb[c] - lb[D + c]); }
    LAS float* scr = (LAS float*)(F.lds + F.wave * 16384);
    const int gw = F.bid * NWAVES + F.wave, NGW = F.G * NWAVES;
    constexpr int I_IN = 16 * 160, I_OUT = 16 * 32;
    for (int it = gw; it < I_IN + I_OUT; it += NGW) {
        int r = it;
        if (r < I_IN) { const int kb = r / 160, nb = r % 160; transpose_item(F.in[8], NPROJ * D, 64 * kb, 32 * nb, (bf16*)(F.ws + WS_WHGIN), D, (size_t)32 * nb, scr, F.lane); continue; } r -= I_IN;
        { const int kb = r >> 5, nb = r & 31; transpose_item(F.in[12], D, 64 * kb, 32 * nb, (bf16*)(F.ws + WS_WHGOUT), D, (size_t)32 * nb, scr, F.lane); }
    }
}
__device__ __forceinline__ void fold_pool_weights(Frame& F) {
    const int g = (F.bid >> 6) & 3, n0 = (F.bid & 63) * 16;
    LAS float* WS = (LAS float*)F.lds;
    const float* Wout = F.in[16]; const float* ps = F.in[15]; const float* Wg = F.in[14] + (size_t)g * 256 * 256;
    for (int idx = F.tid; idx < 256 * 4; idx += NTHR) { const int j = idx >> 2, c4 = (idx & 3) * 4;
        const f32x4 v = *(const f32x4*)(Wout + (size_t)(256 * g + j) * D + n0 + c4) * ps[256 * g + j];
        *(LAS f32x4*)(WS + j * 20 + c4) = v; }
    __syncthreads();
    const int i = F.tid >> 1, nh = (F.tid & 1) * 8;
    f32x4 acc0 = {0.f, 0.f, 0.f, 0.f}, acc1 = acc0;
    const float* wr = Wg + (size_t)i * 256;
#pragma unroll 4
    for (int j4 = 0; j4 < 256; j4 += 4) { const f32x4 a = *(const f32x4*)(wr + j4);
#pragma unroll
        for (int jj = 0; jj < 4; ++jj) { const LAS f32x4* wp = (const LAS f32x4*)(WS + (j4 + jj) * 20 + nh); acc0 += wp[0] * a[jj]; acc1 += wp[1] * a[jj]; } }
    bf16* WPT = (bf16*)(F.ws + WS_WPOUT);
#pragma unroll
    for (int q = 0; q < 4; ++q) { WPT[(size_t)(n0 + nh + q) * D + 256 * g + i] = (bf16)f2bf(acc0[q]); WPT[(size_t)(n0 + nh + 4 + q) * D + 256 * g + i] = (bf16)f2bf(acc1[q]); }
    __syncthreads();
}
__device__ __forceinline__ void conv_layer1(Frame& F) {
    LAS float* scr = (LAS float*)(F.lds + F.wave * 16384);
    const int gw = F.bid * NWAVES + F.wave, NGW = F.G * NWAVES;
    constexpr int I_SQ = 16 * 32;
    for (int it = gw; it < I_SQ; it += NGW) {
        int r = it;
        { const int kb = r >> 5, nb = r & 31; transpose_item(F.in[13], D, 64 * kb, 32 * nb, (bf16*)(F.ws + WS_WPIN), D, (size_t)32 * nb, scr, F.lane); }
    }
    for (int it = gw; it < 6144; it += NGW) conv_moe_item(F, 1, it, (bf16*)(F.ws + WS_WGU1), (bf16*)(F.ws + WS_WD1), scr);
}

__device__ __forceinline__ void load_row_bf16(const bf16* xr, int lane, f32x4 (&v)[4]) {
#pragma unroll
    for (int j = 0; j < 4; ++j) { const v2u a = ((const v2u*)xr)[lane + 64 * j]; v[j] = (f32x4){bflo(a.x), bfhi(a.x), bflo(a.y), bfhi(a.y)}; }
}
__device__ __forceinline__ void store_row_bf16(bf16* xr, int lane, const f32x4 (&v)[4]) {
#pragma unroll
    for (int j = 0; j < 4; ++j) ((v2u*)xr)[lane + 64 * j] = (v2u){pk2(v[j].x, v[j].y), pk2(v[j].z, v[j].w)};
}
__device__ __forceinline__ void modulate_row(const f32x4 (&v)[4], const float* g, const float* sh, const float* sc, bf16* orow, int lane) {
    float s2 = 0.f;
#pragma unroll
    for (int j = 0; j < 4; ++j) s2 += (v[j].x * v[j].x + v[j].y * v[j].y) + (v[j].z * v[j].z + v[j].w * v[j].w);
    const float rstd = 1.f / sqrtf(wave_sum(s2) * (1.f / D) + EPS);
    unsigned long long* o8 = (unsigned long long*)orow + lane;
#pragma unroll
    for (int j = 0; j < 4; ++j) { const int c = 4 * lane + 256 * j;
        const f32x4 gv = *(const f32x4*)(g + c), shv = *(const f32x4*)(sh + c), scv = *(const f32x4*)(sc + c);
        const f32x4 h = v[j] * rstd * gv * (scv + 1.f) + shv;
        o8[64 * j] = (unsigned long long)pk2(h.x, h.y) | ((unsigned long long)pk2(h.z, h.w) << 32); }
}
__device__ __forceinline__ void p1_modulate0(Frame& F) {
    const int gw = F.bid * NWAVES + F.wave, NGW = F.G * NWAVES;
    bf16* H = (bf16*)(F.ws + WS_H);
    for (int row = gw; row < M_ALL; row += NGW) {
        const bool isctx = row >= M_LAT; const int b = isctx ? 4 : row / SEQ;
        const float* xr = isctx ? F.in[2] + (size_t)(row - M_LAT) * D : F.in[0] + (size_t)row * D;
        f32x4 v[4];
#pragma unroll
        for (int j = 0; j < 4; ++j) v[j] = ((const f32x4*)xr)[F.lane + 64 * j];
        modulate_row(v, F.in[6], modv(F, 0, b, 0), modv(F, 0, b, 1), H + (size_t)row * D, F.lane);
    }
}

__device__ __forceinline__ void p3_scan_naive(Frame& F) {
    if (F.bid >= 64) return;
    const int b = F.bid >> 4, h = (F.bid >> 1) & 7, dir = F.bid & 1;
    const bf16* PQ = (const bf16*)(F.ws + WS_PL), *PV = PQ + (size_t)M_ALL * D, *PZ = PQ + (size_t)(2 + dir) * M_ALL * D;
    bf16* OL = (bf16*)F.out + (size_t)dir * M_LAT * D; bf16* OC = (bf16*)(F.ws + (dir ? WS_OBC : WS_OFC));
    LAS float* fl = (LAS float*)F.lds, *kl = fl + 128, *ql = fl + 256, *ored = fl + 384;
    const int v = F.tid & 127, kq = F.tid >> 7;
    float lbv = 0.f;
    if (F.tid < 128) { const float* lb = dir ? F.in[10] : F.in[9]; lbv = sigmoidf_(lb[h * DH + F.tid] - lb[D + h * DH + F.tid]); }
    float S[32];
#pragma unroll
    for (int j = 0; j < 32; ++j) S[j] = 0.f;
    for (int s = 0; s < CTXL + SEQ; ++s) {
        int row;
        if (s < CTXL) row = M_LAT + b * CTXL + (dir ? CTXL - 1 - s : s);
        else row = b * SEQ + (dir ? SEQ - 1 - (s - CTXL) : s - CTXL);
        const size_t off = (size_t)row * D + h * DH;
        if (F.tid < 128) { const float kk = bf2f(PZ[off + F.tid]);
            fl[F.tid] = 1.f - kk; kl[F.tid] = kk; ql[F.tid] = bf2f(PQ[off + F.tid]); }
        const float vv = bf2f(PV[off + v]);
        __syncthreads();
        float po = 0.f;
#pragma unroll
        for (int j = 0; j < 32; ++j) { const int k = 32 * kq + j; S[j] = fl[k] * S[j] + kl[k] * vv; po += S[j] * ql[k]; }
        ored[kq * 128 + v] = po;
        __syncthreads();
        if (kq == 0) { const float o = (ored[v] + ored[128 + v]) + (ored[256 + v] + ored[384 + v]);
            if (s >= CTXL) OL[(size_t)row * D + h * DH + v] = (bf16)f2bf(o);
            else if (CTX_FULL) OC[(size_t)(row - M_LAT) * D + h * DH + v] = (bf16)f2bf(o); }
    }
}

typedef float f32x16 __attribute__((ext_vector_type(16)));
__device__ __forceinline__ void lds_fadd(LAS float* p, float v) { (void)__hip_atomic_fetch_add(p, v, __ATOMIC_RELAXED, __HIP_MEMORY_SCOPE_WORKGROUP); }
typedef float f32x2 __attribute__((ext_vector_type(2)));
#define MFMA32(a, b, c) __builtin_amdgcn_mfma_f32_32x32x16_bf16((a), (b), (c), 0, 0, 0)
__device__ __forceinline__ int crow(int reg, int h) { return (reg & 3) + 8 * (reg >> 2) + 4 * h; }
__device__ __forceinline__ int t256_off(int row, int cb) { return row * 256 + ((((cb >> 4) ^ (row & 15)) << 4) | (cb & 15)); }
__device__ __forceinline__ int t128_off(int row, int cb) { return row * 128 + ((((cb >> 4) ^ ((row >> 1) & 7)) << 4) | (cb & 15)); }
__device__ __forceinline__ bf16x8 pack8(const f32x16& x, int s) {
    v4u p; p.x = pk2(x[8 * s], x[8 * s + 1]); p.y = pk2(x[8 * s + 2], x[8 * s + 3]); p.z = pk2(x[8 * s + 4], x[8 * s + 5]); p.w = pk2(x[8 * s + 6], x[8 * s + 7]);
    return __builtin_bit_cast(bf16x8, p);
}
template <bool STATE  >
__device__ __forceinline__ void scan_items(Frame& F) {
    constexpr int SC_QE = 0, SC_QC = 16384, SC_KR = 32768, SC_KRT = 49152, SC_VT = 65536, SC_ST = 69632, SC_TOT = 77824, SC_VEC = 81920, SC_SLOT = 83968, SC_ST2 = 124928;
    static_assert(SC_ST2 + 8192 <= RING_BYTES, "scan LDS map");
    constexpr int NCH = (CTXL + SEQ) / 64;
    LAS unsigned char* L = F.lds;
    const int tid = F.tid, lane = F.lane, w = F.wave, r = lane & 31, hh = lane >> 5;
    const bf16* PQ = (const bf16*)(F.ws + WS_PL); const bf16* PV = PQ + (size_t)M_ALL * D;
    f32x16 zero16;
#pragma unroll
    for (int i = 0; i < 16; ++i) zero16[i] = 0.f;
    for (int item = F.bid; item < 256; item += F.G) {
        const int dvs = (item >> 3) & 3, bhd = (item >> 5) * 8 + (item & 7), b = bhd >> 4, h = (bhd >> 1) & 7, dir = bhd & 1;
        const bf16* PZ = PQ + (size_t)(2 + dir) * M_ALL * D;
        const int c0 = 2 * lane, colq = h * DH + c0, colv = h * DH + dvs * 32;
        bf16* OL = (bf16*)F.out + (size_t)dir * M_LAT * D; bf16* OC = (bf16*)(F.ws + (dir ? WS_OBC : WS_OFC));
        const int sgn = dir ? -1 : 1;
        __syncthreads();
        for (int i = tid; i < 8192 / 16; i += NTHR) ((LAS v4u*)(L + SC_ST))[i] = (v4u){0u, 0u, 0u, 0u};
        f32x16 S0 = zero16, S1 = zero16;
        unsigned zr[8], qr[8]; v4u vr = {0u, 0u, 0u, 0u};
#define SCAN_BASE(n) (((n) < 4) ? (M_LAT + b * CTXL + (dir ? CTXL - 1 - 64 * (n) : 64 * (n))) : (b * SEQ + (dir ? SEQ - 1 - 64 * ((n) - 4) : 64 * ((n) - 4))))
#define SCAN_LOAD(n) do { const int _base = SCAN_BASE(n); \
            _Pragma("unroll") for (int _i = 0; _i < 8; ++_i) { const size_t _o = (size_t)(_base + sgn * (8 * w + _i)) * D + colq; zr[_i] = *(const unsigned*)(PZ + _o); qr[_i] = *(const unsigned*)(PQ + _o); } \
            if (tid < 256) vr = *(const v4u*)(PV + (size_t)(_base + sgn * (tid >> 2)) * D + colv + 8 * (tid & 3)); } while (0)
#define SCAN_C(m) do { const LAS unsigned char* sl_ = L + SC_SLOT + ((m) & 1) * 20480; const int base_ = SCAN_BASE(m); \
            _Pragma("unroll") for (int q_ = 0; q_ < 8; ++q_) { const int t_ = lane + 64 * q_, c_ = t_ >> 3, v0_ = (t_ & 7) * 4, so_ = ((c_ & 31) * 32 + v0_) * 4; f32x4 o_; \
                if (c_ < 32) o_ = *(const LAS f32x4*)(sl_ + so_) + *(const LAS f32x4*)(sl_ + 3 * 4096 + so_); \
                else o_ = *(const LAS f32x4*)(sl_ + 4096 + so_) + *(const LAS f32x4*)(sl_ + 2 * 4096 + so_) + *(const LAS f32x4*)(sl_ + 4 * 4096 + so_); \
                const int row_ = base_ + sgn * c_; const v2u ov_ = {pk2(o_.x, o_.y), pk2(o_.z, o_.w)}; \
                if ((m) >= 4) *(v2u*)(OL + (size_t)row_ * D + colv + v0_) = ov_; \
                else if (CTX_FULL) *(v2u*)(OC + (size_t)(row_ - M_LAT) * D + colv + v0_) = ov_; } } while (0)
        SCAN_LOAD(0);
        for (int n = 0; n < NCH; ++n) {
            float f0[8], f1[8];
            float pr0 = 1.f, pr1 = 1.f;
#pragma unroll
            for (int i = 0; i < 8; ++i) { f0[i] = 1.f - bflo(zr[i]); f1[i] = 1.f - bfhi(zr[i]); pr0 *= f0[i]; pr1 *= f1[i]; }
            *(LAS f32x2*)(L + SC_TOT + (w * 128 + c0) * 4) = (f32x2){__logf(pr0), __logf(pr1)};
            __syncthreads();
            if (tid < 256) { const int p = tid >> 2, c8 = tid & 3;
#pragma unroll
                for (int j = 0; j < 8; ++j) { const unsigned hv = (vr[j >> 1] >> (16 * (j & 1))) & 0xffffu; *(LAS unsigned short*)(L + SC_VT + t128_off(8 * c8 + j, 2 * p)) = (unsigned short)hv; } }
            float off0 = 0.f, off1 = 0.f, ref0 = 0.f, ref1 = 0.f, last0 = 0.f, last1 = 0.f;
#pragma unroll
            for (int ww = 0; ww < 8; ++ww) { const f32x2 t2 = *(const LAS f32x2*)(L + SC_TOT + (ww * 128 + c0) * 4); const float t0 = t2.x, t1 = t2.y;
                off0 += (ww < w) ? t0 : 0.f; off1 += (ww < w) ? t1 : 0.f; if (ww < 4) { ref0 += t0; ref1 += t1; } last0 += t0; last1 += t1; }
            float E0 = __expf(off0 - ref0), E1 = __expf(off1 - ref1);
            const float er0 = __expf(ref0), er1 = __expf(ref1);
            unsigned krp0[4], krp1[4];
#pragma unroll
            for (int i = 0; i < 8; i += 2) {
                float kra[2], krb[2];
#pragma unroll
                for (int u = 0; u < 2; ++u) { const int ii = i + u, srow = 8 * w + ii;
                    E0 *= f0[ii]; E1 *= f1[ii];
                    const float R0 = __builtin_amdgcn_rcpf(E0), R1 = __builtin_amdgcn_rcpf(E1);
                    const float q0 = bflo(qr[ii]), q1 = bfhi(qr[ii]);
                    kra[u] = (1.f - f0[ii]) * R0; krb[u] = (1.f - f1[ii]) * R1;
                    *(LAS unsigned*)(L + SC_QE + t256_off(srow, 2 * c0)) = pk2(q0 * E0, q1 * E1);
                    *(LAS unsigned*)(L + SC_QC + t256_off(srow, 2 * c0)) = pk2(q0 * E0 * er0, q1 * E1 * er1);
                    *(LAS unsigned*)(L + SC_KR + t256_off(srow, 2 * c0)) = pk2(kra[u], krb[u]); }
                krp0[i >> 1] = pk2(kra[0], kra[1]); krp1[i >> 1] = pk2(krb[0], krb[1]);
            }
            *(LAS v4u*)(L + SC_KRT + t128_off(c0, 16 * w)) = (v4u){krp0[0], krp0[1], krp0[2], krp0[3]};
            *(LAS v4u*)(L + SC_KRT + t128_off(c0 + 1, 16 * w)) = (v4u){krp1[0], krp1[1], krp1[2], krp1[3]};
            if (w == 0) { *(LAS f32x2*)(L + SC_VEC + c0 * 4) = (f32x2){__expf(last0), __expf(last1)};
                *(LAS f32x2*)(L + SC_VEC + 512 + c0 * 4) = (f32x2){__expf(last0 - ref0), __expf(last1 - ref1)}; }
            if (n + 1 < NCH) SCAN_LOAD(n + 1);
            __syncthreads();
            LAS unsigned char* SLW = L + SC_SLOT + (n & 1) * 20480; const LAS unsigned char* STR = L + ((n & 1) ? SC_ST2 : SC_ST); LAS unsigned char* STW = L + ((n & 1) ? SC_ST : SC_ST2);
            if (!STATE && w < 3) {
                const int sb = (w == 2) ? 1 : 0, cb = (w == 0) ? 0 : 1;
                f32x16 x = zero16;
#pragma unroll
                for (int ks = 0; ks < 8; ++ks) { const int cbyte = (16 * ks + 8 * hh) * 2;
                    const bf16x8 a = *(const LAS bf16x8*)(L + SC_KR + t256_off(32 * sb + r, cbyte)), bq = *(const LAS bf16x8*)(L + SC_QE + t256_off(32 * cb + r, cbyte));
                    x = MFMA32(a, bq, x); }
                if (sb == cb) {
#pragma unroll
                    for (int g = 0; g < 16; ++g) x[g] = (crow(g, hh) > r) ? 0.f : x[g]; }
                f32x16 o = zero16;
#pragma unroll
                for (int sp = 0; sp < 2; ++sp) { const bf16x8 pa = pack8(x, sp); const int s0 = 32 * sb + 16 * sp + 4 * hh;
                    const v2u lo = *(const LAS v2u*)(L + SC_VT + t128_off(r, 2 * s0)), hi = *(const LAS v2u*)(L + SC_VT + t128_off(r, 2 * (s0 + 8)));
                    const bf16x8 vb = __builtin_bit_cast(bf16x8, ((v4u){lo.x, lo.y, hi.x, hi.y}));
                    o = MFMA32(pa, vb, o); }
#pragma unroll
                for (int g = 0; g < 16; ++g) *(LAS float*)(SLW + w * 4096 + (crow(g, hh) * 32 + r) * 4) = o[g];
            } else if (!STATE && w < 5) {
                const int cb = w - 3; f32x16 o = zero16;
#pragma unroll
                for (int ks = 0; ks < 8; ++ks) { const int cbyte = (16 * ks + 8 * hh) * 2;
                    const bf16x8 a = *(const LAS bf16x8*)(L + SC_QC + t256_off(32 * cb + r, cbyte)), bs = *(const LAS bf16x8*)(STR + t256_off(r, cbyte));
                    o = MFMA32(a, bs, o); }
#pragma unroll
                for (int g = 0; g < 16; ++g) *(LAS float*)(SLW + w * 4096 + (crow(g, hh) * 32 + r) * 4) = o[g];
            } else if (STATE) {
#define SCAN_KV(ST_, kb_) do { f32x16 kv = zero16; \
                    _Pragma("unroll") for (int ks = 0; ks < 4; ++ks) { const int sbyte = (16 * ks + 8 * hh) * 2; \
                        const bf16x8 a = *(const LAS bf16x8*)(L + SC_KRT + t128_off(32 * (kb_) + r, sbyte)), bv = *(const LAS bf16x8*)(L + SC_VT + t128_off(r, sbyte)); \
                        kv = MFMA32(a, bv, kv); } \
                    _Pragma("unroll") for (int g4 = 0; g4 < 4; ++g4) { const int kk = (32 * (kb_) + 8 * g4 + 4 * hh) * 4; \
                        const f32x4 el = *(const LAS f32x4*)(L + SC_VEC + kk), elr = *(const LAS f32x4*)(L + SC_VEC + 512 + kk); \
                        _Pragma("unroll") for (int j = 0; j < 4; ++j) ST_[4 * g4 + j] = el[j] * ST_[4 * g4 + j] + elr[j] * kv[4 * g4 + j]; } } while (0)
                const int kb0 = 2 * (w - 5);
                SCAN_KV(S0, kb0); SCAN_KV(S1, kb0 + 1);
#pragma unroll
                for (int g = 0; g < 4; ++g) {
                    *(LAS v2u*)(STW + t256_off(r, 2 * (32 * kb0 + 8 * g + 4 * hh))) = (v2u){pk2(S0[4 * g], S0[4 * g + 1]), pk2(S0[4 * g + 2], S0[4 * g + 3])};
                    *(LAS v2u*)(STW + t256_off(r, 2 * (32 * (kb0 + 1) + 8 * g + 4 * hh))) = (v2u){pk2(S1[4 * g], S1[4 * g + 1]), pk2(S1[4 * g + 2], S1[4 * g + 3])}; }
            } else if (!STATE && n > 0) { SCAN_C(n - 1); }
        }
#undef SCAN_KV
        __syncthreads();
        if (!STATE && w == 7) SCAN_C(NCH - 1);
#undef SCAN_C
#undef SCAN_LOAD
#undef SCAN_BASE
    }
}

__device__ __forceinline__ void p3_scan(Frame& F) {
    if (F.wave == 5 || F.wave == 6) scan_items<true>(F); else scan_items<false>(F);
}
__device__ __forceinline__ void p4_readout_prep(Frame& F) {
    const int gw = F.bid * NWAVES + F.wave, NGW = F.G * NWAVES;
    const bf16* SG = (const bf16*)(F.ws + WS_PL) + (size_t)4 * M_ALL * D; bf16* YP = (bf16*)(F.ws + WS_H);
    const int nrows = CTX_FULL ? M_ALL : M_LAT;
    for (int row = gw; row < nrows; row += NGW) {
        const bf16 *ofp, *obp;
        if (row < M_LAT) { ofp = (const bf16*)F.out + (size_t)row * D; obp = ofp + (size_t)M_LAT * D; }
        else { ofp = (const bf16*)(F.ws + WS_OFC) + (size_t)(row - M_LAT) * D; obp = (const bf16*)(F.ws + WS_OBC) + (size_t)(row - M_LAT) * D; }
        const int c0 = 16 * F.lane;
        const v4u f0 = *(const v4u*)(ofp + c0), f1 = *(const v4u*)(ofp + c0 + 8), b0 = *(const v4u*)(obp + c0), b1 = *(const v4u*)(obp + c0 + 8);
        const v4u g0 = *(const v4u*)(SG + (size_t)row * D + c0), g1 = *(const v4u*)(SG + (size_t)row * D + c0 + 8);
        float o[16]; float ss = 0.f;
#pragma unroll
        for (int q = 0; q < 4; ++q) { o[2 * q] = bflo(f0[q]) + bflo(b0[q]); o[2 * q + 1] = bfhi(f0[q]) + bfhi(b0[q]); o[8 + 2 * q] = bflo(f1[q]) + bflo(b1[q]); o[8 + 2 * q + 1] = bfhi(f1[q]) + bfhi(b1[q]); }
#pragma unroll
        for (int j = 0; j < 16; ++j) ss += o[j] * o[j];
        ss += __shfl_xor(ss, 1); ss += __shfl_xor(ss, 2); ss += __shfl_xor(ss, 4);
        const float rstd = 1.f / sqrtf(ss * (1.f / DH) + EPS);
        const float* gn = F.in[11] + (c0 & 127);
        float y[16];
#pragma unroll
        for (int q = 0; q < 4; ++q) { y[2 * q] = o[2 * q] * rstd * gn[2 * q] * bflo(g0[q]); y[2 * q + 1] = o[2 * q + 1] * rstd * gn[2 * q + 1] * bfhi(g0[q]);
            y[8 + 2 * q] = o[8 + 2 * q] * rstd * gn[8 + 2 * q] * bflo(g1[q]); y[8 + 2 * q + 1] = o[8 + 2 * q + 1] * rstd * gn[8 + 2 * q + 1] * bfhi(g1[q]); }
        v4u w0, w1;
#pragma unroll
        for (int q = 0; q < 4; ++q) { w0[q] = pk2(y[2 * q], y[2 * q + 1]); w1[q] = pk2(y[8 + 2 * q], y[8 + 2 * q + 1]); }
        *(v4u*)(YP + (size_t)row * D + c0) = w0; *(v4u*)(YP + (size_t)row * D + c0 + 8) = w1;
    }
    fold_pool_weights(F);
    conv_layer1(F);
}

__device__ __forceinline__ void top2_of4(float a0, float a1, float a2, float a3, int& i1, int& i2, float& sum) {
    i1 = 0; float v1 = a0;
    if (a1 > v1) { v1 = a1; i1 = 1; }
    if (a2 > v1) { v1 = a2; i1 = 2; }
    if (a3 > v1) { v1 = a3; i1 = 3; }
    const float c0 = (i1 == 0) ? -1e30f : a0, c1 = (i1 == 1) ? -1e30f : a1, c2 = (i1 == 2) ? -1e30f : a2, c3 = (i1 == 3) ? -1e30f : a3;
    i2 = 0; float v2 = c0;
    if (c1 > v2) { v2 = c1; i2 = 1; }
    if (c2 > v2) { v2 = c2; i2 = 2; }
    if (c3 > v2) { v2 = c3; i2 = 3; }
    sum = v1 + v2;
}
__device__ __forceinline__ int rt_swz(int row, int k) { return row * D + ((((k >> 2) ^ row) << 2) | (k & 3)); }
__device__ __forceinline__ void p_route(Frame& F, int l, int bank) {
    LAS float* RWT = (LAS float*)F.lds;
    LAS float* HL = RWT + NE * D;
    LAS float* PART = (LAS float*)(F.lds + LDSCTL_OFF + 1024);
    LAS float* SG = PART + 8 * 256;
    LAS unsigned* lcnt = (LAS unsigned*)(SG + 256);
    const int tid = F.tid, lane = F.lane, w = F.wave;
    for (int i = tid; i < D * NE; i += NTHR) { const int k = i >> 4, e = i & 15; RWT[rt_swz(e, k)] = F.in[17][i]; }
    if (tid < 32) lcnt[tid] = 0u;
    const int nrows = (l == 0 && CTX_FULL) ? M_ALL : M_LAT, ngroups = nrows / 16;
    const float* g = F.in[7] + l * D;
    f32x4 xv[2][4];
#define RT_LOAD(grp) do { _Pragma("unroll") for (int rr = 0; rr < 2; ++rr) { const int row = (grp) * 16 + 2 * w + rr; \
        load_row_bf16((const bf16*)(F.ws + WS_XL) + (size_t)row * D, lane, xv[rr]); } } while (0)
    const int gpb = (ngroups + F.G - 1) / F.G, grp0 = F.bid * gpb, grp1 = (grp0 + gpb < ngroups) ? grp0 + gpb : ngroups;
    if (grp0 < grp1) RT_LOAD(grp0);
    int it = 0;
    for (int grp = grp0; grp < grp1; ++grp, ++it) {
        __syncthreads();
#pragma unroll
        for (int rr = 0; rr < 2; ++rr) { const int rl = 2 * w + rr, row = grp * 16 + rl; const int b = (row >= M_LAT) ? 4 : row / SEQ;
            float s2 = 0.f;
#pragma unroll
            for (int j = 0; j < 4; ++j) s2 += (xv[rr][j].x * xv[rr][j].x + xv[rr][j].y * xv[rr][j].y) + (xv[rr][j].z * xv[rr][j].z + xv[rr][j].w * xv[rr][j].w);
            const float rstd = 1.f / sqrtf(wave_sum(s2) * (1.f / D) + EPS);
            const float* sh = modv(F, l, b, 3); const float* sc = modv(F, l, b, 4);
            unsigned long long* o8 = (unsigned long long*)((bf16*)(F.ws + WS_H) + (size_t)row * D) + lane;
#pragma unroll
            for (int j = 0; j < 4; ++j) { const int c = 4 * lane + 256 * j;
                const f32x4 gv = *(const f32x4*)(g + c), shv = *(const f32x4*)(sh + c), scv = *(const f32x4*)(sc + c);
                const f32x4 h = xv[rr][j] * rstd * gv * (scv + 1.f) + shv;
                o8[64 * j] = (unsigned long long)pk2(h.x, h.y) | ((unsigned long long)pk2(h.z, h.w) << 32);
                *(LAS f32x4*)(HL + rt_swz(rl, c)) = h; } }
        if (grp + 1 < grp1) RT_LOAD(grp + 1);
        __syncthreads();
        { f32x4 acc = {0.f, 0.f, 0.f, 0.f}; const int r16 = lane & 15, q = lane >> 4;
#pragma unroll
          for (int j = 0; j < 8; ++j) { const int k = 128 * w + 16 * j + 4 * q;
              const f32x4 a4 = *(const LAS f32x4*)(HL + rt_swz(r16, k)), b4 = *(const LAS f32x4*)(RWT + rt_swz(r16, k));
              acc = __builtin_amdgcn_mfma_f32_16x16x4f32(a4.x, b4.x, acc, 0, 0, 0); acc = __builtin_amdgcn_mfma_f32_16x16x4f32(a4.y, b4.y, acc, 0, 0, 0);
              acc = __builtin_amdgcn_mfma_f32_16x16x4f32(a4.z, b4.z, acc, 0, 0, 0); acc = __builtin_amdgcn_mfma_f32_16x16x4f32(a4.w, b4.w, acc, 0, 0, 0); }
#pragma unroll
          for (int j = 0; j < 4; ++j) PART[w * 256 + (q * 4 + j) * 16 + r16] = acc[j]; }
        __syncthreads();
        if (tid < 256) { float lg = 0.f;
#pragma unroll
            for (int ww = 0; ww < 8; ++ww) lg += PART[ww * 256 + tid];
            SG[tid] = sigmoidf_(lg); }
        __syncthreads();
        if (tid < 16) { const int row = grp * 16 + tid;
            float s[16], sel[16];
#pragma unroll
            for (int e4 = 0; e4 < 4; ++e4) { const f32x4 sv = *(const LAS f32x4*)(SG + tid * 16 + 4 * e4), bv = *(const f32x4*)(F.in[18] + 4 * e4);
                s[4 * e4] = sv.x; s[4 * e4 + 1] = sv.y; s[4 * e4 + 2] = sv.z; s[4 * e4 + 3] = sv.w;
                sel[4 * e4] = sv.x + bv.x; sel[4 * e4 + 1] = sv.y + bv.y; sel[4 * e4 + 2] = sv.z + bv.z; sel[4 * e4 + 3] = sv.w + bv.w; }
            int i1a, i2a, i1b, i2b, i1c, i2c, i1d, i2d; float gsa, gsb, gsc, gsd;
            top2_of4(sel[0], sel[1], sel[2], sel[3], i1a, i2a, gsa); top2_of4(sel[4], sel[5], sel[6], sel[7], i1b, i2b, gsb);
            top2_of4(sel[8], sel[9], sel[10], sel[11], i1c, i2c, gsc); top2_of4(sel[12], sel[13], sel[14], sel[15], i1d, i2d, gsd);
            int bpk = i1a | (i2a << 2); float bestv = gsa;
            { const bool c = gsb > bestv; bestv = c ? gsb : bestv; bpk = c ? (i1b | (i2b << 2) | 16) : bpk; }
            { const bool c = gsc > bestv; bestv = c ? gsc : bestv; bpk = c ? (i1c | (i2c << 2) | 32) : bpk; }
            { const bool c = gsd > bestv; bestv = c ? gsd : bestv; bpk = c ? (i1d | (i2d << 2) | 48) : bpk; }
            const int e1 = (bpk >> 4) * 4 + (bpk & 3), e2 = (bpk >> 4) * 4 + ((bpk >> 2) & 3);
            float s1 = 0.f, s2v = 0.f;
#pragma unroll
            for (int e = 0; e < 16; ++e) { s1 = (e == e1) ? s[e] : s1; s2v = (e == e2) ? s[e] : s2v; }
            const float inv = 1.f / (s1 + s2v);
            const unsigned p1 = __hip_atomic_fetch_add(lcnt + e1, 1u, __ATOMIC_RELAXED, __HIP_MEMORY_SCOPE_WORKGROUP);
            const unsigned p2 = __hip_atomic_fetch_add(lcnt + e2, 1u, __ATOMIC_RELAXED, __HIP_MEMORY_SCOPE_WORKGROUP);
            lcnt[32 + it * 16 + tid] = (unsigned)e1 | (p1 << 4) | ((unsigned)e2 << 16) | (p2 << 20);
            float* slotw = (float*)(F.ws + WS_SLOTW);
            slotw[row * 2] = s1 * inv; slotw[row * 2 + 1] = s2v * inv; }
    }
#undef RT_LOAD
    __syncthreads();
    if (tid < 16) lcnt[16 + tid] = atomicAdd((unsigned*)(F.ctl + CW_CNT + 1024 * bank + 64 * tid), lcnt[tid]);
    __syncthreads();
    if (tid < 16 * it) { const int row = (grp0 + (tid >> 4)) * 16 + (tid & 15); const unsigned en = lcnt[32 + tid];
        const unsigned e1 = en & 15u, p1 = ((en >> 4) & 0xfffu) + lcnt[16 + e1], e2 = (en >> 16) & 15u, p2 = (en >> 20) + lcnt[16 + e2];
        unsigned* list = (unsigned*)(F.ws + WS_LIST); unsigned* slote = (unsigned*)(F.ws + WS_SLOTE);
        list[(size_t)e1 * LIST_CAP + p1] = (unsigned)row * 2u; list[(size_t)e2 * LIST_CAP + p2] = (unsigned)row * 2u + 1u;
        slote[row * 2] = e1 | (p1 << 8); slote[row * 2 + 1] = e2 | (p2 << 8); }
    __syncthreads();
}
__device__ __forceinline__ void moe_prefix(Frame& F, int l) {
    if (F.tid == 0) { unsigned acc = 0;
        for (int e = 0; e < 16; ++e) { const unsigned c = __hip_atomic_load((unsigned*)(F.ctl + CW_CNT + 1024 * l + 64 * e), RLX_AGENT); F.MISC[32 + e] = acc; F.MISC[32 + 17 + e] = c; acc += (c + 255u) >> 8; }
        F.MISC[32 + 16] = acc; }
    __syncthreads();
}
__device__ __forceinline__ void combine_row(Frame& F, int l, int row, int b, const volatile LAS unsigned* tb, f32x4 (&v)[4]) {
    const unsigned se0 = ((const unsigned*)(F.ws + WS_SLOTE))[row * 2], se1 = ((const unsigned*)(F.ws + WS_SLOTE))[row * 2 + 1];
    const float w0 = ((const float*)(F.ws + WS_SLOTW))[row * 2], w1 = ((const float*)(F.ws + WS_SLOTW))[row * 2 + 1];
    const size_t p0 = (size_t)tb[se0 & 255u] * 256 + (se0 >> 8), p1 = (size_t)tb[se1 & 255u] * 256 + (se1 >> 8);
    const bf16* Y2 = (const bf16*)(F.ws + WS_Y2);
    const v2u* y0 = (const v2u*)(Y2 + p0 * D) + F.lane; const v2u* y1 = (const v2u*)(Y2 + p1 * D) + F.lane;
    const float* g2 = modv(F, l, b, 5);
#pragma unroll
    for (int j = 0; j < 4; ++j) { const v2u a = y0[64 * j], c = y1[64 * j]; const f32x4 gv = *(const f32x4*)(g2 + 4 * F.lane + 256 * j);
        f32x4 ff; ff.x = w0 * bflo(a.x) + w1 * bflo(c.x); ff.y = w0 * bfhi(a.x) + w1 * bfhi(c.x); ff.z = w0 * bflo(a.y) + w1 * bflo(c.y); ff.w = w0 * bfhi(a.y) + w1 * bfhi(c.y);
        v[j] = v[j] + gv * ff; }
}
__device__ __forceinline__ void p9_combine_mod(Frame& F) {
    moe_prefix(F, 0);
    const volatile LAS unsigned* tb = F.MISC + 32;
    const int gw = F.bid * NWAVES + F.wave, NGW = F.G * NWAVES;
    const int nrows = CTX_FULL ? M_ALL : M_LAT;
    for (int row = gw; row < nrows; row += NGW) {
        const bool isctx = row >= M_LAT; const int b = isctx ? 4 : row / SEQ;
        bf16* xr = (bf16*)(F.ws + WS_XL) + (size_t)row * D;
        f32x4 v[4];
        load_row_bf16(xr, F.lane, v);
        combine_row(F, 0, row, b, tb, v);
        store_row_bf16(xr, F.lane, v);
        if (!isctx) modulate_row(v, F.in[6] + D, modv(F, 1, b, 0), modv(F, 1, b, 1), (bf16*)(F.ws + WS_H) + (size_t)row * D, F.lane);
    }
}
__device__ __forceinline__ void p11_pool(Frame& F) {
    LAS float* I = (LAS float*)F.lds;
    const bf16* U = (const bf16*)F.out; bf16* DP = (bf16*)(F.ws + WS_DP);
    const int t = F.tid;
    for (int item = F.bid; item < 512; item += F.G) {
        const int b = item >> 7, slab = item & 127, g = slab >> 5, win = 2 << g, half = win >> 1;
        const bf16* Ub = U + ((size_t)b * 128 + slab) * SEQ * 8;
        __syncthreads();
#pragma unroll
        for (int j = 0; j < 8; ++j) { const int tok = t + 512 * j, r = tok >> 6, c = tok & 63; const v4u w = *(const v4u*)(Ub + (size_t)tok * 8);
            LAS f32x4* dst = (LAS f32x4*)(I + r * 512 + ((c ^ (r & 3)) * 8));
            dst[0] = (f32x4){bflo(w.x), bfhi(w.x), bflo(w.y), bfhi(w.y)}; dst[1] = (f32x4){bflo(w.z), bfhi(w.z), bflo(w.w), bfhi(w.w)}; }
        __syncthreads();
        { const int r = t >> 3, ch = t & 7; float run = 0.f;
#pragma unroll
          for (int c0 = 0; c0 < 64; c0 += 16) { float x[16];
#pragma unroll
              for (int k = 0; k < 16; ++k) x[k] = I[r * 512 + (((c0 + k) ^ (r & 3)) * 8) + ch];
#pragma unroll
              for (int k = 0; k < 16; ++k) { run += x[k]; x[k] = run; }
#pragma unroll
              for (int k = 0; k < 16; ++k) I[r * 512 + (((c0 + k) ^ (r & 3)) * 8) + ch] = x[k]; } }
        __syncthreads();
        { const int c = t >> 3, ch = t & 7; float run = 0.f;
#pragma unroll
          for (int r0 = 0; r0 < 64; r0 += 16) { float x[16];
#pragma unroll
              for (int k = 0; k < 16; ++k) x[k] = I[(r0 + k) * 512 + ((c ^ ((r0 + k) & 3)) * 8) + ch];
#pragma unroll
              for (int k = 0; k < 16; ++k) { run += x[k]; x[k] = run; }
#pragma unroll
              for (int k = 0; k < 16; ++k) I[(r0 + k) * 512 + ((c ^ ((r0 + k) & 3)) * 8) + ch] = x[k]; } }
        __syncthreads();
#pragma unroll 2
        for (int j = 0; j < 8; ++j) { const int tok = t + 512 * j, r = tok >> 6, c = tok & 63;
            const int rlo = max(r - half, 0), rhi = min(r - half + win, GRIDW), clo = max(c - half, 0), chi = min(c - half + win, GRIDW);
            const int r1 = rhi - 1, c1 = chi - 1, r0 = rlo - 1, c0 = clo - 1;
            const LAS f32x4* p11 = (const LAS f32x4*)(I + r1 * 512 + ((c1 ^ (r1 & 3)) * 8));
            f32x4 s0 = p11[0], s1 = p11[1];
            if (r0 >= 0) { const LAS f32x4* q = (const LAS f32x4*)(I + r0 * 512 + ((c1 ^ (r0 & 3)) * 8)); s0 -= q[0]; s1 -= q[1]; }
            if (c0 >= 0) { const LAS f32x4* q = (const LAS f32x4*)(I + r1 * 512 + ((c0 ^ (r1 & 3)) * 8)); s0 -= q[0]; s1 -= q[1]; }
            if (r0 >= 0 && c0 >= 0) { const LAS f32x4* q = (const LAS f32x4*)(I + r0 * 512 + ((c0 ^ (r0 & 3)) * 8)); s0 += q[0]; s1 += q[1]; }
            const float inv = 1.f / (float)((rhi - rlo) * (chi - clo));
            const v4u w = *(const v4u*)(Ub + (size_t)tok * 8);
            v4u o; o.x = pk2(s0.x * inv - bflo(w.x), s0.y * inv - bfhi(w.x)); o.y = pk2(s0.z * inv - bflo(w.y), s0.w * inv - bfhi(w.y));
            o.z = pk2(s1.x * inv - bflo(w.z), s1.y * inv - bfhi(w.z)); o.w = pk2(s1.z * inv - bflo(w.w), s1.w * inv - bfhi(w.w));
            *(v4u*)(DP + ((size_t)slab * M_LAT + (size_t)b * SEQ + tok) * 8) = o; }
    }
}
__device__ __forceinline__ void p17_final(Frame& F) {
    moe_prefix(F, 1);
    const volatile LAS unsigned* tb = F.MISC + 32;
    const int gw = F.bid * NWAVES + F.wave, NGW = F.G * NWAVES;
    for (int row = gw; row < M_LAT; row += NGW) {
        float* xr = F.out + (size_t)row * D;
        f32x4 v[4];
        load_row_bf16((const bf16*)(F.ws + WS_XL) + (size_t)row * D, F.lane, v);
        combine_row(F, 1, row, row / SEQ, tb, v);
        float s2 = 0.f;
#pragma unroll
        for (int j = 0; j < 4; ++j) s2 += (v[j].x * v[j].x + v[j].y * v[j].y) + (v[j].z * v[j].z + v[j].w * v[j].w);
        const float rstd = 1.f / sqrtf(wave_sum(s2) * (1.f / D) + EPS);
#pragma unroll
        for (int j = 0; j < 4; ++j) { const f32x4 gv = *(const f32x4*)(F.in[22] + 4 * F.lane + 256 * j); ((f32x4*)xr)[F.lane + 64 * j] = v[j] * rstd * gv; }
    }
}

struct Args { const float* in[23]; float* out; unsigned char* ws; int ph_lo, ph_hi; };
#ifndef NAIVE_GEMM
#define RUN_GEMM(EpiT, SchedT, g, S, E) gemm_phase<EpiT, SchedT, true, true>(F.lds, g, S, E)
#else
#define RUN_GEMM(EpiT, SchedT, g, S, E) gemm_naive<EpiT, SchedT>(g, S, E)
#endif

__global__ void __launch_bounds__(NTHR, 2) fwd_kernel(Args args) {
    extern __shared__ __attribute__((aligned(16))) unsigned char lds[];
    Frame F;
    F.lds = (LAS unsigned char*)lds; F.MISC = (volatile LAS unsigned*)(F.lds + MISC_OFF);
    F.tid = threadIdx.x; F.lane = F.tid & 63; F.wave = __builtin_amdgcn_readfirstlane(F.tid >> 6);
    F.G = gridDim.x; F.bid = blockIdx.x;
#pragma unroll
    for (int i = 0; i < 23; ++i) F.in[i] = args.in[i];
    F.out = args.out; F.ws = args.ws; F.ctl = (gu32*)(args.ws + WS_CTL);
    for (int u = F.tid; u < (LDS_BYTES - LDSCTL_OFF) / 4; u += NTHR) ((LAS unsigned*)(F.lds + LDSCTL_OFF))[u] = 0u;
    __syncthreads();
    XcdBarrier bar; bar.bar = (unsigned*)(F.ctl + CW_BAR); bar.x = 0; bar.st = nullptr;
    if (MK_ONE_LAUNCH) bar = xcd_barrier_post((unsigned*)(F.ctl + CW_BAR), F.MISC + 8);
    const int lo = args.ph_lo, hi = args.ph_hi;
#ifndef PHMASK
#define PHMASK 0x3ffff
#endif
#define IN(k) (((PHMASK >> (k)) & 1) && lo <= (k) && (k) < hi)
#ifndef REPMASK
#define REPMASK 0
#endif
#define REPLOOP(k) for (int _r = 0; _r <= ((REPMASK >> (k)) & 1); (++_r <= ((REPMASK >> (k)) & 1)) ? xcd_barrier(bar) : (void)0)
#define SEAM(k) do { if (IN(k) && IN((k) + 1)) xcd_barrier(bar); } while (0)
    bf16* const PL = (bf16*)(F.ws + WS_PL);

    if (IN(0)) REPLOOP(0) { p0_prep(F); } SEAM(0);
    if (IN(1)) REPLOOP(1) { p1_modulate0(F); } SEAM(1);
    if (IN(2)) REPLOOP(2) {
        Gemm g{(const bf16*)(F.ws + WS_H), (const bf16*)(F.ws + WS_WHGIN), D, 128}; StaticOrder S; S.init(M_ALL, NPROJ * D, F.G, F.bid);
        EpiInProj E{PL, (const float*)(F.ws + WS_LBV)}; RUN_GEMM(EpiInProj, StaticOrder, g, S, E);
        conv_moe_queue(F, 0, (bf16*)(F.ws + WS_WGU0), (bf16*)(F.ws + WS_WD0)); } SEAM(2);
    #ifdef SCAN_NAIVE
    if (IN(3)) REPLOOP(3) { p3_scan_naive(F); } SEAM(3);
#else
    if (IN(3)) REPLOOP(3) { p3_scan(F); } SEAM(3);
#endif
    if (IN(4)) REPLOOP(4) { p4_readout_prep(F); } SEAM(4);
    if (IN(5)) REPLOOP(5) {
        Gemm g{(const bf16*)(F.ws + WS_H), (const bf16*)(F.ws + WS_WHGOUT), D, 128}; StaticOrder S; S.init(CTX_FULL ? M_ALL : M_LAT, D, F.G, F.bid);
        EpiResid<true> E{F.in[0], (bf16*)(F.ws + WS_XL), modv(F, 0, 0, 2)}; RUN_GEMM(EpiResid<true>, StaticOrder, g, S, E); } SEAM(5);
    if (IN(6)) REPLOOP(6) { p_route(F, 0, (_r < ((REPMASK >> 6) & 1)) ? 2 : 0); } SEAM(6);
    if (IN(7)) REPLOOP(7) { moe_prefix(F, 0);
        Gemm g{(const bf16*)(F.ws + WS_H), (const bf16*)(F.ws + WS_WGU0), D, 128}; MoeOrder S{F.G, F.bid, 2, 1, F.MISC + 32, (const unsigned*)(F.ws + WS_LIST)};
        EpiGateUp E{(bf16*)(F.ws + WS_ACT)}; RUN_GEMM(EpiGateUp, MoeOrder, g, S, E);
 } SEAM(7);
    if (IN(8)) REPLOOP(8) { moe_prefix(F, 0);
        Gemm g{(const bf16*)(F.ws + WS_ACT), (const bf16*)(F.ws + WS_WD0), DE, 128}; MoeOrder S{F.G, F.bid, 4, 0, F.MISC + 32, (const unsigned*)(F.ws + WS_LIST)};
        EpiDown E{(bf16*)(F.ws + WS_Y2)}; RUN_GEMM(EpiDown, MoeOrder, g, S, E); } SEAM(8);
    if (IN(9)) REPLOOP(9) { p9_combine_mod(F); } SEAM(9);
    if (IN(10)) REPLOOP(10) {
        Gemm g{(const bf16*)(F.ws + WS_H), (const bf16*)(F.ws + WS_WPIN), D, 128}; StaticOrder S; S.init(M_LAT, D, F.G, F.bid);
        EpiPoolIn E{(bf16*)F.out}; RUN_GEMM(EpiPoolIn, StaticOrder, g, S, E); } SEAM(10);
        if (IN(11)) REPLOOP(11) { p11_pool(F); } SEAM(11);
    if (IN(13)) REPLOOP(13) {
        Gemm g{(const bf16*)(F.ws + WS_DP), (const bf16*)(F.ws + WS_WPOUT), D, (size_t)8 * M_LAT * 16}; SlabOrder S; S.init(M_LAT, D, F.G, F.bid);
        EpiResid<false> E{F.ws + WS_XL, (bf16*)(F.ws + WS_XL), modv(F, 1, 0, 2)}; RUN_GEMM(EpiResid<false>, SlabOrder, g, S, E); } SEAM(13);
    if (IN(14)) REPLOOP(14) { p_route(F, 1, (_r < ((REPMASK >> 14) & 1)) ? 3 : 1); } SEAM(14);
    if (IN(15)) REPLOOP(15) { moe_prefix(F, 1);
        Gemm g{(const bf16*)(F.ws + WS_H), (const bf16*)(F.ws + WS_WGU1), D, 128}; MoeOrder S{F.G, F.bid, 2, 1, F.MISC + 32, (const unsigned*)(F.ws + WS_LIST)};
        EpiGateUp E{(bf16*)(F.ws + WS_ACT)}; RUN_GEMM(EpiGateUp, MoeOrder, g, S, E); } SEAM(15);
    if (IN(16)) REPLOOP(16) { moe_prefix(F, 1);
        Gemm g{(const bf16*)(F.ws + WS_ACT), (const bf16*)(F.ws + WS_WD1), DE, 128}; MoeOrder S{F.G, F.bid, 4, 0, F.MISC + 32, (const unsigned*)(F.ws + WS_LIST)};
        EpiDown E{(bf16*)(F.ws + WS_Y2)}; RUN_GEMM(EpiDown, MoeOrder, g, S, E); } SEAM(16);
    if (IN(17)) REPLOOP(17) { p17_final(F); }
#undef IN
#undef SEAM
}

extern "C" void kernel_launch(void* const* d_in, const int* in_sizes, int n_in, void* d_out, int out_size, void* d_ws, size_t ws_size, hipStream_t stream) {
    static int grid = 0;
    if (grid == 0) {
        if (n_in != 23 || in_sizes[0] != M_LAT * D || out_size != M_LAT * D || ws_size < WS_END) { fprintf(stderr, "kernel_launch: unexpected shapes (n_in %d, in0 %d, out %d, ws %zu); nothing launched\n", n_in, n_in > 0 ? in_sizes[0] : -1, out_size, ws_size); grid = -1; return; }
        int dev = 0, cus = 0, per_cu = 0;
        if (hipGetDevice(&dev) != hipSuccess || hipDeviceGetAttribute(&cus, hipDeviceAttributeMultiprocessorCount, dev) != hipSuccess) { grid = -1; return; }
        if (hipFuncSetAttribute((const void*)fwd_kernel, hipFuncAttributeMaxDynamicSharedMemorySize, LDS_BYTES) != hipSuccess) { fprintf(stderr, "kernel_launch: hipFuncSetAttribute failed\n"); grid = -1; return; }
        if (hipOccupancyMaxActiveBlocksPerMultiprocessor(&per_cu, (const void*)fwd_kernel, NTHR, LDS_BYTES) != hipSuccess || per_cu < 1) { fprintf(stderr, "kernel_launch: occupancy query says %d blocks per CU\n", per_cu); per_cu = 1; }
        (void)hipGetLastError();
        grid = cus;
    }
    if (grid < 0) return;
    if (hipMemsetAsync((char*)d_ws + WS_CTL, 0, CTL_ZERO_BYTES, stream) != hipSuccess) return;
    Args a{};
    for (int i = 0; i < 23; ++i) a.in[i] = (const float*)d_in[i];
    a.out = (float*)d_out; a.ws = (unsigned char*)d_ws;
    if (MK_ONE_LAUNCH) { a.ph_lo = 0; a.ph_hi = NPHASE; hipLaunchKernelGGL(fwd_kernel, dim3(grid), dim3(NTHR), LDS_BYTES, stream, a); }
    else for (int p = 0; p < NPHASE; ++p) { a.ph_lo = p; a.ph_hi = p + 1; hipLaunchKernelGGL(fwd_kernel, dim3(grid), dim3(NTHR), LDS_BYTES, stream, a); }
}
```

```cpp
#include <hip/hip_runtime.h>
#include <cstdio>
#include <cstdint>

#ifndef MK_ONE_LAUNCH
#define MK_ONE_LAUNCH 1
#endif
#ifndef CTX_FULL
#define CTX_FULL 0
#endif

constexpr int D = 1024, NB = 4, SEQ = 4096, CTXL = 256;
constexpr int M_LAT = NB * SEQ, M_CTX = NB * CTXL, M_ALL = M_LAT + M_CTX;
constexpr int NH = 8, DH = 128, NPROJ = 5;
constexpr int NE = 16, DE = 256, NGRP = 4, EPG = 4;
constexpr int GRIDW = 64;
constexpr float EPS = 1e-6f;
constexpr int NWAVES = 8, NTHR = 512;
constexpr int NPHASE = 18;

constexpr size_t MiB = 1u << 20;
constexpr size_t WS_CTL = 0, CTL_ZERO_BYTES = 1 * MiB;
constexpr size_t WS_MODV = 1 * MiB;
constexpr size_t WS_LBV = 1 * MiB + 256 * 1024;
constexpr size_t WS_LIST = 2 * MiB;
constexpr size_t WS_SLOTE = 2 * MiB + 1280 * 1024;
constexpr size_t WS_SLOTW = 2 * MiB + 1536 * 1024;
constexpr size_t WS_WHGIN = 4 * MiB;
constexpr size_t WS_WHGOUT = 14 * MiB;
constexpr size_t WS_WGU0 = 16 * MiB;
constexpr size_t WS_WD0 = 32 * MiB;
constexpr size_t WS_XC = 40 * MiB;
constexpr size_t WS_H = 44 * MiB;
constexpr size_t WS_PL = 78 * MiB;
constexpr size_t PLANE = (size_t)M_ALL * D * 2;
constexpr size_t WS_OFC = 248 * MiB, WS_OBC = 250 * MiB;
constexpr size_t WS_WPIN = 78 * MiB, WS_WGRP = 80 * MiB, WS_WPOUT = 81 * MiB;
constexpr size_t WS_WGU1 = 83 * MiB, WS_WD1 = 99 * MiB;
constexpr size_t WS_ACT = 108 * MiB;
constexpr size_t WS_Y2 = 128 * MiB;
constexpr size_t WS_XL = 204 * MiB;
constexpr size_t WS_DP = 108 * MiB;
constexpr size_t WS_E = 140 * MiB;
constexpr size_t WS_END = 256 * MiB;
static_assert(WS_PL + 5 * PLANE <= WS_OFC && WS_H + PLANE <= WS_PL && WS_Y2 + (size_t)38912 * 2048 <= WS_XL && WS_XL + (size_t)M_LAT * 2048 <= WS_OFC, "ws map");
static_assert(WS_ACT + (size_t)38912 * 512 <= WS_Y2 && WS_DP + (size_t)M_LAT * 2048 <= WS_E && WS_E + (size_t)M_LAT * 2048 <= WS_XL && WS_WD1 + 8 * MiB <= WS_ACT, "ws map 2");
constexpr int CW_BAR = 4096;
constexpr int CW_Q = 16384;
constexpr int CW_CNT = 8192;
constexpr int LIST_CAP = M_ALL;

constexpr int RING_BYTES = 147456;
constexpr int LDSCTL_OFF = RING_BYTES, MISC_OFF = LDSCTL_OFF + 320;
constexpr int LDS_BYTES = 163840;

#define GAS __attribute__((address_space(1)))
#define LAS __attribute__((address_space(3)))
typedef unsigned short bf16;
typedef unsigned v4u __attribute__((ext_vector_type(4)));
typedef unsigned v2u __attribute__((ext_vector_type(2)));
typedef float f32x4 __attribute__((ext_vector_type(4)));
typedef short bf16x8 __attribute__((ext_vector_type(8)));
typedef GAS unsigned gu32;
#define RLX_AGENT __ATOMIC_RELAXED, __HIP_MEMORY_SCOPE_AGENT
#define LDS_WAIT() asm volatile("s_waitcnt lgkmcnt(0)" ::: "memory")
#define VM_WAIT() asm volatile("s_waitcnt vmcnt(0)" ::: "memory")

__device__ __forceinline__ unsigned f2bf(float f) { unsigned u = __builtin_bit_cast(unsigned, f); return (u + 0x7fffu + ((u >> 16) & 1u)) >> 16; }
typedef float f32x2_t __attribute__((ext_vector_type(2)));
typedef __bf16 bf16x2_t __attribute__((ext_vector_type(2)));
__device__ __forceinline__ unsigned pk2(float lo, float hi) { const f32x2_t v = {lo, hi}; const bf16x2_t b = __builtin_convertvector(v, bf16x2_t); return __builtin_bit_cast(unsigned, b); }
__device__ __forceinline__ float bf2f(unsigned b) { return __builtin_bit_cast(float, b << 16); }
__device__ __forceinline__ float bflo(unsigned w) { return __builtin_bit_cast(float, w << 16); }
__device__ __forceinline__ float bfhi(unsigned w) { return __builtin_bit_cast(float, w & 0xffff0000u); }
__device__ __forceinline__ float sigmoidf_(float x) { return __builtin_amdgcn_rcpf(1.f + __expf(-x)); }
__device__ __forceinline__ float siluf_(float x) { return x * __builtin_amdgcn_rcpf(1.f + __expf(-x)); }
__device__ __forceinline__ float wave_sum(float v) {
#pragma unroll
    for (int o = 1; o < 64; o <<= 1) v += __shfl_xor(v, o);
    return v;
}

#define XB_TMO      128
#define XB_XCNT(j)  (256  + 64 * (j))
#define XB_XSUB(j)  (1280 + 64 * (j))
#define XB_XGEN(j)  (2304 + 64 * (j))
#define XB_TOP      3328
#define XB_TOPGEN   3392
#define XCD_BAR_WORDS 3456
#define XB_SPIN_CAP (1u << 18)
__device__ __forceinline__ unsigned xb_ld(unsigned* p)              { return __hip_atomic_load(p, __ATOMIC_RELAXED, __HIP_MEMORY_SCOPE_AGENT); }
__device__ __forceinline__ unsigned xb_add(unsigned* p, unsigned v) { return __hip_atomic_fetch_add(p, v, __ATOMIC_RELAXED, __HIP_MEMORY_SCOPE_AGENT); }
__device__ __forceinline__ unsigned xb_xcc_id() { return (unsigned)__builtin_amdgcn_s_getreg((3 << 11) | 20) & 0xFu; }
#define XB_SPIN(cond, bar) do { unsigned _sp = 0; while (cond) { __builtin_amdgcn_s_sleep(1); \
    if ((++_sp & 255u) == 0u) { if (xb_ld(&(bar)[XB_TMO])) break; if (_sp > XB_SPIN_CAP) { atomicAdd(&(bar)[XB_TMO], 1u); break; } } } } while (0)
struct XcdBarrier { unsigned* bar; unsigned x; volatile LAS unsigned* st; };
__device__ __forceinline__ XcdBarrier xcd_barrier_post(unsigned* bar, volatile LAS unsigned* st) {
    XcdBarrier b; b.bar = bar; b.x = xb_xcc_id(); b.st = st;
    if (threadIdx.x == 0) (void)xb_add(&bar[XB_XCNT(b.x)], 1u);
    return b;
}
__device__ __forceinline__ void xcd_barrier_complete(unsigned* bar, unsigned x, unsigned& nloc, unsigned& nx) {
    const unsigned G = gridDim.x * gridDim.y * gridDim.z;
    unsigned sum, cnt, mine, sp = 0u;
    for (;;) {
        sum = 0u; cnt = 0u; mine = 0u;
#pragma unroll
        for (unsigned j = 0; j < 16; ++j) { const unsigned c = xb_ld(&bar[XB_XCNT(j)]); sum += c; cnt += (c > 0u) ? 1u : 0u; mine = (j == x) ? c : mine; }
        if (sum == G) break;
        __builtin_amdgcn_s_sleep(1);
        if ((++sp & 255u) == 0u) { if (xb_ld(&bar[XB_TMO])) break; if (sp > XB_SPIN_CAP) { atomicAdd(&bar[XB_TMO], 1u); break; } }
    }
    nloc = mine > 0u ? mine : 1u; nx = cnt > 0u ? cnt : 1u;
}
__device__ __forceinline__ void xcd_barrier(const XcdBarrier& b) {
    asm volatile("s_waitcnt vmcnt(0)" ::: "memory");
    __syncthreads();
    if (threadIdx.x == 0) {
        unsigned* bar = b.bar;
        __builtin_amdgcn_s_waitcnt(0);
        unsigned nloc = b.st[0], nx = b.st[1];
        if (nloc == 0u) { xcd_barrier_complete(bar, b.x, nloc, nx); b.st[0] = nloc; b.st[1] = nx; }
        const unsigned old = xb_add(&bar[XB_XSUB(b.x)], 1u);
        const unsigned gen = old / nloc;
        if (old + 1u == (gen + 1u) * nloc) {
            __builtin_amdgcn_fence(__ATOMIC_RELEASE, "agent");
            asm volatile("s_waitcnt vmcnt(0)" ::: "memory");
            const unsigned og = xb_add(&bar[XB_TOP], 1u);
            const unsigned tg = og / nx;
            if (og + 1u == (tg + 1u) * nx) xb_add(&bar[XB_TOPGEN], 1u);
            else XB_SPIN(xb_ld(&bar[XB_TOPGEN]) == tg, bar);
            __builtin_amdgcn_fence(__ATOMIC_ACQUIRE, "agent");
            xb_add(&bar[XB_XGEN(b.x)], 1u);
            asm volatile("s_waitcnt vmcnt(0)" ::: "memory");
        } else {
            XB_SPIN(xb_ld(&bar[XB_XGEN(b.x)]) == gen, bar);
            __builtin_amdgcn_fence(__ATOMIC_ACQUIRE, "agent");
            asm volatile("s_waitcnt vmcnt(0)" ::: "memory");
        }
    }
    __syncthreads();
}

struct Unit { int pm, pn; };
struct Gemm { const bf16* A; const bf16* Bt; int K; size_t kstepA; };
constexpr int NXCD = 8, WGM = 8, BM = 256;

struct StaticOrder {
    int nM, nN, nwg, G, c;
    __device__ __forceinline__ void init(int M, int N, int G_, int c_) { nM = M / BM; nN = N / BM; nwg = nM * nN; G = G_; c = c_; }
    __device__ __forceinline__ bool next(int i, Unit& u) const {
        const long L = (long)i * G + c; if (L >= nwg) return false;
        int wgid = (int)L; { const int q = nwg / NXCD, r = nwg % NXCD, xcd = wgid % NXCD, off = wgid / NXCD; wgid = (xcd < r ? xcd * (q + 1) : r * (q + 1) + (xcd - r) * q) + off; }
        const int nig = WGM * nN, gid = wgid / nig, fm = gid * WGM, gsz = (nM - fm) < WGM ? (nM - fm) : WGM;
        u.pm = fm + ((wgid % nig) % gsz); u.pn = (wgid % nig) / gsz; return true;
    }
    __device__ __forceinline__ int a_row(const Unit& u, int r) const { return u.pm * BM + r; }
    __device__ __forceinline__ unsigned a_off(const Unit& u, int r, int c, int K) const { return (unsigned)((u.pm * BM + r) * K + c) * 2u; }
};
struct GroupOrder {
    int G, c;
    __device__ __forceinline__ bool next(int i, Unit& u) const { const int L = i * G + c; if (L >= 256) return false; u.pm = L; u.pn = L >> 6; return true; }
    __device__ __forceinline__ int a_row(const Unit& u, int r) const { return u.pm * BM + r; }
    __device__ __forceinline__ unsigned a_off(const Unit& u, int r, int c, int K) const { return (unsigned)(((u.pn * 32 + (c >> 3)) * M_LAT + (u.pm & 63) * BM + r) * 8 + (c & 7)) * 2u; }
};
struct SlabOrder : StaticOrder {
    __device__ __forceinline__ unsigned a_off(const Unit& u, int r, int c, int K) const { return (unsigned)(((c >> 3) * M_LAT + u.pm * BM + r) * 8 + (c & 7)) * 2u; }
};
struct MoeOrder {
    int G, c, npn, gather; const volatile LAS unsigned* tb; const unsigned* list;
    __device__ __forceinline__ bool next(int i, Unit& u) const {
        const int L = i * G + c; const int nt = (int)tb[16];
        if (L >= nt * npn) return false;
        const int t = L / npn, nl = L % npn; int e = 0;
#pragma unroll
        for (int j = 1; j < 16; ++j) e += (t >= (int)tb[j]) ? 1 : 0;
        u.pm = t; u.pn = e * npn + nl; return true;
    }
    __device__ __forceinline__ int a_row(const Unit& u, int r) const {
        if (!gather) return u.pm * BM + r;
        const int e = u.pn / npn; const int idx = (u.pm - (int)tb[e]) * BM + r;
        const unsigned ent = (idx < (int)tb[17 + e]) ? list[(size_t)e * LIST_CAP + idx] : 0u;
        return (int)(ent >> 1);
    }
    __device__ __forceinline__ unsigned a_off(const Unit& u, int r, int c, int K) const { return (unsigned)(a_row(u, r) * K + c) * 2u; }
};

template <class Epi, class Sched>
__device__ __forceinline__ void gemm_naive(const Gemm g, const Sched& S, const Epi& E) {
    const int tid = threadIdx.x, wid = tid >> 6, lane = tid & 63, wr = wid >> 2, wc = wid & 3, fr = lane & 15, fq = lane >> 4;
    const int K = g.K;
    Unit u;
    for (int i = 0; S.next(i, u); ++i) {
        f32x4 acc[2][2][4][2];
#pragma unroll
        for (int ai = 0; ai < 2; ++ai)
#pragma unroll
            for (int m = 0; m < 4; ++m) {
                const bf16* ar = g.A + (size_t)S.a_row(u, 128 * ai + 64 * wr + 16 * m + fr) * K;
#pragma unroll
                for (int bj = 0; bj < 2; ++bj)
#pragma unroll
                    for (int n = 0; n < 2; ++n) {
                        const int c0 = 128 * bj + 32 * wc + (Epi::PERM ? 8 * fq + 4 * n : 16 * n + 4 * fq);
                        const bf16* br = g.Bt + (size_t)(u.pn * BM + c0) * K;
                        f32x4 a0 = {0.f, 0.f, 0.f, 0.f};
#pragma unroll 1
                        for (int k = 0; k < K; k += 8) {
                            const v4u b0 = *(const v4u*)(br + k), b1 = *(const v4u*)(br + (size_t)K + k), b2 = *(const v4u*)(br + (size_t)2 * K + k), b3 = *(const v4u*)(br + (size_t)3 * K + k);
                            const v4u x0 = *(const v4u*)(ar + k);
#pragma unroll
                            for (int q = 0; q < 4; ++q) {
                                const f32x4 blo = {bflo(b0[q]), bflo(b1[q]), bflo(b2[q]), bflo(b3[q])}, bhi = {bfhi(b0[q]), bfhi(b1[q]), bfhi(b2[q]), bfhi(b3[q])};
                                a0 += blo * bflo(x0[q]) + bhi * bfhi(x0[q]);
                            }
                        }
                        asm volatile("" : "+v"(a0));
                        acc[ai][bj][m][n] = a0;
                    }
            }
        E(acc, u, wr, wc, fr, fq);
    }
}

constexpr int BK = 64, HALF = 128, HTB = HALF * BK * 2;
__device__ __forceinline__ int lds_byte(int r, int c) { const int st = (r >> 4) * 2 + (c >> 5), rr = r & 15, cc = c & 31, ob = rr * 64 + cc * 2; return st * 1024 + (ob ^ (((ob >> 9) & 1) << 5)); }
__device__ __forceinline__ void stage_rc(int b, int& R, int& C) { const int st = b / 1024, sb = b % 1024, swz = sb ^ (((sb >> 9) & 1) << 5); R = (st >> 1) * 16 + swz / 64; C = (st & 1) * 32 + (swz % 64) / 2; }
__device__ __forceinline__ int perm32(int rho) { const int n = rho >> 4, i = rho & 15; return 8 * (i >> 2) + 4 * n + (i & 3); }
template <class Epi, class Sched, bool ALIGN_EPI = false, bool SP2 = false>
__device__ __forceinline__ void gemm_phase(LAS unsigned char* lds, const Gemm g, const Sched& S, const Epi& E) {
    const int tid = threadIdx.x, wid = __builtin_amdgcn_readfirstlane(tid >> 6), lane = tid & 63, wr = wid >> 2, wc = wid & 3, fr = lane & 15, fq = lane >> 4;
    const int K = g.K, nt = K / BK;
    unsigned vAc0[2], vAc1[2], vAn0[2], vAn1[2], voffB[2]; int stR[2], stC[2];
#pragma unroll
    for (int i = 0; i < 2; ++i) { int R, C; stage_rc(tid * 16 + i * 8192, R, C); const int Rb = Epi::PERM ? ((R & ~31) + perm32(R & 31)) : R;
        stR[i] = R; stC[i] = C; voffB[i] = (unsigned)(Rb * K + C) * 2u; }
#define PG8_SETA(v0, v1, U) do { _Pragma("unroll") for (int _i = 0; _i < 2; ++_i) { v0[_i] = S.a_off(U, stR[_i], stC[_i], K); v1[_i] = S.a_off(U, HALF + stR[_i], stC[_i], K); } } while (0)
    const size_t kstep = (size_t)(BK * 2);
    const size_t kstepA = g.kstepA;
    const size_t hstep = (size_t)HALF * K * 2;
    const size_t tstep = 2 * hstep;
    const unsigned ldsw = (unsigned)wid * 1024u;
    const int aoff = lds_byte(wr * 64 + fr, fq * 8), boff = lds_byte(wc * 32 + fr, fq * 8);
#define PG8_SA(b, h) (((b) * 2 + (h)) * HTB)
#define PG8_SB(b, h) ((4 + (b) * 2 + (h)) * HTB)
#define PG8_STAGE(bufoff, gbase, voff) do { _Pragma("unroll") for (int _i = 0; _i < 2; ++_i) \
        __builtin_amdgcn_global_load_lds((const unsigned*)((const char*)(gbase) + (voff)[_i]), (LAS unsigned*)(lds + (bufoff) + ldsw + _i * 8192), 16, 0, 0); } while (0)
#define PG8_LDA(dst, b, h) do { _Pragma("unroll") for (int m = 0; m < 4; ++m) _Pragma("unroll") for (int k = 0; k < 2; ++k) dst[m][k] = *(const LAS bf16x8*)(lds + PG8_SA(b, h) + aoff + m * 2048 + k * 1024); } while (0)
#define PG8_LDB(dst, b, h) do { _Pragma("unroll") for (int n = 0; n < 2; ++n) _Pragma("unroll") for (int k = 0; k < 2; ++k) dst[n][k] = *(const LAS bf16x8*)(lds + PG8_SB(b, h) + boff + n * 2048 + k * 1024); } while (0)
#define PG8_MMA(ai, bj, At, Bt) do { __builtin_amdgcn_s_setprio(1); _Pragma("unroll") for (int m = 0; m < 4; ++m) _Pragma("unroll") for (int n = 0; n < 2; ++n) _Pragma("unroll") for (int k = 0; k < 2; ++k) \
        acc[ai][bj][m][n] = __builtin_amdgcn_mfma_f32_16x16x32_bf16(Bt[n][k], At[m][k], acc[ai][bj][m][n], 0, 0, 0); __builtin_amdgcn_s_setprio(0); } while (0)
#define PG8_WAIT_V(n) asm volatile("s_waitcnt vmcnt(" #n ")" ::: "memory")
#define PG8_WAIT_L(n) asm volatile("s_waitcnt lgkmcnt(" #n ")" ::: "memory")
#define PG8_BAR __builtin_amdgcn_s_barrier()
#define PG8_SCHED __builtin_amdgcn_sched_barrier(0)
    Unit cur, nxt; int ui = 0;
    if (!S.next(0, cur)) return;
    f32x4 acc[2][2][4][2];
#pragma unroll
    for (int a = 0; a < 2; ++a)
#pragma unroll
        for (int b = 0; b < 2; ++b)
#pragma unroll
            for (int m = 0; m < 4; ++m)
#pragma unroll
                for (int n = 0; n < 2; ++n) acc[a][b][m][n] = (f32x4){0.f, 0.f, 0.f, 0.f};
    bf16x8 At[4][2], B0[2][2], B1[2][2];
    const char* const cA = (const char*)g.A; PG8_SETA(vAc0, vAc1, cur); const char* cB = (const char*)g.Bt + (size_t)cur.pn * tstep;
    if constexpr (SP2) {
        PG8_STAGE(PG8_SB(0, 0), cB, voffB); PG8_STAGE(PG8_SB(0, 1), cB + hstep, voffB); PG8_STAGE(PG8_SA(0, 0), cA, vAc0); PG8_STAGE(PG8_SA(0, 1), cA, vAc1);
        if (wr == 1) PG8_BAR;
        PG8_WAIT_V(2); PG8_BAR;
        PG8_STAGE(PG8_SB(1, 0), cB + kstep, voffB); PG8_STAGE(PG8_SA(1, 0), cA + kstepA, vAc0); PG8_STAGE(PG8_SB(1, 1), cB + hstep + kstep, voffB);
        PG8_WAIT_V(6); PG8_BAR;
    } else {
        PG8_STAGE(PG8_SB(0, 0), cB, voffB); PG8_STAGE(PG8_SA(0, 0), cA, vAc0); PG8_STAGE(PG8_SB(0, 1), cB + hstep, voffB); PG8_STAGE(PG8_SA(0, 1), cA, vAc1);
        if (wr == 1) PG8_BAR;
        PG8_WAIT_V(4); PG8_BAR;
        PG8_STAGE(PG8_SB(1, 0), cB + kstep, voffB); PG8_STAGE(PG8_SA(1, 0), cA + kstepA, vAc0); PG8_STAGE(PG8_SB(1, 1), cB + hstep + kstep, voffB);
        PG8_WAIT_V(6); PG8_BAR;
    }
    for (;;) {
        const bool has_next = S.next(ui + 1, nxt);
        if (has_next) { PG8_SETA(vAn0, vAn1, nxt); } else { vAn0[0] = vAc0[0]; vAn0[1] = vAc0[1]; vAn1[0] = vAc1[0]; vAn1[1] = vAc1[1]; }
        const char* nB = has_next ? (const char*)g.Bt + (size_t)nxt.pn * tstep : cB;
#pragma unroll 1
        for (int t = 0; t < nt; t += 2) {
            const bool last = (t == nt - 2);
            const char* a1 = cA + (size_t)(t + 1) * kstepA;
            const char* a2 = last ? cA : cA + (size_t)(t + 2) * kstepA; unsigned w0[2], w1[2]; w0[0] = last ? vAn0[0] : vAc0[0]; w0[1] = last ? vAn0[1] : vAc0[1]; w1[0] = last ? vAn1[0] : vAc1[0]; w1[1] = last ? vAn1[1] : vAc1[1]; const char* b2 = last ? nB : cB + (size_t)(t + 2) * kstep;
            const char* a3 = a2 + kstepA; const char* b3 = b2 + kstep;
            if constexpr (SP2) {
            PG8_LDB(B0, 0, 0); PG8_LDB(B1, 0, 1); PG8_SCHED; PG8_LDA(At, 0, 0); PG8_STAGE(PG8_SA(1, 1), a1, vAc1);
            PG8_WAIT_V(8); PG8_WAIT_L(0); PG8_BAR; PG8_MMA(0, 0, At, B0); PG8_MMA(0, 1, At, B1); PG8_BAR; PG8_SCHED;
            PG8_LDA(At, 0, 1); PG8_STAGE(PG8_SB(0, 0), b2, voffB); PG8_STAGE(PG8_SB(0, 1), b2 + hstep, voffB); PG8_STAGE(PG8_SA(0, 0), a2, w0);
            PG8_WAIT_V(8); PG8_WAIT_L(0); PG8_BAR; PG8_MMA(1, 0, At, B0); PG8_MMA(1, 1, At, B1); PG8_BAR; PG8_SCHED;
            PG8_LDB(B0, 1, 0); PG8_LDB(B1, 1, 1); PG8_SCHED; PG8_LDA(At, 1, 0); PG8_STAGE(PG8_SA(0, 1), a2, w1);
            PG8_WAIT_V(8); PG8_WAIT_L(0); PG8_BAR; PG8_MMA(0, 0, At, B0); PG8_MMA(0, 1, At, B1); PG8_BAR; PG8_SCHED;
            PG8_LDA(At, 1, 1); PG8_STAGE(PG8_SB(1, 0), b3, voffB); PG8_STAGE(PG8_SB(1, 1), b3 + hstep, voffB); PG8_STAGE(PG8_SA(1, 0), a3, w0);
            PG8_WAIT_V(8); PG8_WAIT_L(0); PG8_BAR; PG8_MMA(1, 0, At, B0); PG8_MMA(1, 1, At, B1); PG8_BAR; PG8_SCHED;
            } else {
            PG8_LDB(B0, 0, 0); PG8_SCHED; PG8_LDA(At, 0, 0); PG8_STAGE(PG8_SA(1, 1), a1, vAc1);
            PG8_WAIT_L(8); PG8_BAR; PG8_WAIT_L(0); PG8_MMA(0, 0, At, B0); PG8_BAR; PG8_SCHED;
            PG8_LDB(B1, 0, 1); PG8_STAGE(PG8_SB(0, 0), b2, voffB);
            PG8_BAR; PG8_WAIT_L(0); PG8_MMA(0, 1, At, B1); PG8_BAR;
            PG8_LDA(At, 0, 1); PG8_STAGE(PG8_SA(0, 0), a2, w0);
            PG8_BAR; PG8_WAIT_L(0); PG8_MMA(1, 0, At, B0); PG8_BAR; PG8_SCHED;
            PG8_STAGE(PG8_SB(0, 1), b2 + hstep, voffB);
            PG8_WAIT_V(6); PG8_BAR; PG8_MMA(1, 1, At, B1); PG8_BAR;
            PG8_LDB(B0, 1, 0); PG8_SCHED; PG8_LDA(At, 1, 0); PG8_STAGE(PG8_SA(0, 1), a2, w1);
            PG8_WAIT_L(8); PG8_BAR; PG8_WAIT_L(0); PG8_MMA(0, 0, At, B0); PG8_BAR; PG8_SCHED;
            PG8_LDB(B1, 1, 1); PG8_STAGE(PG8_SB(1, 0), b3, voffB);
            PG8_BAR; PG8_WAIT_L(0); PG8_MMA(0, 1, At, B1); PG8_BAR;
            PG8_LDA(At, 1, 1); PG8_STAGE(PG8_SA(1, 0), a3, w0);
            PG8_BAR; PG8_WAIT_L(0); PG8_MMA(1, 0, At, B0); PG8_BAR; PG8_SCHED;
            PG8_STAGE(PG8_SB(1, 1), b3 + hstep, voffB);
            PG8_WAIT_V(6); PG8_BAR; PG8_MMA(1, 1, At, B1); PG8_BAR;
            }
        }
        if constexpr (ALIGN_EPI) { if (wr == 0) PG8_BAR; }
        { E(acc, cur, wr, wc, fr, fq); }
        if (!has_next) break;
#pragma unroll
        for (int a = 0; a < 2; ++a)
#pragma unroll
            for (int b = 0; b < 2; ++b)
#pragma unroll
                for (int m = 0; m < 4; ++m)
#pragma unroll
                    for (int n = 0; n < 2; ++n) acc[a][b][m][n] = (f32x4){0.f, 0.f, 0.f, 0.f};
        cur = nxt; cB = nB; ++ui; vAc0[0] = vAn0[0]; vAc0[1] = vAn0[1]; vAc1[0] = vAn1[0]; vAc1[1] = vAn1[1];
        if constexpr (ALIGN_EPI) { if (wr == 1) PG8_BAR; }
    }
    PG8_WAIT_V(0);
    if constexpr (!ALIGN_EPI) { if (wr == 0) PG8_BAR; }
    PG8_BAR;

#undef PG8_SETA
#undef PG8_SA
#undef PG8_SB
#undef PG8_STAGE
#undef PG8_LDA
#undef PG8_LDB
#undef PG8_MMA
#undef PG8_WAIT_V
#undef PG8_WAIT_L
#undef PG8_BAR
#undef PG8_SCHED
}

struct EpiInProj {
    static constexpr bool PERM = true, AFTER_DRAIN = false;
    bf16* PL; const float* lbv;
    __device__ __forceinline__ void operator()(const f32x4 (&acc)[2][2][4][2], const Unit& u, int wr, int wc, int fr, int fq) const {
        const int p = u.pn >> 2; const bool act = (p == 0) || (p == 4), gate = (p == 2) || (p == 3);
        bf16* base = PL + (size_t)p * ((size_t)M_ALL * D);
        const int col0 = (u.pn & 3) * BM + wc * 32 + 8 * fq, row0 = u.pm * BM + wr * 64 + fr;
        f32x4 om[2][2];
#pragma unroll
        for (int bj = 0; bj < 2; ++bj)
#pragma unroll
            for (int n = 0; n < 2; ++n) om[bj][n] = gate ? (1.f - *(const f32x4*)(lbv + (p - 2) * D + col0 + bj * 128 + 4 * n)) : (f32x4){0.f, 0.f, 0.f, 0.f};
#pragma unroll
        for (int ai = 0; ai < 2; ++ai)
#pragma unroll
            for (int m = 0; m < 4; ++m) { bf16* rowp = base + (size_t)(row0 + ai * 128 + m * 16) * D + col0;
#pragma unroll
                for (int bj = 0; bj < 2; ++bj) { f32x4 v0 = acc[ai][bj][m][0], v1 = acc[ai][bj][m][1];
                    if (act) {
#pragma unroll
                        for (int j = 0; j < 4; ++j) { v0[j] = siluf_(v0[j]); v1[j] = siluf_(v1[j]); } }
                    if (gate) {
#pragma unroll
                        for (int j = 0; j < 4; ++j) { v0[j] = om[bj][0][j] * __builtin_amdgcn_rcpf(1.f + __expf(v0[j])); v1[j] = om[bj][1][j] * __builtin_amdgcn_rcpf(1.f + __expf(v1[j])); } }
                    v4u w; w.x = pk2(v0[0], v0[1]); w.y = pk2(v0[2], v0[3]); w.z = pk2(v1[0], v1[1]); w.w = pk2(v1[2], v1[3]);
                    *(v4u*)(rowp + bj * 128) = w; } }
    }
};
struct EpiPoolIn {
    static constexpr bool PERM = true, AFTER_DRAIN = false;
    bf16* O;
    __device__ __forceinline__ void operator()(const f32x4 (&acc)[2][2][4][2], const Unit& u, int wr, int wc, int fr, int fq) const {
        const int slab0 = (u.pn * BM + wc * 32 + 8 * fq) >> 3, row0 = u.pm * BM + wr * 64 + fr;
#pragma unroll
        for (int ai = 0; ai < 2; ++ai)
#pragma unroll
            for (int m = 0; m < 4; ++m) { const int row = row0 + ai * 128 + m * 16, b = row / SEQ, t = row % SEQ;
#pragma unroll
                for (int bj = 0; bj < 2; ++bj) { const f32x4 v0 = acc[ai][bj][m][0], v1 = acc[ai][bj][m][1];
                    v4u w; w.x = pk2(v0[0], v0[1]); w.y = pk2(v0[2], v0[3]); w.z = pk2(v1[0], v1[1]); w.w = pk2(v1[2], v1[3]);
                    *(v4u*)(O + (((size_t)b * 128 + slab0 + bj * 16) * SEQ + t) * 8) = w; } }
    }
};
struct EpiDown {
    static constexpr bool PERM = true, AFTER_DRAIN = false;
    bf16* O;
    __device__ __forceinline__ void operator()(const f32x4 (&acc)[2][2][4][2], const Unit& u, int wr, int wc, int fr, int fq) const {
        const int col0 = (u.pn & 3) * BM + wc * 32 + 8 * fq, row0 = u.pm * BM + wr * 64 + fr;
#pragma unroll
        for (int ai = 0; ai < 2; ++ai)
#pragma unroll
            for (int m = 0; m < 4; ++m) { bf16* rowp = O + (size_t)(row0 + ai * 128 + m * 16) * D + col0;
#pragma unroll
                for (int bj = 0; bj < 2; ++bj) { const f32x4 v0 = acc[ai][bj][m][0], v1 = acc[ai][bj][m][1];
                    v4u w; w.x = pk2(v0[0], v0[1]); w.y = pk2(v0[2], v0[3]); w.z = pk2(v1[0], v1[1]); w.w = pk2(v1[2], v1[3]);
                    *(v4u*)(rowp + bj * 128) = w; } }
    }
};
struct EpiGateUp {
    static constexpr bool PERM = true, AFTER_DRAIN = false;
    bf16* ACT;
    __device__ __forceinline__ void operator()(const f32x4 (&acc)[2][2][4][2], const Unit& u, int wr, int wc, int fr, int fq) const {
        const int col0 = (u.pn & 1) * 128 + wc * 32 + 8 * fq, row0 = u.pm * BM + wr * 64 + fr;
#pragma unroll
        for (int ai = 0; ai < 2; ++ai)
#pragma unroll
            for (int m = 0; m < 4; ++m) { bf16* rowp = ACT + (size_t)(row0 + ai * 128 + m * 16) * DE + col0;
                f32x4 v0, v1;
#pragma unroll
                for (int j = 0; j < 4; ++j) { v0[j] = siluf_(acc[ai][0][m][0][j]) * acc[ai][1][m][0][j]; v1[j] = siluf_(acc[ai][0][m][1][j]) * acc[ai][1][m][1][j]; }
                v4u w; w.x = pk2(v0[0], v0[1]); w.y = pk2(v0[2], v0[3]); w.z = pk2(v1[0], v1[1]); w.w = pk2(v1[2], v1[3]);
                *(v4u*)rowp = w; }
    }
};
struct EpiGrp {
    static constexpr bool PERM = true, AFTER_DRAIN = false;
    bf16* O; const float* ps;
    __device__ __forceinline__ void operator()(const f32x4 (&acc)[2][2][4][2], const Unit& u, int wr, int wc, int fr, int fq) const {
        const int col0 = u.pn * BM + wc * 32 + 8 * fq, row0 = (u.pm & 63) * BM + wr * 64 + fr;
#pragma unroll
        for (int bj = 0; bj < 2; ++bj) {
            const f32x4 s0 = *(const f32x4*)(ps + col0 + bj * 128), s1 = *(const f32x4*)(ps + col0 + bj * 128 + 4);
#pragma unroll
            for (int ai = 0; ai < 2; ++ai)
#pragma unroll
                for (int m = 0; m < 4; ++m) { bf16* rowp = O + (size_t)(row0 + ai * 128 + m * 16) * D + col0 + bj * 128;
                    const f32x4 v0 = acc[ai][bj][m][0] * s0, v1 = acc[ai][bj][m][1] * s1;
                    v4u w; w.x = pk2(v0[0], v0[1]); w.y = pk2(v0[2], v0[3]); w.z = pk2(v1[0], v1[1]); w.w = pk2(v1[2], v1[3]);
                    *(v4u*)rowp = w; }
        }
    }
};
template <bool XF32> struct EpiResid {
    static constexpr bool PERM = true, AFTER_DRAIN = false;
    const void* xin; bf16* out; const float* gate;
    __device__ __forceinline__ void operator()(const f32x4 (&acc)[2][2][4][2], const Unit& u, int wr, int wc, int fr, int fq) const {
        const int col0 = u.pn * BM + wc * 32 + 8 * fq, row0 = u.pm * BM + wr * 64 + fr;
        const float* gp = gate + (size_t)(row0 / SEQ) * 6144 + col0;
        f32x4 gv[2][2];
#pragma unroll
        for (int bj = 0; bj < 2; ++bj) { gv[bj][0] = *(const f32x4*)(gp + bj * 128); gv[bj][1] = *(const f32x4*)(gp + bj * 128 + 4); }
#pragma unroll
        for (int ai = 0; ai < 2; ++ai)
#pragma unroll
            for (int m = 0; m < 4; ++m) { const size_t ro = (size_t)(row0 + ai * 128 + m * 16) * D + col0;
#pragma unroll
                for (int bj = 0; bj < 2; ++bj) { f32x4 x0, x1;
                    if (XF32) { x0 = *(const f32x4*)((const float*)xin + ro + bj * 128); x1 = *(const f32x4*)((const float*)xin + ro + bj * 128 + 4); }
                    else { const v4u w = *(const v4u*)((const bf16*)xin + ro + bj * 128); x0 = (f32x4){bflo(w.x), bfhi(w.x), bflo(w.y), bfhi(w.y)}; x1 = (f32x4){bflo(w.z), bfhi(w.z), bflo(w.w), bfhi(w.w)}; }
                    const f32x4 y0 = x0 + gv[bj][0] * acc[ai][bj][m][0], y1 = x1 + gv[bj][1] * acc[ai][bj][m][1];
                    v4u o; o.x = pk2(y0[0], y0[1]); o.y = pk2(y0[2], y0[3]); o.z = pk2(y1[0], y1[1]); o.w = pk2(y1[2], y1[3]);
                    *(v4u*)(out + ro + bj * 128) = o; } }
    }
};
static_assert(!CTX_FULL, "the bf16 residual path covers latent rows only");

struct Frame {
    LAS unsigned char* lds; volatile LAS unsigned* MISC; gu32* ctl;
    int tid, lane, wave, G, bid;
    const float* in[23]; float* out; unsigned char* ws;
};
__device__ __forceinline__ const float* modv(const Frame& F, int l, int b, int j) { return (const float*)(F.ws + WS_MODV) + ((size_t)l * 5 + b) * 6144 + j * 1024; }

__device__ __forceinline__ void transpose_item(const float* W, int N, int k0, int n0, bf16* WT, int KT, size_t dst_row0, LAS float* scr, int lane) {
    { const int kr = lane >> 3, ch = lane & 7; f32x4 v[8];
#pragma unroll
      for (int i = 0; i < 8; ++i) v[i] = *(const f32x4*)(W + (size_t)(k0 + 8 * i + kr) * N + n0 + 4 * ch);
#pragma unroll
      for (int i = 0; i < 8; ++i) { LAS float* d = scr + (8 * i + kr) * 33 + 4 * ch; d[0] = v[i].x; d[1] = v[i].y; d[2] = v[i].z; d[3] = v[i].w; } }
    LDS_WAIT(); asm volatile("" ::: "memory");
    const int c = lane & 7;
#pragma unroll
    for (int j = 0; j < 4; ++j) { const int n = (lane >> 3) + 8 * j; const LAS float* s = scr + (8 * c) * 33 + n;
        v4u o; o.x = pk2(s[0 * 33], s[1 * 33]); o.y = pk2(s[2 * 33], s[3 * 33]); o.z = pk2(s[4 * 33], s[5 * 33]); o.w = pk2(s[6 * 33], s[7 * 33]);
        *(v4u*)(WT + (dst_row0 + n) * KT + k0 + 8 * c) = o; }
    LDS_WAIT(); asm volatile("" ::: "memory");
}
__device__ __forceinline__ void conv_moe_item(const Frame& F, int l, int r, bf16* WGU, bf16* WD, LAS float* scr) {
    const int kind = r >> 11, rr = r & 2047, e = rr >> 7, it = rr & 127;
    if (kind < 2) { const float* W = (kind ? F.in[20] : F.in[19]) + (size_t)(l * NE + e) * D * DE; const int kb = it >> 3, nb = it & 7, n0 = 32 * nb;
        transpose_item(W, DE, 64 * kb, n0, WGU, D, (size_t)e * 512 + (n0 >> 7) * 256 + kind * 128 + (n0 & 127), scr, F.lane); }
    else { const float* W = F.in[21] + (size_t)(l * NE + e) * DE * D; const int kb = it >> 5, nb = it & 31;
        transpose_item(W, D, 64 * kb, 32 * nb, WD, DE, (size_t)e * D + 32 * nb, scr, F.lane); }
}

__device__ __forceinline__ void conv_moe_queue(Frame& F, int l, bf16* WGU, bf16* WD) {
    LAS float* scr = (LAS float*)(F.lds + F.wave * 16384);
    unsigned* q = (unsigned*)(F.ctl + CW_Q + 64 * l);
    for (;;) {
        unsigned base = 0;
        if (F.lane == 0) base = atomicAdd(q, 8u);
        base = (unsigned)__builtin_amdgcn_readfirstlane((int)base);
        if (base >= 6144u) break;
        for (int r = (int)base; r < (int)base + 8; ++r) conv_moe_item(F, l, r, WGU, WD, scr);
    }
}
__device__ __forceinline__ void p0_prep(Frame& F) {
    if (F.bid < 192) {
        LAS float* sil = (LAS float*)(F.lds);
        LAS float* red = (LAS float*)(F.lds + 32768);
        for (int i = F.tid; i < 5 * D; i += NTHR) { const float cv = (i < 4 * D) ? F.in[1][i] : F.in[3][i - 4 * D]; sil[i] = siluf_(cv); }
        __syncthreads();
        const int l = F.bid / 96, col0 = (F.bid % 96) * 64;
        const float* W = F.in[4] + (size_t)l * D * 6144 + col0 + F.lane;
        float a0 = 0.f, a1 = 0.f, a2 = 0.f, a3 = 0.f, a4 = 0.f;
        const int kbeg = F.wave * 128;
#pragma unroll 8
        for (int k = kbeg; k < kbeg + 128; ++k) { const float w = W[(size_t)k * 6144];
            a0 += sil[k] * w; a1 += sil[D + k] * w; a2 += sil[2 * D + k] * w; a3 += sil[3 * D + k] * w; a4 += sil[4 * D + k] * w; }
        red[(F.wave * 5 + 0) * 64 + F.lane] = a0; red[(F.wave * 5 + 1) * 64 + F.lane] = a1; red[(F.wave * 5 + 2) * 64 + F.lane] = a2;
        red[(F.wave * 5 + 3) * 64 + F.lane] = a3; red[(F.wave * 5 + 4) * 64 + F.lane] = a4;
        __syncthreads();
        if (F.tid < 320) { const int b = F.tid >> 6, cc = F.tid & 63; float s = 0.f;
#pragma unroll
            for (int w = 0; w < 8; ++w) s += red[(w * 5 + b) * 64 + cc];
            ((float*)(F.ws + WS_MODV))[((size_t)l * 5 + b) * 6144 + col0 + cc] = s + F.in[5][l * 6144 + col0 + cc]; }
        __syncthreads();
    }
    if (F.bid == 192) for (int i = F.tid; i < 2 * D; i += NTHR) { const float* lb = (i < D) ? F.in[9] : F.in[10]; const int c = i & (D - 1);
        ((float*)(F.ws + WS_LBV))[i] = sigmoidf_(lb[c] - lb[D + c]); }
    LAS float* scr = (LAS float*)(F.lds + F.wave * 16384);
    const int gw = F.bid * NWAVES + F.wave, NGW = F.G * NWAVES;
    constexpr int I_IN = 16 * 160, I_OUT = 16 * 32;
    for (int it = gw; it < I_IN + I_OUT; it += NGW) {
        int r = it;
        if (r < I_IN) { const int kb = r / 160, nb = r % 160; transpose_item(F.in[8], NPROJ * D, 64 * kb, 32 * nb, (bf16*)(F.ws + WS_WHGIN), D, (size_t)32 * nb, scr, F.lane); continue; } r -= I_IN;
        { const int kb = r >> 5, nb = r & 31; transpose_item(F.in[12], D, 64 * kb, 32 * nb, (bf16*)(F.ws + WS_WHGOUT), D, (size_t)32 * nb, scr, F.lane); }
    }
}
__device__ __forceinline__ void fold_pool_weights(Frame& F) {
    const int g = (F.bid >> 6) & 3, n0 = (F.bid & 63) * 16;
    LAS float* WS = (LAS float*)F.lds;
    const float* Wout = F.in[16]; const float* ps = F.in[15]; const float* Wg = F.in[14] + (size_t)g * 256 * 256;
    for (int idx = F.tid; idx < 256 * 4; idx += NTHR) { const int j = idx >> 2, c4 = (idx & 3) * 4;
        const f32x4 v = *(const f32x4*)(Wout + (size_t)(256 * g + j) * D + n0 + c4) * ps[256 * g + j];
        *(LAS f32x4*)(WS + j * 20 + c4) = v; }
    __syncthreads();
    const int i = F.tid >> 1, nh = (F.tid & 1) * 8;
    f32x4 acc0 = {0.f, 0.f, 0.f, 0.f}, acc1 = acc0;
    const float* wr = Wg + (size_t)i * 256;
#pragma unroll 4
    for (int j4 = 0; j4 < 256; j4 += 4) { const f32x4 a = *(const f32x4*)(wr + j4);
#pragma unroll
        for (int jj = 0; jj < 4; ++jj) { const LAS f32x4* wp = (const LAS f32x4*)(WS + (j4 + jj) * 20 + nh); acc0 += wp[0] * a[jj]; acc1 += wp[1] * a[jj]; } }
    bf16* WPT = (bf16*)(F.ws + WS_WPOUT);
#pragma unroll
    for (int q = 0; q < 4; ++q) { WPT[(size_t)(n0 + nh + q) * D + 256 * g + i] = (bf16)f2bf(acc0[q]); WPT[(size_t)(n0 + nh + 4 + q) * D + 256 * g + i] = (bf16)f2bf(acc1[q]); }
    __syncthreads();
}
__device__ __forceinline__ void conv_layer1(Frame& F) {
    LAS float* scr = (LAS float*)(F.lds + F.wave * 16384);
    const int gw = F.bid * NWAVES + F.wave, NGW = F.G * NWAVES;
    constexpr int I_SQ = 16 * 32;
    for (int it = gw; it < I_SQ; it += NGW) {
        int r = it;
        { const int kb = r >> 5, nb = r & 31; transpose_item(F.in[13], D, 64 * kb, 32 * nb, (bf16*)(F.ws + WS_WPIN), D, (size_t)32 * nb, scr, F.lane); }
    }
    for (int it = gw; it < 6144; it += NGW) conv_moe_item(F, 1, it, (bf16*)(F.ws + WS_WGU1), (bf16*)(F.ws + WS_WD1), scr);
}

__device__ __forceinline__ void load_row_bf16(const bf16* xr, int lane, f32x4 (&v)[4]) {
#pragma unroll
    for (int j = 0; j < 4; ++j) { const v2u a = ((const v2u*)xr)[lane + 64 * j]; v[j] = (f32x4){bflo(a.x), bfhi(a.x), bflo(a.y), bfhi(a.y)}; }
}
__device__ __forceinline__ void store_row_bf16(bf16* xr, int lane, const f32x4 (&v)[4]) {
#pragma unroll
    for (int j = 0; j < 4; ++j) ((v2u*)xr)[lane + 64 * j] = (v2u){pk2(v[j].x, v[j].y), pk2(v[j].z, v[j].w)};
}
__device__ __forceinline__ void modulate_row(const f32x4 (&v)[4], const float* g, const float* sh, const float* sc, bf16* orow, int lane) {
    float s2 = 0.f;
#pragma unroll
    for (int j = 0; j < 4; ++j) s2 += (v[j].x * v[j].x + v[j].y * v[j].y) + (v[j].z * v[j].z + v[j].w * v[j].w);
    const float rstd = 1.f / sqrtf(wave_sum(s2) * (1.f / D) + EPS);
    unsigned long long* o8 = (unsigned long long*)orow + lane;
#pragma unroll
    for (int j = 0; j < 4; ++j) { const int c = 4 * lane + 256 * j;
        const f32x4 gv = *(const f32x4*)(g + c), shv = *(const f32x4*)(sh + c), scv = *(const f32x4*)(sc + c);
        const f32x4 h = v[j] * rstd * gv * (scv + 1.f) + shv;
        o8[64 * j] = (unsigned long long)pk2(h.x, h.y) | ((unsigned long long)pk2(h.z, h.w) << 32); }
}
__device__ __forceinline__ void p1_modulate0(Frame& F) {
    const int gw = F.bid * NWAVES + F.wave, NGW = F.G * NWAVES;
    bf16* H = (bf16*)(F.ws + WS_H);
    for (int row = gw; row < M_ALL; row += NGW) {
        const bool isctx = row >= M_LAT; const int b = isctx ? 4 : row / SEQ;
        const float* xr = isctx ? F.in[2] + (size_t)(row - M_LAT) * D : F.in[0] + (size_t)row * D;
        f32x4 v[4];
#pragma unroll
        for (int j = 0; j < 4; ++j) v[j] = ((const f32x4*)xr)[F.lane + 64 * j];
        modulate_row(v, F.in[6], modv(F, 0, b, 0), modv(F, 0, b, 1), H + (size_t)row * D, F.lane);
    }
}

__device__ __forceinline__ void p3_scan_naive(Frame& F) {
    if (F.bid >= 64) return;
    const int b = F.bid >> 4, h = (F.bid >> 1) & 7, dir = F.bid & 1;
    const bf16* PQ = (const bf16*)(F.ws + WS_PL), *PV = PQ + (size_t)M_ALL * D, *PZ = PQ + (size_t)(2 + dir) * M_ALL * D;
    bf16* OL = (bf16*)F.out + (size_t)dir * M_LAT * D; bf16* OC = (bf16*)(F.ws + (dir ? WS_OBC : WS_OFC));
    LAS float* fl = (LAS float*)F.lds, *kl = fl + 128, *ql = fl + 256, *ored = fl + 384;
    const int v = F.tid & 127, kq = F.tid >> 7;
    float lbv = 0.f;
    if (F.tid < 128) { const float* lb = dir ? F.in[10] : F.in[9]; lbv = sigmoidf_(lb[h * DH + F.tid] - lb[D + h * DH + F.tid]); }
    float S[32];
#pragma unroll
    for (int j = 0; j < 32; ++j) S[j] = 0.f;
    for (int s = 0; s < CTXL + SEQ; ++s) {
        int row;
        if (s < CTXL) row = M_LAT + b * CTXL + (dir ? CTXL - 1 - s : s);
        else row = b * SEQ + (dir ? SEQ - 1 - (s - CTXL) : s - CTXL);
        const size_t off = (size_t)row * D + h * DH;
        if (F.tid < 128) { const float kk = bf2f(PZ[off + F.tid]);
            fl[F.tid] = 1.f - kk; kl[F.tid] = kk; ql[F.tid] = bf2f(PQ[off + F.tid]); }
        const float vv = bf2f(PV[off + v]);
        __syncthreads();
        float po = 0.f;
#pragma unroll
        for (int j = 0; j < 32; ++j) { const int k = 32 * kq + j; S[j] = fl[k] * S[j] + kl[k] * vv; po += S[j] * ql[k]; }
        ored[kq * 128 + v] = po;
        __syncthreads();
        if (kq == 0) { const float o = (ored[v] + ored[128 + v]) + (ored[256 + v] + ored[384 + v]);
            if (s >= CTXL) OL[(size_t)row * D + h * DH + v] = (bf16)f2bf(o);
            else if (CTX_FULL) OC[(size_t)(row - M_LAT) * D + h * DH + v] = (bf16)f2bf(o); }
    }
}

typedef float f32x16 __attribute__((ext_vector_type(16)));
__device__ __forceinline__ void lds_fadd(LAS float* p, float v) { (void)__hip_atomic_fetch_add(p, v, __ATOMIC_RELAXED, __HIP_MEMORY_SCOPE_WORKGROUP); }
typedef float f32x2 __attribute__((ext_vector_type(2)));
#define MFMA32(a, b, c) __builtin_amdgcn_mfma_f32_32x32x16_bf16((a), (b), (c), 0, 0, 0)
__device__ __forceinline__ int crow(int reg, int h) { return (reg & 3) + 8 * (reg >> 2) + 4 * h; }
__device__ __forceinline__ int t256_off(int row, int cb) { return row * 256 + ((((cb >> 4) ^ (row & 15)) << 4) | (cb & 15)); }
__device__ __forceinline__ int t128_off(int row, int cb) { return row * 128 + ((((cb >> 4) ^ ((row >> 1) & 7)) << 4) | (cb & 15)); }
__device__ __forceinline__ bf16x8 pack8(const f32x16& x, int s) {
    v4u p; p.x = pk2(x[8 * s], x[8 * s + 1]); p.y = pk2(x[8 * s + 2], x[8 * s + 3]); p.z = pk2(x[8 * s + 4], x[8 * s + 5]); p.w = pk2(x[8 * s + 6], x[8 * s + 7]);
    return __builtin_bit_cast(bf16x8, p);
}
template <bool STATE  >
__device__ __forceinline__ void scan_items(Frame& F) {
    constexpr int SC_QE = 0, SC_QC = 16384, SC_KR = 32768, SC_KRT = 49152, SC_VT = 65536, SC_ST = 69632, SC_TOT = 77824, SC_VEC = 81920, SC_SLOT = 83968, SC_ST2 = 124928;
    static_assert(SC_ST2 + 8192 <= RING_BYTES, "scan LDS map");
    constexpr int NCH = (CTXL + SEQ) / 64;
    LAS unsigned char* L = F.lds;
    const int tid = F.tid, lane = F.lane, w = F.wave, r = lane & 31, hh = lane >> 5;
    const bf16* PQ = (const bf16*)(F.ws + WS_PL); const bf16* PV = PQ + (size_t)M_ALL * D;
    f32x16 zero16;
#pragma unroll
    for (int i = 0; i < 16; ++i) zero16[i] = 0.f;
    for (int item = F.bid; item < 256; item += F.G) {
        const int dvs = (item >> 3) & 3, bhd = (item >> 5) * 8 + (item & 7), b = bhd >> 4, h = (bhd >> 1) & 7, dir = bhd & 1;
        const bf16* PZ = PQ + (size_t)(2 + dir) * M_ALL * D;
        const int c0 = 2 * lane, colq = h * DH + c0, colv = h * DH + dvs * 32;
        bf16* OL = (bf16*)F.out + (size_t)dir * M_LAT * D; bf16* OC = (bf16*)(F.ws + (dir ? WS_OBC : WS_OFC));
        const int sgn = dir ? -1 : 1;
        __syncthreads();
        for (int i = tid; i < 8192 / 16; i += NTHR) ((LAS v4u*)(L + SC_ST))[i] = (v4u){0u, 0u, 0u, 0u};
        f32x16 S0 = zero16, S1 = zero16;
        unsigned zr[8], qr[8]; v4u vr = {0u, 0u, 0u, 0u};
#define SCAN_BASE(n) (((n) < 4) ? (M_LAT + b * CTXL + (dir ? CTXL - 1 - 64 * (n) : 64 * (n))) : (b * SEQ + (dir ? SEQ - 1 - 64 * ((n) - 4) : 64 * ((n) - 4))))
#define SCAN_LOAD(n) do { const int _base = SCAN_BASE(n); \
            _Pragma("unroll") for (int _i = 0; _i < 8; ++_i) { const size_t _o = (size_t)(_base + sgn * (8 * w + _i)) * D + colq; zr[_i] = *(const unsigned*)(PZ + _o); qr[_i] = *(const unsigned*)(PQ + _o); } \
            if (tid < 256) vr = *(const v4u*)(PV + (size_t)(_base + sgn * (tid >> 2)) * D + colv + 8 * (tid & 3)); } while (0)
#define SCAN_C(m) do { const LAS unsigned char* sl_ = L + SC_SLOT + ((m) & 1) * 20480; const int base_ = SCAN_BASE(m); \
            _Pragma("unroll") for (int q_ = 0; q_ < 8; ++q_) { const int t_ = lane + 64 * q_, c_ = t_ >> 3, v0_ = (t_ & 7) * 4, so_ = ((c_ & 31) * 32 + v0_) * 4; f32x4 o_; \
                if (c_ < 32) o_ = *(const LAS f32x4*)(sl_ + so_) + *(const LAS f32x4*)(sl_ + 3 * 4096 + so_); \
                else o_ = *(const LAS f32x4*)(sl_ + 4096 + so_) + *(const LAS f32x4*)(sl_ + 2 * 4096 + so_) + *(const LAS f32x4*)(sl_ + 4 * 4096 + so_); \
                const int row_ = base_ + sgn * c_; const v2u ov_ = {pk2(o_.x, o_.y), pk2(o_.z, o_.w)}; \
                if ((m) >= 4) *(v2u*)(OL + (size_t)row_ * D + colv + v0_) = ov_; \
                else if (CTX_FULL) *(v2u*)(OC + (size_t)(row_ - M_LAT) * D + colv + v0_) = ov_; } } while (0)
        SCAN_LOAD(0);
        for (int n = 0; n < NCH; ++n) {
            float f0[8], f1[8];
            float pr0 = 1.f, pr1 = 1.f;
#pragma unroll
            for (int i = 0; i < 8; ++i) { f0[i] = 1.f - bflo(zr[i]); f1[i] = 1.f - bfhi(zr[i]); pr0 *= f0[i]; pr1 *= f1[i]; }
            *(LAS f32x2*)(L + SC_TOT + (w * 128 + c0) * 4) = (f32x2){__logf(pr0), __logf(pr1)};
            __syncthreads();
            if (tid < 256) { const int p = tid >> 2, c8 = tid & 3;
#pragma unroll
                for (int j = 0; j < 8; ++j) { const unsigned hv = (vr[j >> 1] >> (16 * (j & 1))) & 0xffffu; *(LAS unsigned short*)(L + SC_VT + t128_off(8 * c8 + j, 2 * p)) = (unsigned short)hv; } }
            float off0 = 0.f, off1 = 0.f, ref0 = 0.f, ref1 = 0.f, last0 = 0.f, last1 = 0.f;
#pragma unroll
            for (int ww = 0; ww < 8; ++ww) { const f32x2 t2 = *(const LAS f32x2*)(L + SC_TOT + (ww * 128 + c0) * 4); const float t0 = t2.x, t1 = t2.y;
                off0 += (ww < w) ? t0 : 0.f; off1 += (ww < w) ? t1 : 0.f; if (ww < 4) { ref0 += t0; ref1 += t1; } last0 += t0; last1 += t1; }
            float E0 = __expf(off0 - ref0), E1 = __expf(off1 - ref1);
            const float er0 = __expf(ref0), er1 = __expf(ref1);
            unsigned krp0[4], krp1[4];
#pragma unroll
            for (int i = 0; i < 8; i += 2) {
                float kra[2], krb[2];
#pragma unroll
                for (int u = 0; u < 2; ++u) { const int ii = i + u, srow = 8 * w + ii;
                    E0 *= f0[ii]; E1 *= f1[ii];
                    const float R0 = __builtin_amdgcn_rcpf(E0), R1 = __builtin_amdgcn_rcpf(E1);
                    const float q0 = bflo(qr[ii]), q1 = bfhi(qr[ii]);
                    kra[u] = (1.f - f0[ii]) * R0; krb[u] = (1.f - f1[ii]) * R1;
                    *(LAS unsigned*)(L + SC_QE + t256_off(srow, 2 * c0)) = pk2(q0 * E0, q1 * E1);
                    *(LAS unsigned*)(L + SC_QC + t256_off(srow, 2 * c0)) = pk2(q0 * E0 * er0, q1 * E1 * er1);
                    *(LAS unsigned*)(L + SC_KR + t256_off(srow, 2 * c0)) = pk2(kra[u], krb[u]); }
                krp0[i >> 1] = pk2(kra[0], kra[1]); krp1[i >> 1] = pk2(krb[0], krb[1]);
            }
            *(LAS v4u*)(L + SC_KRT + t128_off(c0, 16 * w)) = (v4u){krp0[0], krp0[1], krp0[2], krp0[3]};
            *(LAS v4u*)(L + SC_KRT + t128_off(c0 + 1, 16 * w)) = (v4u){krp1[0], krp1[1], krp1[2], krp1[3]};
            if (w == 0) { *(LAS f32x2*)(L + SC_VEC + c0 * 4) = (f32x2){__expf(last0), __expf(last1)};
                *(LAS f32x2*)(L + SC_VEC + 512 + c0 * 4) = (f32x2){__expf(last0 - ref0), __expf(last1 - ref1)}; }
            if (n + 1 < NCH) SCAN_LOAD(n + 1);
            __syncthreads();
            LAS unsigned char* SLW = L + SC_SLOT + (n & 1) * 20480; const LAS unsigned char* STR = L + ((n & 1) ? SC_ST2 : SC_ST); LAS unsigned char* STW = L + ((n & 1) ? SC_ST : SC_ST2);
            if (!STATE && w < 3) {
                const int sb = (w == 2) ? 1 : 0, cb = (w == 0) ? 0 : 1;
                f32x16 x = zero16;
#pragma unroll
                for (int ks = 0; ks < 8; ++ks) { const int cbyte = (16 * ks + 8 * hh) * 2;
                    const bf16x8 a = *(const LAS bf16x8*)(L + SC_KR + t256_off(32 * sb + r, cbyte)), bq = *(const LAS bf16x8*)(L + SC_QE + t256_off(32 * cb + r, cbyte));
                    x = MFMA32(a, bq, x); }
                if (sb == cb) {
#pragma unroll
                    for (int g = 0; g < 16; ++g) x[g] = (crow(g, hh) > r) ? 0.f : x[g]; }
                f32x16 o = zero16;
#pragma unroll
                for (int sp = 0; sp < 2; ++sp) { const bf16x8 pa = pack8(x, sp); const int s0 = 32 * sb + 16 * sp + 4 * hh;
                    const v2u lo = *(const LAS v2u*)(L + SC_VT + t128_off(r, 2 * s0)), hi = *(const LAS v2u*)(L + SC_VT + t128_off(r, 2 * (s0 + 8)));
                    const bf16x8 vb = __builtin_bit_cast(bf16x8, ((v4u){lo.x, lo.y, hi.x, hi.y}));
                    o = MFMA32(pa, vb, o); }
#pragma unroll
                for (int g = 0; g < 16; ++g) *(LAS float*)(SLW + w * 4096 + (crow(g, hh) * 32 + r) * 4) = o[g];
            } else if (!STATE && w < 5) {
                const int cb = w - 3; f32x16 o = zero16;
#pragma unroll
                for (int ks = 0; ks < 8; ++ks) { const int cbyte = (16 * ks + 8 * hh) * 2;
                    const bf16x8 a = *(const LAS bf16x8*)(L + SC_QC + t256_off(32 * cb + r, cbyte)), bs = *(const LAS bf16x8*)(STR + t256_off(r, cbyte));
                    o = MFMA32(a, bs, o); }
#pragma unroll
                for (int g = 0; g < 16; ++g) *(LAS float*)(SLW + w * 4096 + (crow(g, hh) * 32 + r) * 4) = o[g];
            } else if (STATE) {
#define SCAN_KV(ST_, kb_) do { f32x16 kv = zero16; \
                    _Pragma("unroll") for (int ks = 0; ks < 4; ++ks) { const int sbyte = (16 * ks + 8 * hh) * 2; \
                        const bf16x8 a = *(const LAS bf16x8*)(L + SC_KRT + t128_off(32 * (kb_) + r, sbyte)), bv = *(const LAS bf16x8*)(L + SC_VT + t128_off(r, sbyte)); \
                        kv = MFMA32(a, bv, kv); } \
                    _Pragma("unroll") for (int g4 = 0; g4 < 4; ++g4) { const int kk = (32 * (kb_) + 8 * g4 + 4 * hh) * 4; \
                        const f32x4 el = *(const LAS f32x4*)(L + SC_VEC + kk), elr = *(const LAS f32x4*)(L + SC_VEC + 512 + kk); \
                        _Pragma("unroll") for (int j = 0; j < 4; ++j) ST_[4 * g4 + j] = el[j] * ST_[4 * g4 + j] + elr[j] * kv[4 * g4 + j]; } } while (0)
                const int kb0 = 2 * (w - 5);
                SCAN_KV(S0, kb0); SCAN_KV(S1, kb0 + 1);
#pragma unroll
                for (int g = 0; g < 4; ++g) {
                    *(LAS v2u*)(STW + t256_off(r, 2 * (32 * kb0 + 8 * g + 4 * hh))) = (v2u){pk2(S0[4 * g], S0[4 * g + 1]), pk2(S0[4 * g + 2], S0[4 * g + 3])};
                    *(LAS v2u*)(STW + t256_off(r, 2 * (32 * (kb0 + 1) + 8 * g + 4 * hh))) = (v2u){pk2(S1[4 * g], S1[4 * g + 1]), pk2(S1[4 * g + 2], S1[4 * g + 3])}; }
            } else if (!STATE && n > 0) { SCAN_C(n - 1); }
        }
#undef SCAN_KV
        __syncthreads();
        if (!STATE && w == 7) SCAN_C(NCH - 1);
#undef SCAN_C
#undef SCAN_LOAD
#undef SCAN_BASE
    }
}

__device__ __forceinline__ void p3_scan(Frame& F) {
    if (F.wave == 5 || F.wave == 6) scan_items<true>(F); else scan_items<false>(F);
}
__device__ __forceinline__ void p4_readout_prep(Frame& F) {
    const int gw = F.bid * NWAVES + F.wave, NGW = F.G * NWAVES;
    const bf16* SG = (const bf16*)(F.ws + WS_PL) + (size_t)4 * M_ALL * D; bf16* YP = (bf16*)(F.ws + WS_H);
    const int nrows = CTX_FULL ? M_ALL : M_LAT;
    for (int row = gw; row < nrows; row += NGW) {
        const bf16 *ofp, *obp;
        if (row < M_LAT) { ofp = (const bf16*)F.out + (size_t)row * D; obp = ofp + (size_t)M_LAT * D; }
        else { ofp = (const bf16*)(F.ws + WS_OFC) + (size_t)(row - M_LAT) * D; obp = (const bf16*)(F.ws + WS_OBC) + (size_t)(row - M_LAT) * D; }
        const int c0 = 16 * F.lane;
        const v4u f0 = *(const v4u*)(ofp + c0), f1 = *(const v4u*)(ofp + c0 + 8), b0 = *(const v4u*)(obp + c0), b1 = *(const v4u*)(obp + c0 + 8);
        const v4u g0 = *(const v4u*)(SG + (size_t)row * D + c0), g1 = *(const v4u*)(SG + (size_t)row * D + c0 + 8);
        float o[16]; float ss = 0.f;
#pragma unroll
        for (int q = 0; q < 4; ++q) { o[2 * q] = bflo(f0[q]) + bflo(b0[q]); o[2 * q + 1] = bfhi(f0[q]) + bfhi(b0[q]); o[8 + 2 * q] = bflo(f1[q]) + bflo(b1[q]); o[8 + 2 * q + 1] = bfhi(f1[q]) + bfhi(b1[q]); }
#pragma unroll
        for (int j = 0; j < 16; ++j) ss += o[j] * o[j];
        ss += __shfl_xor(ss, 1); ss += __shfl_xor(ss, 2); ss += __shfl_xor(ss, 4);
        const float rstd = 1.f / sqrtf(ss * (1.f / DH) + EPS);
        const float* gn = F.in[11] + (c0 & 127);
        float y[16];
#pragma unroll
        for (int q = 0; q < 4; ++q) { y[2 * q] = o[2 * q] * rstd * gn[2 * q] * bflo(g0[q]); y[2 * q + 1] = o[2 * q + 1] * rstd * gn[2 * q + 1] * bfhi(g0[q]);
            y[8 + 2 * q] = o[8 + 2 * q] * rstd * gn[8 + 2 * q] * bflo(g1[q]); y[8 + 2 * q + 1] = o[8 + 2 * q + 1] * rstd * gn[8 + 2 * q + 1] * bfhi(g1[q]); }
        v4u w0, w1;
#pragma unroll
        for (int q = 0; q < 4; ++q) { w0[q] = pk2(y[2 * q], y[2 * q + 1]); w1[q] = pk2(y[8 + 2 * q], y[8 + 2 * q + 1]); }
        *(v4u*)(YP + (size_t)row * D + c0) = w0; *(v4u*)(YP + (size_t)row * D + c0 + 8) = w1;
    }
    fold_pool_weights(F);
    conv_layer1(F);
}

__device__ __forceinline__ void top2_of4(float a0, float a1, float a2, float a3, int& i1, int& i2, float& sum) {
    i1 = 0; float v1 = a0;
    if (a1 > v1) { v1 = a1; i1 = 1; }
    if (a2 > v1) { v1 = a2; i1 = 2; }
    if (a3 > v1) { v1 = a3; i1 = 3; }
    const float c0 = (i1 == 0) ? -1e30f : a0, c1 = (i1 == 1) ? -1e30f : a1, c2 = (i1 == 2) ? -1e30f : a2, c3 = (i1 == 3) ? -1e30f : a3;
    i2 = 0; float v2 = c0;
    if (c1 > v2) { v2 = c1; i2 = 1; }
    if (c2 > v2) { v2 = c2; i2 = 2; }
    if (c3 > v2) { v2 = c3; i2 = 3; }
    sum = v1 + v2;
}
__device__ __forceinline__ int rt_swz(int row, int k) { return row * D + ((((k >> 2) ^ row) << 2) | (k & 3)); }
__device__ __forceinline__ void p_route(Frame& F, int l, int bank) {
    LAS float* RWT = (LAS float*)F.lds;
    LAS float* HL = RWT + NE * D;
    LAS float* PART = (LAS float*)(F.lds + LDSCTL_OFF + 1024);
    LAS float* SG = HL + 16 * D;
    LAS unsigned* lcnt = (LAS unsigned*)(PART + 8 * 256);
    const int tid = F.tid, lane = F.lane, w = F.wave;
    for (int i = tid; i < D * NE; i += NTHR) { const int k = i >> 4, e = i & 15; RWT[rt_swz(e, k)] = F.in[17][i]; }
    if (tid < 32) lcnt[tid] = 0u;
    const int nrows = (l == 0 && CTX_FULL) ? M_ALL : M_LAT, ngroups = nrows / 16;
    const float* g = F.in[7] + l * D;
    f32x4 xv[2][4];
#define RT_LOAD(grp) do { _Pragma("unroll") for (int rr = 0; rr < 2; ++rr) { const int row = (grp) * 16 + 2 * w + rr; \
        load_row_bf16((const bf16*)(F.ws + WS_XL) + (size_t)row * D, lane, xv[rr]); } } while (0)
    const int gpb = (ngroups + F.G - 1) / F.G, grp0 = F.bid * gpb, grp1 = (grp0 + gpb < ngroups) ? grp0 + gpb : ngroups;
    if (grp0 < grp1) RT_LOAD(grp0);
    int it = 0;
    for (int grp = grp0; grp < grp1; ++grp, ++it) {
        __syncthreads();
#pragma unroll
        for (int rr = 0; rr < 2; ++rr) { const int rl = 2 * w + rr, row = grp * 16 + rl; const int b = (row >= M_LAT) ? 4 : row / SEQ;
            float s2 = 0.f;
#pragma unroll
            for (int j = 0; j < 4; ++j) s2 += (xv[rr][j].x * xv[rr][j].x + xv[rr][j].y * xv[rr][j].y) + (xv[rr][j].z * xv[rr][j].z + xv[rr][j].w * xv[rr][j].w);
            const float rstd = 1.f / sqrtf(wave_sum(s2) * (1.f / D) + EPS);
            const float* sh = modv(F, l, b, 3); const float* sc = modv(F, l, b, 4);
            unsigned long long* o8 = (unsigned long long*)((bf16*)(F.ws + WS_H) + (size_t)row * D) + lane;
#pragma unroll
            for (int j = 0; j < 4; ++j) { const int c = 4 * lane + 256 * j;
                const f32x4 gv = *(const f32x4*)(g + c), shv = *(const f32x4*)(sh + c), scv = *(const f32x4*)(sc + c);
                const f32x4 h = xv[rr][j] * rstd * gv * (scv + 1.f) + shv;
                o8[64 * j] = (unsigned long long)pk2(h.x, h.y) | ((unsigned long long)pk2(h.z, h.w) << 32);
                *(LAS f32x4*)(HL + rt_swz(rl, c)) = h; } }
        if (grp + 1 < grp1) RT_LOAD(grp + 1);
        __syncthreads();
        { f32x4 acc = {0.f, 0.f, 0.f, 0.f}; const int r16 = lane & 15, q = lane >> 4;
#pragma unroll
          for (int j = 0; j < 8; ++j) { const int k = 128 * w + 16 * j + 4 * q;
              const f32x4 a4 = *(const LAS f32x4*)(HL + rt_swz(r16, k)), b4 = *(const LAS f32x4*)(RWT + rt_swz(r16, k));
              acc = __builtin_amdgcn_mfma_f32_16x16x4f32(a4.x, b4.x, acc, 0, 0, 0); acc = __builtin_amdgcn_mfma_f32_16x16x4f32(a4.y, b4.y, acc, 0, 0, 0);
              acc = __builtin_amdgcn_mfma_f32_16x16x4f32(a4.z, b4.z, acc, 0, 0, 0); acc = __builtin_amdgcn_mfma_f32_16x16x4f32(a4.w, b4.w, acc, 0, 0, 0); }
#pragma unroll
          for (int j = 0; j < 4; ++j) PART[w * 256 + (q * 4 + j) * 16 + r16] = acc[j]; }
        __syncthreads();
        if (tid < 256) { float lg = 0.f;
#pragma unroll
            for (int ww = 0; ww < 8; ++ww) lg += PART[ww * 256 + tid];
            SG[it * 256 + tid] = sigmoidf_(lg); }
    }
#undef RT_LOAD
    __syncthreads();
    {   if (tid < 16 * it) { const int gi = tid >> 4, row = (grp0 + gi) * 16 + (tid & 15);
            float s[16], sel[16];
#pragma unroll
            for (int e4 = 0; e4 < 4; ++e4) { const f32x4 sv = *(const LAS f32x4*)(SG + tid * 16 + 4 * e4), bv = *(const f32x4*)(F.in[18] + 4 * e4);
                s[4 * e4] = sv.x; s[4 * e4 + 1] = sv.y; s[4 * e4 + 2] = sv.z; s[4 * e4 + 3] = sv.w;
                sel[4 * e4] = sv.x + bv.x; sel[4 * e4 + 1] = sv.y + bv.y; sel[4 * e4 + 2] = sv.z + bv.z; sel[4 * e4 + 3] = sv.w + bv.w; }
            int i1a, i2a, i1b, i2b, i1c, i2c, i1d, i2d; float gsa, gsb, gsc, gsd;
            top2_of4(sel[0], sel[1], sel[2], sel[3], i1a, i2a, gsa); top2_of4(sel[4], sel[5], sel[6], sel[7], i1b, i2b, gsb);
            top2_of4(sel[8], sel[9], sel[10], sel[11], i1c, i2c, gsc); top2_of4(sel[12], sel[13], sel[14], sel[15], i1d, i2d, gsd);
            int bpk = i1a | (i2a << 2); float bestv = gsa;
            { const bool c = gsb > bestv; bestv = c ? gsb : bestv; bpk = c ? (i1b | (i2b << 2) | 16) : bpk; }
            { const bool c = gsc > bestv; bestv = c ? gsc : bestv; bpk = c ? (i1c | (i2c << 2) | 32) : bpk; }
            { const bool c = gsd > bestv; bestv = c ? gsd : bestv; bpk = c ? (i1d | (i2d << 2) | 48) : bpk; }
            const int e1 = (bpk >> 4) * 4 + (bpk & 3), e2 = (bpk >> 4) * 4 + ((bpk >> 2) & 3);
            float s1 = 0.f, s2v = 0.f;
#pragma unroll
            for (int e = 0; e < 16; ++e) { s1 = (e == e1) ? s[e] : s1; s2v = (e == e2) ? s[e] : s2v; }
            const float inv = 1.f / (s1 + s2v);
            const unsigned p1 = __hip_atomic_fetch_add(lcnt + e1, 1u, __ATOMIC_RELAXED, __HIP_MEMORY_SCOPE_WORKGROUP);
            const unsigned p2 = __hip_atomic_fetch_add(lcnt + e2, 1u, __ATOMIC_RELAXED, __HIP_MEMORY_SCOPE_WORKGROUP);
            lcnt[32 + tid] = (unsigned)e1 | (p1 << 4) | ((unsigned)e2 << 16) | (p2 << 20);
            float* slotw = (float*)(F.ws + WS_SLOTW);
            slotw[row * 2] = s1 * inv; slotw[row * 2 + 1] = s2v * inv; }
    }
    __syncthreads();
    if (tid < 16) lcnt[16 + tid] = atomicAdd((unsigned*)(F.ctl + CW_CNT + 1024 * bank + 64 * tid), lcnt[tid]);
    __syncthreads();
    if (tid < 16 * it) { const int row = (grp0 + (tid >> 4)) * 16 + (tid & 15); const unsigned en = lcnt[32 + tid];
        const unsigned e1 = en & 15u, p1 = ((en >> 4) & 0xfffu) + lcnt[16 + e1], e2 = (en >> 16) & 15u, p2 = (en >> 20) + lcnt[16 + e2];
        unsigned* list = (unsigned*)(F.ws + WS_LIST); unsigned* slote = (unsigned*)(F.ws + WS_SLOTE);
        list[(size_t)e1 * LIST_CAP + p1] = (unsigned)row * 2u; list[(size_t)e2 * LIST_CAP + p2] = (unsigned)row * 2u + 1u;
        slote[row * 2] = e1 | (p1 << 8); slote[row * 2 + 1] = e2 | (p2 << 8); }
    __syncthreads();
}
__device__ __forceinline__ void moe_prefix(Frame& F, int l) {
    if (F.tid == 0) { unsigned acc = 0;
        for (int e = 0; e < 16; ++e) { const unsigned c = __hip_atomic_load((unsigned*)(F.ctl + CW_CNT + 1024 * l + 64 * e), RLX_AGENT); F.MISC[32 + e] = acc; F.MISC[32 + 17 + e] = c; acc += (c + 255u) >> 8; }
        F.MISC[32 + 16] = acc; }
    __syncthreads();
}
__device__ __forceinline__ void combine_row(Frame& F, int l, int row, int b, const volatile LAS unsigned* tb, f32x4 (&v)[4]) {
    const unsigned se0 = ((const unsigned*)(F.ws + WS_SLOTE))[row * 2], se1 = ((const unsigned*)(F.ws + WS_SLOTE))[row * 2 + 1];
    const float w0 = ((const float*)(F.ws + WS_SLOTW))[row * 2], w1 = ((const float*)(F.ws + WS_SLOTW))[row * 2 + 1];
    const size_t p0 = (size_t)tb[se0 & 255u] * 256 + (se0 >> 8), p1 = (size_t)tb[se1 & 255u] * 256 + (se1 >> 8);
    const bf16* Y2 = (const bf16*)(F.ws + WS_Y2);
    const v2u* y0 = (const v2u*)(Y2 + p0 * D) + F.lane; const v2u* y1 = (const v2u*)(Y2 + p1 * D) + F.lane;
    const float* g2 = modv(F, l, b, 5);
#pragma unroll
    for (int j = 0; j < 4; ++j) { const v2u a = y0[64 * j], c = y1[64 * j]; const f32x4 gv = *(const f32x4*)(g2 + 4 * F.lane + 256 * j);
        f32x4 ff; ff.x = w0 * bflo(a.x) + w1 * bflo(c.x); ff.y = w0 * bfhi(a.x) + w1 * bfhi(c.x); ff.z = w0 * bflo(a.y) + w1 * bflo(c.y); ff.w = w0 * bfhi(a.y) + w1 * bfhi(c.y);
        v[j] = v[j] + gv * ff; }
}
__device__ __forceinline__ void p9_combine_mod(Frame& F) {
    moe_prefix(F, 0);
    const volatile LAS unsigned* tb = F.MISC + 32;
    const int gw = F.bid * NWAVES + F.wave, NGW = F.G * NWAVES;
    const int nrows = CTX_FULL ? M_ALL : M_LAT;
    for (int row = gw; row < nrows; row += NGW) {
        const bool isctx = row >= M_LAT; const int b = isctx ? 4 : row / SEQ;
        bf16* xr = (bf16*)(F.ws + WS_XL) + (size_t)row * D;
        f32x4 v[4];
        load_row_bf16(xr, F.lane, v);
        combine_row(F, 0, row, b, tb, v);
        store_row_bf16(xr, F.lane, v);
        if (!isctx) modulate_row(v, F.in[6] + D, modv(F, 1, b, 0), modv(F, 1, b, 1), (bf16*)(F.ws + WS_H) + (size_t)row * D, F.lane);
    }
}
__device__ __forceinline__ void p11_pool(Frame& F) {
    LAS float* I = (LAS float*)F.lds;
    const bf16* U = (const bf16*)F.out; bf16* DP = (bf16*)(F.ws + WS_DP);
    const int t = F.tid;
    for (int item = F.bid; item < 512; item += F.G) {
        const int b = item >> 7, slab = item & 127, g = slab >> 5, win = 2 << g, half = win >> 1;
        const bf16* Ub = U + ((size_t)b * 128 + slab) * SEQ * 8;
        __syncthreads();
#pragma unroll
        for (int j = 0; j < 8; ++j) { const int tok = t + 512 * j, r = tok >> 6, c = tok & 63; const v4u w = *(const v4u*)(Ub + (size_t)tok * 8);
            LAS f32x4* dst = (LAS f32x4*)(I + r * 512 + ((c ^ (r & 3)) * 8));
            dst[0] = (f32x4){bflo(w.x), bfhi(w.x), bflo(w.y), bfhi(w.y)}; dst[1] = (f32x4){bflo(w.z), bfhi(w.z), bflo(w.w), bfhi(w.w)}; }
        __syncthreads();
        { const int r = t >> 3, ch = t & 7; float run = 0.f;
#pragma unroll
          for (int c0 = 0; c0 < 64; c0 += 16) { float x[16];
#pragma unroll
              for (int k = 0; k < 16; ++k) x[k] = I[r * 512 + (((c0 + k) ^ (r & 3)) * 8) + ch];
#pragma unroll
              for (int k = 0; k < 16; ++k) { run += x[k]; x[k] = run; }
#pragma unroll
              for (int k = 0; k < 16; ++k) I[r * 512 + (((c0 + k) ^ (r & 3)) * 8) + ch] = x[k]; } }
        __syncthreads();
        { const int c = t >> 3, ch = t & 7; float run = 0.f;
#pragma unroll
          for (int r0 = 0; r0 < 64; r0 += 16) { float x[16];
#pragma unroll
              for (int k = 0; k < 16; ++k) x[k] = I[(r0 + k) * 512 + ((c ^ ((r0 + k) & 3)) * 8) + ch];
#pragma unroll
              for (int k = 0; k < 16; ++k) { run += x[k]; x[k] = run; }
#pragma unroll
              for (int k = 0; k < 16; ++k) I[(r0 + k) * 512 + ((c ^ ((r0 + k) & 3)) * 8) + ch] = x[k]; } }
        __syncthreads();
#pragma unroll 2
        for (int j = 0; j < 8; ++j) { const int tok = t + 512 * j, r = tok >> 6, c = tok & 63;
            const int rlo = max(r - half, 0), rhi = min(r - half + win, GRIDW), clo = max(c - half, 0), chi = min(c - half + win, GRIDW);
            const int r1 = rhi - 1, c1 = chi - 1, r0 = rlo - 1, c0 = clo - 1;
            const LAS f32x4* p11 = (const LAS f32x4*)(I + r1 * 512 + ((c1 ^ (r1 & 3)) * 8));
            f32x4 s0 = p11[0], s1 = p11[1];
            if (r0 >= 0) { const LAS f32x4* q = (const LAS f32x4*)(I + r0 * 512 + ((c1 ^ (r0 & 3)) * 8)); s0 -= q[0]; s1 -= q[1]; }
            if (c0 >= 0) { const LAS f32x4* q = (const LAS f32x4*)(I + r1 * 512 + ((c0 ^ (r1 & 3)) * 8)); s0 -= q[0]; s1 -= q[1]; }
            if (r0 >= 0 && c0 >= 0) { const LAS f32x4* q = (const LAS f32x4*)(I + r0 * 512 + ((c0 ^ (r0 & 3)) * 8)); s0 += q[0]; s1 += q[1]; }
            const float inv = 1.f / (float)((rhi - rlo) * (chi - clo));
            const v4u w = *(const v4u*)(Ub + (size_t)tok * 8);
            v4u o; o.x = pk2(s0.x * inv - bflo(w.x), s0.y * inv - bfhi(w.x)); o.y = pk2(s0.z * inv - bflo(w.y), s0.w * inv - bfhi(w.y));
            o.z = pk2(s1.x * inv - bflo(w.z), s1.y * inv - bfhi(w.z)); o.w = pk2(s1.z * inv - bflo(w.w), s1.w * inv - bfhi(w.w));
            *(v4u*)(DP + ((size_t)slab * M_LAT + (size_t)b * SEQ + tok) * 8) = o; }
    }
}
__device__ __forceinline__ void p17_final(Frame& F) {
    moe_prefix(F, 1);
    const volatile LAS unsigned* tb = F.MISC + 32;
    const int gw = F.bid * NWAVES + F.wave, NGW = F.G * NWAVES;
    for (int row = gw; row < M_LAT; row += NGW) {
        float* xr = F.out + (size_t)row * D;
        f32x4 v[4];
        load_row_bf16((const bf16*)(F.ws + WS_XL) + (size_t)row * D, F.lane, v);
        combine_row(F, 1, row, row / SEQ, tb, v);
        float s2 = 0.f;
#pragma unroll
        for (int j = 0; j < 4; ++j) s2 += (v[j].x * v[j].x + v[j].y * v[j].y) + (v[j].z * v[j].z + v[j].w * v[j].w);
        const float rstd = 1.f / sqrtf(wave_sum(s2) * (1.f / D) + EPS);
#pragma unroll
        for (int j = 0; j < 4; ++j) { const f32x4 gv = *(const f32x4*)(F.in[22] + 4 * F.lane + 256 * j); ((f32x4*)xr)[F.lane + 64 * j] = v[j] * rstd * gv; }
    }
}

struct Args { const float* in[23]; float* out; unsigned char* ws; int ph_lo, ph_hi; };
#ifndef NAIVE_GEMM
#define RUN_GEMM(EpiT, SchedT, g, S, E) gemm_phase<EpiT, SchedT, true, true>(F.lds, g, S, E)
#else
#define RUN_GEMM(EpiT, SchedT, g, S, E) gemm_naive<EpiT, SchedT>(g, S, E)
#endif

__global__ void __launch_bounds__(NTHR, 2) fwd_kernel(Args args) {
    extern __shared__ __attribute__((aligned(16))) unsigned char lds[];
    Frame F;
    F.lds = (LAS unsigned char*)lds; F.MISC = (volatile LAS unsigned*)(F.lds + MISC_OFF);
    F.tid = threadIdx.x; F.lane = F.tid & 63; F.wave = __builtin_amdgcn_readfirstlane(F.tid >> 6);
    F.G = gridDim.x; F.bid = blockIdx.x;
#pragma unroll
    for (int i = 0; i < 23; ++i) F.in[i] = args.in[i];
    F.out = args.out; F.ws = args.ws; F.ctl = (gu32*)(args.ws + WS_CTL);
    for (int u = F.tid; u < (LDS_BYTES - LDSCTL_OFF) / 4; u += NTHR) ((LAS unsigned*)(F.lds + LDSCTL_OFF))[u] = 0u;
    __syncthreads();
    XcdBarrier bar; bar.bar = (unsigned*)(F.ctl + CW_BAR); bar.x = 0; bar.st = nullptr;
    if (MK_ONE_LAUNCH) bar = xcd_barrier_post((unsigned*)(F.ctl + CW_BAR), F.MISC + 8);
    const int lo = args.ph_lo, hi = args.ph_hi;
#ifndef PHMASK
#define PHMASK 0x3ffff
#endif
#define IN(k) (((PHMASK >> (k)) & 1) && lo <= (k) && (k) < hi)
#ifndef REPMASK
#define REPMASK 0
#endif
#define REPLOOP(k) for (int _r = 0; _r <= ((REPMASK >> (k)) & 1); (++_r <= ((REPMASK >> (k)) & 1)) ? xcd_barrier(bar) : (void)0)
#define SEAM(k) do { if (IN(k) && IN((k) + 1)) xcd_barrier(bar); } while (0)
    bf16* const PL = (bf16*)(F.ws + WS_PL);

    if (IN(0)) REPLOOP(0) { p0_prep(F); } SEAM(0);
    if (IN(1)) REPLOOP(1) { p1_modulate0(F); } SEAM(1);
    if (IN(2)) REPLOOP(2) {
        Gemm g{(const bf16*)(F.ws + WS_H), (const bf16*)(F.ws + WS_WHGIN), D, 128}; StaticOrder S; S.init(M_ALL, NPROJ * D, F.G, F.bid);
        EpiInProj E{PL, (const float*)(F.ws + WS_LBV)}; RUN_GEMM(EpiInProj, StaticOrder, g, S, E);
        conv_moe_queue(F, 0, (bf16*)(F.ws + WS_WGU0), (bf16*)(F.ws + WS_WD0)); } SEAM(2);
    #ifdef SCAN_NAIVE
    if (IN(3)) REPLOOP(3) { p3_scan_naive(F); } SEAM(3);
#else
    if (IN(3)) REPLOOP(3) { p3_scan(F); } SEAM(3);
#endif
    if (IN(4)) REPLOOP(4) { p4_readout_prep(F); } SEAM(4);
    if (IN(5)) REPLOOP(5) {
        Gemm g{(const bf16*)(F.ws + WS_H), (const bf16*)(F.ws + WS_WHGOUT), D, 128}; StaticOrder S; S.init(CTX_FULL ? M_ALL : M_LAT, D, F.G, F.bid);
        EpiResid<true> E{F.in[0], (bf16*)(F.ws + WS_XL), modv(F, 0, 0, 2)}; RUN_GEMM(EpiResid<true>, StaticOrder, g, S, E); } SEAM(5);
    if (IN(6)) REPLOOP(6) { p_route(F, 0, (_r < ((REPMASK >> 6) & 1)) ? 2 : 0); } SEAM(6);
    if (IN(7)) REPLOOP(7) { moe_prefix(F, 0);
        Gemm g{(const bf16*)(F.ws + WS_H), (const bf16*)(F.ws + WS_WGU0), D, 128}; MoeOrder S{F.G, F.bid, 2, 1, F.MISC + 32, (const unsigned*)(F.ws + WS_LIST)};
        EpiGateUp E{(bf16*)(F.ws + WS_ACT)}; RUN_GEMM(EpiGateUp, MoeOrder, g, S, E);
 } SEAM(7);
    if (IN(8)) REPLOOP(8) { moe_prefix(F, 0);
        Gemm g{(const bf16*)(F.ws + WS_ACT), (const bf16*)(F.ws + WS_WD0), DE, 128}; MoeOrder S{F.G, F.bid, 4, 0, F.MISC + 32, (const unsigned*)(F.ws + WS_LIST)};
        EpiDown E{(bf16*)(F.ws + WS_Y2)}; RUN_GEMM(EpiDown, MoeOrder, g, S, E); } SEAM(8);
    if (IN(9)) REPLOOP(9) { p9_combine_mod(F); } SEAM(9);
    if (IN(10)) REPLOOP(10) {
        Gemm g{(const bf16*)(F.ws + WS_H), (const bf16*)(F.ws + WS_WPIN), D, 128}; StaticOrder S; S.init(M_LAT, D, F.G, F.bid);
        EpiPoolIn E{(bf16*)F.out}; RUN_GEMM(EpiPoolIn, StaticOrder, g, S, E); } SEAM(10);
        if (IN(11)) REPLOOP(11) { p11_pool(F); } SEAM(11);
    if (IN(13)) REPLOOP(13) {
        Gemm g{(const bf16*)(F.ws + WS_DP), (const bf16*)(F.ws + WS_WPOUT), D, (size_t)8 * M_LAT * 16}; SlabOrder S; S.init(M_LAT, D, F.G, F.bid);
        EpiResid<false> E{F.ws + WS_XL, (bf16*)(F.ws + WS_XL), modv(F, 1, 0, 2)}; RUN_GEMM(EpiResid<false>, SlabOrder, g, S, E); } SEAM(13);
    if (IN(14)) REPLOOP(14) { p_route(F, 1, (_r < ((REPMASK >> 14) & 1)) ? 3 : 1); } SEAM(14);
    if (IN(15)) REPLOOP(15) { moe_prefix(F, 1);
        Gemm g{(const bf16*)(F.ws + WS_H), (const bf16*)(F.ws + WS_WGU1), D, 128}; MoeOrder S{F.G, F.bid, 2, 1, F.MISC + 32, (const unsigned*)(F.ws + WS_LIST)};
        EpiGateUp E{(bf16*)(F.ws + WS_ACT)}; RUN_GEMM(EpiGateUp, MoeOrder, g, S, E); } SEAM(15);
    if (IN(16)) REPLOOP(16) { moe_prefix(F, 1);
        Gemm g{(const bf16*)(F.ws + WS_ACT), (const bf16*)(F.ws + WS_WD1), DE, 128}; MoeOrder S{F.G, F.bid, 4, 0, F.MISC + 32, (const unsigned*)(F.ws + WS_LIST)};
        EpiDown E{(bf16*)(F.ws + WS_Y2)}; RUN_GEMM(EpiDown, MoeOrder, g, S, E); } SEAM(16);
    if (IN(17)) REPLOOP(17) { p17_final(F); }
#undef IN
#undef SEAM
}

extern "C" void kernel_launch(void* const* d_in, const int* in_sizes, int n_in, void* d_out, int out_size, void* d_ws, size_t ws_size, hipStream_t stream) {
    static int grid = 0;
    if (grid == 0) {
        if (n_in != 23 || in_sizes[0] != M_LAT * D || out_size != M_LAT * D || ws_size < WS_END) { fprintf(stderr, "kernel_launch: unexpected shapes (n_in %d, in0 %d, out %d, ws %zu); nothing launched\n", n_in, n_in > 0 ? in_sizes[0] : -1, out_size, ws_size); grid = -1; return; }
        int dev = 0, cus = 0, per_cu = 0;
        if (hipGetDevice(&dev) != hipSuccess || hipDeviceGetAttribute(&cus, hipDeviceAttributeMultiprocessorCount, dev) != hipSuccess) { grid = -1; return; }
        if (hipFuncSetAttribute((const void*)fwd_kernel, hipFuncAttributeMaxDynamicSharedMemorySize, LDS_BYTES) != hipSuccess) { fprintf(stderr, "kernel_launch: hipFuncSetAttribute failed\n"); grid = -1; return; }
        if (hipOccupancyMaxActiveBlocksPerMultiprocessor(&per_cu, (const void*)fwd_kernel, NTHR, LDS_BYTES) != hipSuccess || per_cu < 1) { fprintf(stderr, "kernel_launch: occupancy query says %d blocks per CU\n", per_cu); per_cu = 1; }
        (void)hipGetLastError();
        grid = cus;
    }
    if (grid < 0) return;
    if (hipMemsetAsync((char*)d_ws + WS_CTL, 0, CTL_ZERO_BYTES, stream) != hipSuccess) return;
    Args a{};
    for (int i = 0; i < 23; ++i) a.in[i] = (const float*)d_in[i];
    a.out = (float*)d_out; a.ws = (unsigned char*)d_ws;
    if (MK_ONE_LAUNCH) { a.ph_lo = 0; a.ph_hi = NPHASE; hipLaunchKernelGGL(fwd_kernel, dim3(grid), dim3(NTHR), LDS_BYTES, stream, a); }
    else for (int p = 0; p < NPHASE; ++p) { a.ph_lo = p; a.ph_hi = p + 1; hipLaunchKernelGGL(fwd_kernel, dim3(grid), dim3(NTHR), LDS_BYTES, stream, a); }
}
```
